# Optimizing an MI355X kernel written in HIP

```python
import math
import jax, jax.numpy as jnp
from jax import lax
import numpy as np

D_MODEL = 1024
BATCH = 8
SEQ = 4096
DEPTH = 4

CHUNK = 64
Q_BLOCK = 128
D_FF = 2816
NORM_EPS = 1e-6

A_HEADS = 4
A_QK_DIM = 64
A_V_DIM = 2 * A_QK_DIM
A_WIDTH = A_HEADS * A_V_DIM
A_COLS = 3 * A_WIDTH

B_HEAD_DIM = 64
B_WIDTH = D_MODEL - A_WIDTH
B_HEADS = B_WIDTH // B_HEAD_DIM
B_DECAY_RANK = 64
B_A_RANK = 64
B_GATE_RANK = 128
B_VRES_RANK = 32
B_LN_EPS = 64e-5
B_COLS = 3 * B_WIDTH + B_DECAY_RANK + B_A_RANK + B_GATE_RANK
B_SPLITS = [B_WIDTH, 2 * B_WIDTH, 3 * B_WIDTH, 3 * B_WIDTH + B_DECAY_RANK,
            3 * B_WIDTH + B_DECAY_RANK + B_A_RANK]
EVEN_IN = A_COLS + B_COLS

C_HEADS = 4
C_QK_DIM = D_MODEL // C_HEADS
C_V_DIM = 2 * C_QK_DIM
C_QK_WIDTH = C_HEADS * C_QK_DIM
C_V_WIDTH = C_HEADS * C_V_DIM
ODD_IN = 2 * C_QK_WIDTH + 2 * C_V_WIDTH

N_EVEN = (DEPTH + 1) // 2
N_ODD = DEPTH // 2

kernel_name = 'hybrid_diffattn_rwkv7_retention_macaron'


def rms_norm(x, g, eps=NORM_EPS):
    xf = x.astype(jnp.float32)
    y = xf * lax.rsqrt(jnp.mean(xf * xf, axis=-1, keepdims=True) + eps)
    return (y * g.astype(jnp.float32)).astype(x.dtype)


def swiglu(x, w_gu, w_d):
    gate, up = jnp.split(x @ w_gu, 2, axis=-1)
    return (jax.nn.silu(gate) * up) @ w_d


def token_shift(z, mu):
    z_prev = jnp.pad(z, ((0, 0), (1, 0), (0, 0)))[:, :-1]
    return z + (z_prev - z) * mu


def diff_attention(q, k, v, lam):
    S_ = q.shape[1]
    q = q * (A_QK_DIM ** -0.5)
    slopes = 2.0 ** (-8.0 / A_HEADS * jnp.arange(1, A_HEADS + 1, dtype=jnp.float32))
    pos = jnp.arange(S_)
    chunk_id = pos // CHUNK
    outs = []
    for s0 in range(0, S_, Q_BLOCK):
        kend = s0 + Q_BLOCK
        scores = jnp.einsum('bqhmd,bkhmd->bhmqk', q[:, s0:kend], k[:, :kend]).astype(jnp.float32)
        dist = jnp.abs(pos[s0:kend][:, None] - pos[:kend][None, :]).astype(jnp.float32)
        bias = -slopes[:, None, None, None] * dist
        allowed = chunk_id[:kend][None, :] <= chunk_id[s0:kend][:, None]
        scores = jnp.where(allowed, scores + bias, -jnp.inf)
        p = jax.nn.softmax(scores, axis=-1)
        p = p[:, :, 0] - lam * p[:, :, 1]
        outs.append(jnp.einsum('bhqk,bkhe->bqhe', p.astype(v.dtype), v[:, :kend]))
    return jnp.concatenate(outs, axis=1)


def rwkv7_recurrence(r, w, k, v, kk, a):
    Bn, _, H, N = r.shape

    def step(state, inp):
        r_t, w_t, k_t, v_t, kk_t, a_t = inp
        sa = jnp.einsum('bhvk,bhk->bhv', state, -kk_t)
        state = (state * w_t[:, :, None, :]
                 + sa[..., None] * (kk_t * a_t)[:, :, None, :]
                 + v_t[..., None] * k_t[:, :, None, :])
        return state, jnp.einsum('bhvk,bhk->bhv', state, r_t)

    xs = tuple(jnp.moveaxis(t, 1, 0) for t in (r, w, k, v, kk, a))
    state0 = jnp.zeros((Bn, H, N, N), jnp.float32)
    _, y = lax.scan(step, state0, xs)
    return jnp.moveaxis(y, 0, 1)


def head_group_norm(y, w, b):
    Bn, S_ = y.shape[:2]
    mean = jnp.mean(y, axis=-1, keepdims=True)
    var = jnp.mean(jnp.square(y - mean), axis=-1, keepdims=True)
    yn = (y - mean) * lax.rsqrt(var + B_LN_EPS)
    return yn.reshape(Bn, S_, -1) * w + b


def rwkv7_time_mix(zb, mu, vec, w_up, a_up, g_up, v_first, vres):
    Bn, S_, _ = zb.shape
    f32 = jnp.float32
    zs = token_shift(zb.astype(f32), mu.astype(f32))
    r, k, v, xw, xa, xg = jnp.split(zs, B_SPLITS, axis=-1)
    w0, a0, k_k, k_a, r_k, ln_w, ln_b = vec.astype(f32)
    w = -jax.nn.softplus(-(w0 + jnp.tanh(xw) @ w_up.astype(f32))) - 0.5
    decay = jnp.exp(-jnp.exp(w))
    if vres is not None:
        v0, v_down, v_up = vres
        v = v + (v_first - v) * jax.nn.sigmoid(v0.astype(f32) + (v @ v_down.astype(f32)) @ v_up.astype(f32))
    a = jax.nn.sigmoid(a0 + xa @ a_up.astype(f32))
    g = jax.nn.sigmoid(xg) @ g_up.astype(f32)
    heads = lambda t: t.reshape(Bn, S_, B_HEADS, B_HEAD_DIM)
    kk = heads(k * k_k)
    kk = kk / jnp.maximum(jnp.sqrt(jnp.sum(kk * kk, axis=-1, keepdims=True)), 1e-12)
    k = k * (1.0 + (a - 1.0) * k_a)
    rh, kh, vh = heads(r), heads(k), heads(v)
    y = rwkv7_recurrence(rh, heads(decay), kh, vh, kk, heads(a))
    y = head_group_norm(y, ln_w, ln_b)
    r_k_h = r_k.reshape(B_HEADS, B_HEAD_DIM)
    bonus = jnp.sum(rh * kh * r_k_h, axis=-1, keepdims=True) * vh
    y = y + bonus.reshape(Bn, S_, B_WIDTH)
    return y * g, v


def diff_rwkv_mixer(h, w_in, w_out, lam_vecs, subln, lam_init, mu, vec, w_up, a_up, g_up, v_first, vres):
    Bn, S_, _ = h.shape
    z = h @ w_in
    za, zb = z[..., :A_COLS], z[..., A_COLS:]
    qa, ka, va = jnp.split(za, 3, axis=-1)
    qa = qa.reshape(Bn, S_, A_HEADS, 2, A_QK_DIM)
    ka = ka.reshape(Bn, S_, A_HEADS, 2, A_QK_DIM)
    va = va.reshape(Bn, S_, A_HEADS, A_V_DIM)
    lv = lam_vecs.astype(jnp.float32)
    lam = jnp.exp(jnp.sum(lv[0] * lv[1])) - jnp.exp(jnp.sum(lv[2] * lv[3])) + lam_init
    oa = diff_attention(qa, ka, va, lam)
    oa = rms_norm(oa, subln) * (1.0 - lam_init)
    ob, v_b = rwkv7_time_mix(zb, mu, vec, w_up, a_up, g_up, v_first, vres)
    mix = jnp.concatenate([oa.reshape(Bn, S_, A_WIDTH), ob.astype(h.dtype)], axis=-1)
    return mix @ w_out, v_b


def retention(q, k, v):
    Bn, S_, H, _ = q.shape
    dk, dv = q.shape[-1], v.shape[-1]
    n_chunks = S_ // CHUNK
    log_g = jnp.log(1.0 - 2.0 ** (-5.0 - jnp.arange(H, dtype=jnp.float32)))
    idx = jnp.arange(CHUNK, dtype=jnp.float32)
    intra = jnp.exp(log_g[:, None, None] * jnp.abs(idx[:, None] - idx[None, :]))
    q_decay = jnp.exp(log_g[:, None] * (idx + 1.0))
    k_decay = jnp.exp(log_g[:, None] * (CHUNK - 1.0 - idx))
    chunk_decay = jnp.exp(log_g * CHUNK)

    def to_chunks(t):
        return t.reshape(Bn, n_chunks, CHUNK, H, t.shape[-1]).transpose(1, 0, 3, 2, 4)

    def step(state, inp):
        qc, kc, vc = inp
        scores = jnp.einsum('bhid,bhjd->bhij', qc, kc) * intra
        y = (jnp.einsum('bhij,bhjv->bhiv', scores, vc)
             + jnp.einsum('bhid,bhdv->bhiv', qc, state) * q_decay[:, :, None])
        state = (state * chunk_decay[:, None, None]
                 + jnp.einsum('bhjd,bhjv->bhdv', kc * k_decay[:, :, None], vc))
        return state, y

    state0 = jnp.zeros((Bn, H, dk, dv), jnp.float32)
    _, y = lax.scan(step, state0, (to_chunks(q), to_chunks(k), to_chunks(v)))
    return y.transpose(1, 0, 3, 2, 4).reshape(Bn, S_, H, dv)


def retention_mixer(h, w_in, w_out):
    Bn, S_, _ = h.shape
    z = (h @ w_in).astype(jnp.float32)
    q, k, v, g = jnp.split(z, [C_QK_WIDTH, 2 * C_QK_WIDTH, 2 * C_QK_WIDTH + C_V_WIDTH], axis=-1)
    q = q.reshape(Bn, S_, C_HEADS, C_QK_DIM)
    k = k.reshape(Bn, S_, C_HEADS, C_QK_DIM) * (C_QK_DIM ** -0.5)
    v = v.reshape(Bn, S_, C_HEADS, C_V_DIM)
    y = retention(q, k, v)
    y = y * lax.rsqrt(jnp.mean(y * y, axis=-1, keepdims=True) + NORM_EPS)
    y = jax.nn.silu(g) * y.reshape(Bn, S_, C_V_WIDTH)
    return y.astype(h.dtype) @ w_out


def setup_inputs(seed: int = 0) -> dict:
    key = jax.random.key(seed)
    ks = jax.random.split(key, 24)
    nrm = lambda k, shape, s: s * jax.random.normal(k, shape, jnp.float32)
    x = nrm(ks[0], (BATCH, SEQ, D_MODEL), 1.0)
    norms = 1.0 + nrm(ks[1], (DEPTH, 6, D_MODEL), 0.05)
    ffn_wgu = nrm(ks[2], (DEPTH, 2, D_MODEL, 2 * D_FF), D_MODEL ** -0.5)
    ffn_wd = nrm(ks[3], (DEPTH, 2, D_FF, D_MODEL), D_FF ** -0.5)
    even_w_in = nrm(ks[4], (N_EVEN, D_MODEL, EVEN_IN), D_MODEL ** -0.5)
    even_w_out = nrm(ks[5], (N_EVEN, D_MODEL, D_MODEL), D_MODEL ** -0.5)
    diff_lam = nrm(ks[6], (N_EVEN, 4, A_QK_DIM), 0.1)
    diff_subln = 1.0 + nrm(ks[7], (N_EVEN, A_V_DIM), 0.05)
    rwkv_mu = jax.random.uniform(ks[8], (N_EVEN, B_COLS), jnp.float32)
    vshape = (N_EVEN, B_WIDTH)
    w0 = jnp.linspace(-6.0, -1.0, B_WIDTH, dtype=jnp.float32)[None, :] + nrm(ks[9], vshape, 0.1)
    a0 = nrm(ks[10], vshape, 0.1)
    k_k = 0.85 + nrm(ks[11], vshape, 0.05)
    k_a = 1.0 + nrm(ks[12], vshape, 0.05)
    r_k = nrm(ks[13], vshape, 0.1)
    ln_w = 1.0 + nrm(ks[14], vshape, 0.05)
    ln_b = nrm(ks[15], vshape, 0.02)
    rwkv_vec = jnp.stack([w0, a0, k_k, k_a, r_k, ln_w, ln_b], axis=1)
    rwkv_w_up = nrm(ks[16], (N_EVEN, B_DECAY_RANK, B_WIDTH), 0.1 * B_DECAY_RANK ** -0.5)
    rwkv_a_up = nrm(ks[17], (N_EVEN, B_A_RANK, B_WIDTH), 0.5 * B_A_RANK ** -0.5)
    rwkv_g_up = nrm(ks[18], (N_EVEN, B_GATE_RANK, B_WIDTH), B_GATE_RANK ** -0.5)
    rwkv_v0 = nrm(ks[19], (N_EVEN - 1, B_WIDTH), 0.1)
    rwkv_v_down = nrm(ks[20], (N_EVEN - 1, B_WIDTH, B_VRES_RANK), B_WIDTH ** -0.5)
    rwkv_v_up = nrm(ks[21], (N_EVEN - 1, B_VRES_RANK, B_WIDTH), 0.5 * B_VRES_RANK ** -0.5)
    odd_w_in = nrm(ks[22], (N_ODD, D_MODEL, ODD_IN), D_MODEL ** -0.5)
    odd_w_out = nrm(ks[23], (N_ODD, C_V_WIDTH, D_MODEL), C_V_WIDTH ** -0.5)
    return {'x': x, 'norms': norms, 'ffn_wgu': ffn_wgu, 'ffn_wd': ffn_wd,
            'even_w_in': even_w_in, 'even_w_out': even_w_out,
            'diff_lam': diff_lam, 'diff_subln': diff_subln,
            'rwkv_mu': rwkv_mu, 'rwkv_vec': rwkv_vec,
            'rwkv_w_up': rwkv_w_up, 'rwkv_a_up': rwkv_a_up, 'rwkv_g_up': rwkv_g_up,
            'rwkv_v0': rwkv_v0, 'rwkv_v_down': rwkv_v_down, 'rwkv_v_up': rwkv_v_up,
            'odd_w_in': odd_w_in, 'odd_w_out': odd_w_out}


def reference(x, norms, ffn_wgu, ffn_wd, even_w_in, even_w_out, diff_lam, diff_subln,
              rwkv_mu, rwkv_vec, rwkv_w_up, rwkv_a_up, rwkv_g_up,
              rwkv_v0, rwkv_v_down, rwkv_v_up, odd_w_in, odd_w_out):
    v_first = None
    for i in range(DEPTH):
        g = norms[i]
        x = x + 0.5 * rms_norm(swiglu(rms_norm(x, g[0]), ffn_wgu[i, 0], ffn_wd[i, 0]), g[1])
        h = rms_norm(x, g[2])
        j = i // 2
        if i % 2 == 0:
            lam_init = 0.8 - 0.6 * math.exp(-0.3 * i)
            vres = None if j == 0 else (rwkv_v0[j - 1], rwkv_v_down[j - 1], rwkv_v_up[j - 1])
            mix, v_b = diff_rwkv_mixer(h, even_w_in[j], even_w_out[j], diff_lam[j], diff_subln[j],
                                       lam_init, rwkv_mu[j], rwkv_vec[j], rwkv_w_up[j],
                                       rwkv_a_up[j], rwkv_g_up[j], v_first, vres)
            if j == 0:
                v_first = v_b
        else:
            mix = retention_mixer(h, odd_w_in[j], odd_w_out[j])
        x = x + rms_norm(mix, g[3])
        x = x + 0.5 * rms_norm(swiglu(rms_norm(x, g[4]), ffn_wgu[i, 1], ffn_wd[i, 1]), g[5])
    return x
```

```cpp
#include <hip/hip_runtime.h>
#include <hip/hip_cooperative_groups.h>
#include <cstdio>
#include <cstdint>
namespace cg = cooperative_groups;

#define LAS __attribute__((address_space(3)))
#define DI __device__ __forceinline__
typedef unsigned short bf16_t;
typedef short bf16x8 __attribute__((ext_vector_type(8)));
typedef short s16x4 __attribute__((ext_vector_type(4)));
typedef float f32x4 __attribute__((ext_vector_type(4)));
typedef float f32x2 __attribute__((ext_vector_type(2)));
typedef unsigned u32x4 __attribute__((ext_vector_type(4)));
typedef unsigned u32x2 __attribute__((ext_vector_type(2)));
typedef __bf16 bf16x2_t __attribute__((ext_vector_type(2)));

#ifndef MK_PER_PHASE
#define MK_PER_PHASE 0
#endif

constexpr int M_TOK = 32768, SEQ = 4096, DM = 1024, DFF = 2816, NWAVES = 8, NTHR = 512;
constexpr int EVEN_IN = 3328, ODD_IN = 6144;
constexpr float NORM_EPS = 1e-6f;
constexpr float LOG2E = 1.4426950408889634f;

constexpr size_t MiB = 1u << 20;
constexpr size_t WS_CTL = 0, CTL_BYTES = 4096;
constexpr size_t WS_RINV = 1 * MiB;
constexpr size_t WS_WGU0 = 2 * MiB, WS_WD0 = 13 * MiB, WS_WIN = 19 * MiB, WS_WOUT = 31 * MiB, WS_WGU1 = 35 * MiB, WS_WD1 = 46 * MiB;
constexpr size_t WS_VFIRST = 52 * MiB;
constexpr size_t WS_TMP = 84 * MiB;
constexpr size_t WS_XB = WS_TMP, WS_F = WS_TMP + 64 * MiB;
constexpr size_t WS_BIG = 212 * MiB;
constexpr size_t WS_H = WS_BIG, WS_ZODD = WS_BIG, WS_MIXE = WS_BIG + 112 * MiB, WS_ZEVEN = WS_BIG + 176 * MiB;
constexpr size_t WS_RW = WS_TMP;
constexpr size_t RW_STRIDE = (size_t)M_TOK * 512;
constexpr size_t WS_YB = WS_TMP;
constexpr size_t WS_END = 596 * MiB;

constexpr int LDS_MAIN = 131072, LDS_BYTES = LDS_MAIN + 256;

DI float bf2f(unsigned short b) { return __uint_as_float((unsigned)b << 16); }
DI unsigned cvtpk(float lo, float hi) { f32x2 v = {lo, hi}; bf16x2_t b = __builtin_convertvector(v, bf16x2_t); return __builtin_bit_cast(unsigned, b); }
DI bf16_t f2bf(float f) { return (bf16_t)(cvtpk(f, 0.f) & 0xffffu); }
DI float wave_sum(float v) {
#pragma unroll
  for (int o = 1; o < 64; o <<= 1) v += __shfl_xor(v, o);
  return v;
}
DI float sigmoidf_(float x) { return __builtin_amdgcn_rcpf(1.f + __builtin_amdgcn_exp2f(-x * LOG2E)); }
DI float siluf_(float x) { return x * sigmoidf_(x); }
DI float tanhf_(float x) { return 2.f * sigmoidf_(2.f * x) - 1.f; }
DI void unpack8(const bf16x8 v, float (&f)[8]) {
#pragma unroll
  for (int e = 0; e < 8; ++e) f[e] = bf2f((unsigned short)v[e]);
}
#define MFMA16(a, b, c) __builtin_amdgcn_mfma_f32_16x16x32_bf16((a), (b), (c), 0, 0, 0)
typedef short v4i16_t __attribute__((ext_vector_type(4)));
DI s16x4 tr_read(const LAS unsigned char* p) { return __builtin_bit_cast(s16x4, __builtin_amdgcn_ds_read_tr16_b64_v4i16((LAS v4i16_t*)p)); }
DI bf16x8 comb8(s16x4 lo, s16x4 hi) { return __builtin_shufflevector(lo, hi, 0, 1, 2, 3, 4, 5, 6, 7); }
template <int CTRL> DI float dppf(float v) { return __builtin_bit_cast(float, __builtin_amdgcn_update_dpp(0, __builtin_bit_cast(int, v), CTRL, 0xF, 0xF, true)); }
DI float row16_sum(float v) {
  v += dppf<0xB1>(v); v += dppf<0x4E>(v); v += dppf<0x141>(v); v += dppf<0x140>(v); return v;
}

namespace pg8 {
constexpr int BM = 256, BK = 64, HALF = 128, HTB = HALF * BK * 2, STAGE_BYTES = 8 * HTB, NXCD = 8, WGM = 8;
__host__ __device__ __forceinline__ int lds_byte(int r, int c) { const int st = (r >> 4) * 2 + (c >> 5), rr = r & 15, cc = c & 31, ob = rr * 64 + cc * 2; return st * 1024 + (ob ^ (((ob >> 9) & 1) << 5)); }
__host__ __device__ __forceinline__ void stage_rc(int b, int& R, int& C) { const int st = b / 1024, sb = b % 1024, swz = sb ^ (((sb >> 9) & 1) << 5); R = (st >> 1) * 16 + swz / 64; C = (st & 1) * 32 + (swz % 64) / 2; }
__host__ __device__ __forceinline__ int perm32(int rho) { const int n = rho >> 4, i = rho & 15; return 8 * (i >> 2) + 4 * n + (i & 3); }
struct Unit { int pm, pn; };
struct Gemm { const bf16_t* A; const bf16_t* Bt; int M, N, K, lda, ldb; };
struct StaticOrder {
  int nM, nN, nwg, G, c;
  __device__ void init(int M, int N, int G_, int c_) { nM = M / BM; nN = N / BM; nwg = nM * nN; G = G_; c = c_; }
  __device__ bool next(int i, Unit& u) const {
    const long L = (long)i * G + c; if (L >= nwg) return false;
    int wgid = (int)L; { const int q = nwg / NXCD, r = nwg % NXCD, xcd = wgid % NXCD, off = wgid / NXCD; wgid = (xcd < r ? xcd * (q + 1) : r * (q + 1) + (xcd - r) * q) + off; }
    const int nig = WGM * nN, gid = wgid / nig, fm = gid * WGM, gsz = (nM - fm) < WGM ? (nM - fm) : WGM;
    u.pm = fm + ((wgid % nig) % gsz); u.pn = (wgid % nig) / gsz; return true;
  }
};
template <int MODE> struct Epi {
  static constexpr bool PERM = true;
  bf16_t* O; int ldc; const float* rs;
  DI void operator()(const f32x4 (&acc)[2][2][4][2], const Unit& u, int wr, int wc, int fr, int fq) const {
    const int row0 = u.pm * BM + wr * 64 + fr;
    if constexpr (MODE == 2) {
      const int col0 = u.pn * HALF + wc * 32 + 8 * fq;
#pragma unroll
      for (int ai = 0; ai < 2; ++ai)
#pragma unroll
        for (int m = 0; m < 4; ++m) {
          const int row = row0 + ai * HALF + m * 16; const float r = rs[row];
          f32x4 g0 = acc[ai][0][m][0] * r, g1 = acc[ai][0][m][1] * r, u0 = acc[ai][1][m][0] * r, u1 = acc[ai][1][m][1] * r;
          float h[8];
#pragma unroll
          for (int e = 0; e < 4; ++e) { h[e] = siluf_(g0[e]) * u0[e]; h[4 + e] = siluf_(g1[e]) * u1[e]; }
          u32x4 w; w.x = cvtpk(h[0], h[1]); w.y = cvtpk(h[2], h[3]); w.z = cvtpk(h[4], h[5]); w.w = cvtpk(h[6], h[7]);
          *(u32x4*)(O + (size_t)row * ldc + col0) = w;
        }
    } else {
      const int col0 = u.pn * BM + wc * 32 + 8 * fq;
#pragma unroll
      for (int ai = 0; ai < 2; ++ai)
#pragma unroll
        for (int m = 0; m < 4; ++m) {
          const int row = row0 + ai * HALF + m * 16; float r = 1.f; if constexpr (MODE == 1) r = rs[row];
          bf16_t* rowp = O + (size_t)row * ldc + col0;
#pragma unroll
          for (int bj = 0; bj < 2; ++bj) { f32x4 v0 = acc[ai][bj][m][0] * r, v1 = acc[ai][bj][m][1] * r;
            u32x4 w; w.x = cvtpk(v0[0], v0[1]); w.y = cvtpk(v0[2], v0[3]); w.z = cvtpk(v1[0], v1[1]); w.w = cvtpk(v1[2], v1[3]);
            *(u32x4*)(rowp + bj * HALF) = w; }
        }
    }
  }
};

struct EpiRT {
  static constexpr bool PERM = true;
  int mode; bf16_t* O; int ldc; const float* rs;
  DI void operator()(const f32x4 (&acc)[2][2][4][2], const Unit& u, int wr, int wc, int fr, int fq) const {
    if (mode == 2) { Epi<2> e{O, ldc, rs}; e(acc, u, wr, wc, fr, fq); }
    else if (mode == 1) { Epi<1> e{O, ldc, rs}; e(acc, u, wr, wc, fr, fq); }
    else { Epi<0> e{O, ldc, rs}; e(acc, u, wr, wc, fr, fq); }
  }
};

template <class EpiT>
DI void gemm_phase(LAS unsigned char* lds, const Gemm g, const StaticOrder& S, const EpiT& E) {
  const int tid = threadIdx.x, wid = __builtin_amdgcn_readfirstlane(tid >> 6), lane = tid & 63, wr = wid >> 2, wc = wid & 3, fr = lane & 15, fq = lane >> 4;
  const int K = g.K, nt = K / BK;
  unsigned voffA[2], voffB[2];
#pragma unroll
  for (int i = 0; i < 2; ++i) { int R, C; stage_rc(tid * 16 + i * 8192, R, C); const int Rb = EpiT::PERM ? ((R & ~31) + perm32(R & 31)) : R;
    voffA[i] = (unsigned)(R * g.lda + C) * 2u; voffB[i] = (unsigned)(Rb * g.ldb + C) * 2u; }
  const size_t kstep = (size_t)(BK * 2);
  const size_t hstepA = (size_t)HALF * g.lda * 2, hstepB = (size_t)HALF * g.ldb * 2;
  const size_t tstepA = 2 * hstepA, tstepB = 2 * hstepB;
  const unsigned ldsw = (unsigned)wid * 1024u;
  const int aoff = lds_byte(wr * 64 + fr, fq * 8), boff = lds_byte(wc * 32 + fr, fq * 8);
#define PG8_SA(b, h) (((b) * 2 + (h)) * HTB)
#define PG8_SB(b, h) ((4 + (b) * 2 + (h)) * HTB)
#define PG8_STAGE(bufoff, gbase, voff) do { _Pragma("unroll") for (int _i = 0; _i < 2; ++_i) \
    __builtin_amdgcn_global_load_lds((const unsigned*)((const char*)(gbase) + (voff)[_i]), (LAS unsigned*)(lds + (bufoff) + ldsw + _i * 8192), 16, 0, 0); } while (0)
#define PG8_LDA(dst, b, h) do { _Pragma("unroll") for (int m = 0; m < 4; ++m) _Pragma("unroll") for (int k = 0; k < 2; ++k) dst[m][k] = *(const LAS bf16x8*)(lds + PG8_SA(b, h) + aoff + m * 2048 + k * 1024); } while (0)
#define PG8_LDB(dst, b, h) do { _Pragma("unroll") for (int n = 0; n < 2; ++n) _Pragma("unroll") for (int k = 0; k < 2; ++k) dst[n][k] = *(const LAS bf16x8*)(lds + PG8_SB(b, h) + boff + n * 2048 + k * 1024); } while (0)
#define PG8_MMA(ai, bj, At, Bt) do { __builtin_amdgcn_s_setprio(1); _Pragma("unroll") for (int m = 0; m < 4; ++m) _Pragma("unroll") for (int n = 0; n < 2; ++n) _Pragma("unroll") for (int k = 0; k < 2; ++k) \
    acc[ai][bj][m][n] = __builtin_amdgcn_mfma_f32_16x16x32_bf16(Bt[n][k], At[m][k], acc[ai][bj][m][n], 0, 0, 0); __builtin_amdgcn_s_setprio(0); } while (0)
#define PG8_WAIT_V(n) asm volatile("s_waitcnt vmcnt(" #n ")" ::: "memory")
#define PG8_WAIT_L(n) asm volatile("s_waitcnt lgkmcnt(" #n ")" ::: "memory")
#define PG8_BAR __builtin_amdgcn_s_barrier()
#define PG8_SCHED __builtin_amdgcn_sched_barrier(0)
  Unit cur, nxt; int ui = 0;
  if (!S.next(0, cur)) return;
  f32x4 acc[2][2][4][2];
#pragma unroll
  for (int a = 0; a < 2; ++a)
#pragma unroll
    for (int b = 0; b < 2; ++b)
#pragma unroll
      for (int m = 0; m < 4; ++m)
#pragma unroll
        for (int n = 0; n < 2; ++n) acc[a][b][m][n] = (f32x4){0.f, 0.f, 0.f, 0.f};
  bf16x8 At[4][2], B0[2][2], B1[2][2];
  const char* cA = (const char*)g.A + (size_t)cur.pm * tstepA; const char* cB = (const char*)g.Bt + (size_t)cur.pn * tstepB;
  PG8_STAGE(PG8_SB(0, 0), cB, voffB); PG8_STAGE(PG8_SB(0, 1), cB + hstepB, voffB); PG8_STAGE(PG8_SA(0, 0), cA, voffA); PG8_STAGE(PG8_SA(0, 1), cA + hstepA, voffA);
  if (wr == 1) PG8_BAR;
  PG8_WAIT_V(2); PG8_BAR;
  PG8_STAGE(PG8_SB(1, 0), cB + kstep, voffB); PG8_STAGE(PG8_SA(1, 0), cA + kstep, voffA); PG8_STAGE(PG8_SB(1, 1), cB + hstepB + kstep, voffB);
  PG8_WAIT_V(6); PG8_BAR;
  for (;;) {
    const bool has_next = S.next(ui + 1, nxt);
    const char* nA = has_next ? (const char*)g.A + (size_t)nxt.pm * tstepA : cA; const char* nB = has_next ? (const char*)g.Bt + (size_t)nxt.pn * tstepB : cB;
    for (int t = 0; t < nt; t += 2) {
      const bool last = (t == nt - 2);
      const char* a1 = cA + (size_t)(t + 1) * kstep;
      const char* a2 = last ? nA : cA + (size_t)(t + 2) * kstep; const char* b2 = last ? nB : cB + (size_t)(t + 2) * kstep;
      const char* a3 = a2 + kstep; const char* b3 = b2 + kstep;
      PG8_LDB(B0, 0, 0); PG8_LDB(B1, 0, 1); PG8_SCHED; PG8_LDA(At, 0, 0); PG8_STAGE(PG8_SA(1, 1), a1 + hstepA, voffA);
      PG8_WAIT_V(8); PG8_WAIT_L(0); PG8_BAR; PG8_MMA(0, 0, At, B0); PG8_MMA(0, 1, At, B1); PG8_BAR; PG8_SCHED;
      PG8_LDA(At, 0, 1); PG8_STAGE(PG8_SB(0, 0), b2, voffB); PG8_STAGE(PG8_SB(0, 1), b2 + hstepB, voffB); PG8_STAGE(PG8_SA(0, 0), a2, voffA);
      PG8_WAIT_V(8); PG8_WAIT_L(0); PG8_BAR; PG8_MMA(1, 0, At, B0); PG8_MMA(1, 1, At, B1); PG8_BAR; PG8_SCHED;
      PG8_LDB(B0, 1, 0); PG8_LDB(B1, 1, 1); PG8_SCHED; PG8_LDA(At, 1, 0); PG8_STAGE(PG8_SA(0, 1), a2 + hstepA, voffA);
      PG8_WAIT_V(8); PG8_WAIT_L(0); PG8_BAR; PG8_MMA(0, 0, At, B0); PG8_MMA(0, 1, At, B1); PG8_BAR; PG8_SCHED;
      PG8_LDA(At, 1, 1); PG8_STAGE(PG8_SB(1, 0), b3, voffB); PG8_STAGE(PG8_SB(1, 1), b3 + hstepB, voffB); PG8_STAGE(PG8_SA(1, 0), a3, voffA);
      PG8_WAIT_V(8); PG8_WAIT_L(0); PG8_BAR; PG8_MMA(1, 0, At, B0); PG8_MMA(1, 1, At, B1); PG8_BAR; PG8_SCHED;
    }
    if (wr == 0) PG8_BAR;
    E(acc, cur, wr, wc, fr, fq);
    if (!has_next) break;
#pragma unroll
    for (int a = 0; a < 2; ++a)
#pragma unroll
      for (int b = 0; b < 2; ++b)
#pragma unroll
        for (int m = 0; m < 4; ++m)
#pragma unroll
          for (int n = 0; n < 2; ++n) acc[a][b][m][n] = (f32x4){0.f, 0.f, 0.f, 0.f};
    cur = nxt; cA = nA; cB = nB; ++ui;
    if (wr == 1) PG8_BAR;
  }
  PG8_WAIT_V(0);
  PG8_BAR;
#undef PG8_SA
#undef PG8_SB
#undef PG8_STAGE
#undef PG8_LDA
#undef PG8_LDB
#undef PG8_MMA
#undef PG8_WAIT_V
#undef PG8_WAIT_L
#undef PG8_BAR
#undef PG8_SCHED
}
}

struct Args { const float* in[18]; float* out; unsigned char* ws; int ph_lo, ph_hi; };
struct Ctx {
  LAS unsigned char* lds;
  int tid, lane, wave, G, bid, z;
  unsigned char* ws; float* out;
};
enum { IN_X = 0, IN_NORMS, IN_WGU, IN_WD, IN_EWIN, IN_EWOUT, IN_LAM, IN_SUBLN, IN_MU, IN_VEC, IN_WUP, IN_AUP, IN_GUP, IN_V0, IN_VDOWN, IN_VUP, IN_OWIN, IN_OWOUT };

DI void transpose_item(const float* W, int K, int N, bf16_t* WT, int mode, const float* gain, int sc_lo, int sc_hi, float sc, LAS float* scr, int item, int lane) {
  const int nblk = N / 32, kb = item / nblk, nb = item % nblk, k0 = 64 * kb, n0 = 32 * nb;
  const float cs = (n0 >= sc_lo && n0 < sc_hi) ? sc : 1.f;
#pragma unroll 8
  for (int i = 0; i < 32; ++i) { const int kk = 2 * i + (lane >> 5); const float gk = gain ? gain[k0 + kk] * cs : cs;
    scr[kk * 33 + (lane & 31)] = W[(size_t)(k0 + kk) * N + n0 + (lane & 31)] * gk; }
  asm volatile("s_waitcnt lgkmcnt(0)" ::: "memory");
  int d0 = n0;
  if (mode == 1) d0 = (n0 < DFF) ? 256 * (n0 / 128) + (n0 % 128) : 256 * ((n0 - DFF) / 128) + 128 + ((n0 - DFF) % 128);
  const int c = lane & 7;
#pragma unroll
  for (int j = 0; j < 4; ++j) { const int n = (lane >> 3) + 8 * j; const LAS float* s = scr + (8 * c) * 33 + n;
    u32x4 o; o.x = cvtpk(s[0 * 33], s[1 * 33]); o.y = cvtpk(s[2 * 33], s[3 * 33]); o.z = cvtpk(s[4 * 33], s[5 * 33]); o.w = cvtpk(s[6 * 33], s[7 * 33]);
    *(u32x4*)(WT + (size_t)(d0 + n) * K + k0 + 8 * c) = o; }
  asm volatile("s_waitcnt lgkmcnt(0)" ::: "memory");
}

DI void convert_layer(const Ctx& c, const Args& a, int L) {
  LAS float* scr = (LAS float*)(c.lds + c.wave * 16384);
  const int gw = c.bid * NWAVES + c.wave, NGW = c.G * NWAVES;
  const bool even = (L & 1) == 0; const int j = L >> 1;
  const float* norms = a.in[c.z + IN_NORMS] + (size_t)L * 6 * DM;
  const float* wgu0 = a.in[c.z + IN_WGU] + (size_t)(L * 2 + 0) * DM * 2 * DFF; const float* wgu1 = a.in[c.z + IN_WGU] + (size_t)(L * 2 + 1) * DM * 2 * DFF;
  const float* wd0 = a.in[c.z + IN_WD] + (size_t)(L * 2 + 0) * DFF * DM; const float* wd1 = a.in[c.z + IN_WD] + (size_t)(L * 2 + 1) * DFF * DM;
  const float* win = even ? a.in[c.z + IN_EWIN] + (size_t)j * DM * EVEN_IN : a.in[c.z + IN_OWIN] + (size_t)j * DM * ODD_IN;
  const float* wout = even ? a.in[c.z + IN_EWOUT] + (size_t)j * DM * DM : a.in[c.z + IN_OWOUT] + (size_t)j * 2048 * DM;
  const int NIN = even ? EVEN_IN : ODD_IN, KOUT = even ? DM : 2048;
  const int I_GU = (DM / 64) * (2 * DFF / 32), I_D = (DFF / 64) * (DM / 32), I_IN = (DM / 64) * (NIN / 32), I_OUT = (KOUT / 64) * (DM / 32);
  const int NIT = 2 * I_GU + 2 * I_D + I_IN + I_OUT;
  bf16_t* WGU0 = (bf16_t*)(c.ws + WS_WGU0); bf16_t* WGU1 = (bf16_t*)(c.ws + WS_WGU1); bf16_t* WD0 = (bf16_t*)(c.ws + WS_WD0); bf16_t* WD1 = (bf16_t*)(c.ws + WS_WD1);
  bf16_t* WIN = (bf16_t*)(c.ws + WS_WIN); bf16_t* WOUT = (bf16_t*)(c.ws + WS_WOUT);
  for (int it = gw; it < NIT; it += NGW) {
    int r = it;
    if (r < I_GU) { transpose_item(wgu0, DM, 2 * DFF, WGU0, 1, norms + 0 * DM, 0, 0, 1.f, scr, r, c.lane); continue; } r -= I_GU;
    if (r < I_GU) { transpose_item(wgu1, DM, 2 * DFF, WGU1, 1, norms + 4 * DM, 0, 0, 1.f, scr, r, c.lane); continue; } r -= I_GU;
    if (r < I_D) { transpose_item(wd0, DFF, DM, WD0, 0, nullptr, 0, 0, 1.f, scr, r, c.lane); continue; } r -= I_D;
    if (r < I_D) { transpose_item(wd1, DFF, DM, WD1, 0, nullptr, 0, 0, 1.f, scr, r, c.lane); continue; } r -= I_D;
    if (r < I_IN) { transpose_item(win, DM, NIN, WIN, 0, norms + 2 * DM, even ? 0 : 1024, even ? 0 : 2048, 0.0625f, scr, r, c.lane); continue; } r -= I_IN;
    transpose_item(wout, KOUT, DM, WOUT, 0, nullptr, 0, 0, 1.f, scr, r, c.lane);
  }
}

DI void rowpass(const Ctx& c, const float* xin, const bf16_t* F, const float* gain, float coef) {
  const int gw = c.bid * NWAVES + c.wave, NGW = c.G * NWAVES;
  bf16_t* XB = (bf16_t*)(c.ws + WS_XB); float* RINV = (float*)(c.ws + WS_RINV);
  f32x4 gv[4];
  if (F) {
#pragma unroll
    for (int j = 0; j < 4; ++j) gv[j] = *(const f32x4*)(gain + 256 * j + 4 * c.lane);
  }
  for (int row = gw; row < M_TOK; row += NGW) {
    const f32x4* xr = (const f32x4*)(xin + (size_t)row * DM) + c.lane;
    f32x4 v[4];
#pragma unroll
    for (int j = 0; j < 4; ++j) v[j] = xr[64 * j];
    if (F) {
      const u32x2* fr = (const u32x2*)(F + (size_t)row * DM) + c.lane;
      f32x4 f[4]; float ss = 0.f;
#pragma unroll
      for (int j = 0; j < 4; ++j) { const u32x2 w = fr[64 * j];
        f[j] = (f32x4){__uint_as_float(w.x << 16), __uint_as_float(w.x & 0xffff0000u), __uint_as_float(w.y << 16), __uint_as_float(w.y & 0xffff0000u)};
        ss += (f[j].x * f[j].x + f[j].y * f[j].y) + (f[j].z * f[j].z + f[j].w * f[j].w); }
      const float r = coef * __builtin_amdgcn_rsqf(wave_sum(ss) * (1.f / DM) + NORM_EPS);
#pragma unroll
      for (int j = 0; j < 4; ++j) v[j] = v[j] + f[j] * gv[j] * r;
    }
    float s2 = 0.f;
#pragma unroll
    for (int j = 0; j < 4; ++j) s2 += (v[j].x * v[j].x + v[j].y * v[j].y) + (v[j].z * v[j].z + v[j].w * v[j].w);
    s2 = wave_sum(s2);
    f32x4* xo = (f32x4*)(c.out + (size_t)row * DM) + c.lane;
    u32x2* xb = (u32x2*)(XB + (size_t)row * DM) + c.lane;
#pragma unroll
    for (int j = 0; j < 4; ++j) { xo[64 * j] = v[j]; u32x2 w; w.x = cvtpk(v[j].x, v[j].y); w.y = cvtpk(v[j].z, v[j].w); xb[64 * j] = w; }
    if (c.lane == 0) RINV[row] = __builtin_amdgcn_rsqf(s2 * (1.f / DM) + NORM_EPS);
  }
}

DI void rwkv_prep(const Ctx& c, const Args& a, int j) {
  const bf16_t* Z = (const bf16_t*)(c.ws + WS_ZEVEN);
  bf16_t* RW = (bf16_t*)(c.ws + WS_RW);
  bf16_t* VF = (bf16_t*)(c.ws + WS_VFIRST);
  const float* mu = a.in[c.z + IN_MU] + (size_t)j * 1792;
  const float* vec = a.in[c.z + IN_VEC] + (size_t)j * 7 * 512;
  const float* w_up = a.in[c.z + IN_WUP] + (size_t)j * 64 * 512;
  const float* a_up = a.in[c.z + IN_AUP] + (size_t)j * 64 * 512;
  const float* g_up = a.in[c.z + IN_GUP] + (size_t)j * 128 * 512;
  const bool vres = j > 0;
  const float* v0p = a.in[c.z + IN_V0] + (size_t)(j > 0 ? j - 1 : 0) * 512;
  const float* v_down = a.in[c.z + IN_VDOWN] + (size_t)(j > 0 ? j - 1 : 0) * 512 * 32;
  const float* v_up = a.in[c.z + IN_VUP] + (size_t)(j > 0 ? j - 1 : 0) * 32 * 512;
  LAS float* xs = (LAS float*)(c.lds);
  LAS float* vt = (LAS float*)(c.lds + 32768);
  LAS float* ut = (LAS float*)(c.lds + 98304);
  const int tid = c.tid, col = tid;
  const float mu_r = mu[col], mu_k = mu[512 + col], mu_v = mu[1024 + col];
  const float w0 = vec[col], a0 = vec[512 + col], k_k = vec[1024 + col], k_a = vec[1536 + col];
  for (int u = c.bid; u < M_TOK / 32; u += c.G) {
    const int t0 = u * 32; const bool first = (t0 % SEQ) == 0;
    __syncthreads();
    {
      const int cc = tid & 255, tg = tid >> 8; const float m = mu[1536 + cc];
      const int tb = t0 + tg * 16;
      float prev = (first && tg == 0) ? 0.f : bf2f(Z[(size_t)(tb - 1) * EVEN_IN + 3072 + cc]);
#pragma unroll 4
      for (int i = 0; i < 16; ++i) { const float cur = bf2f(Z[(size_t)(tb + i) * EVEN_IN + 3072 + cc]); const float zs = cur + (prev - cur) * m; prev = cur;
        const float val = cc < 64 ? tanhf_(zs) : (cc < 128 ? zs : sigmoidf_(zs)); xs[(tg * 16 + i) * 256 + cc] = val; }
    }
    __syncthreads();
#pragma unroll 1
    for (int hf = 0; hf < 2; ++hf) {
      float aw[16], aa[16], ag[16];
#pragma unroll
      for (int t = 0; t < 16; ++t) { aw[t] = 0.f; aa[t] = 0.f; ag[t] = 0.f; }
      const LAS float* xh = xs + hf * 16 * 256;
#pragma unroll 1
      for (int k = 0; k < 64; k += 4) {
        float ww[4], au[4];
#pragma unroll
        for (int e = 0; e < 4; ++e) { ww[e] = w_up[(size_t)(k + e) * 512 + col]; au[e] = a_up[(size_t)(k + e) * 512 + col]; }
#pragma unroll
        for (int t = 0; t < 16; ++t) { const f32x4 x1 = *(const LAS f32x4*)(xh + t * 256 + k); const f32x4 x2 = *(const LAS f32x4*)(xh + t * 256 + 64 + k);
          aw[t] += x1.x * ww[0] + x1.y * ww[1] + x1.z * ww[2] + x1.w * ww[3]; aa[t] += x2.x * au[0] + x2.y * au[1] + x2.z * au[2] + x2.w * au[3]; }
      }
#pragma unroll 1
      for (int k = 0; k < 128; k += 4) {
        float gg[4];
#pragma unroll
        for (int e = 0; e < 4; ++e) gg[e] = g_up[(size_t)(k + e) * 512 + col];
#pragma unroll
        for (int t = 0; t < 16; ++t) { const f32x4 x1 = *(const LAS f32x4*)(xh + t * 256 + 128 + k);
          ag[t] += x1.x * gg[0] + x1.y * gg[1] + x1.z * gg[2] + x1.w * gg[3]; }
      }
      const int tb = t0 + hf * 16;
      float pr, pk, pv;
      if (first && hf == 0) { pr = 0.f; pk = 0.f; pv = 0.f; }
      else { const bf16_t* zp = Z + (size_t)(tb - 1) * EVEN_IN + 1536 + col; pr = bf2f(zp[0]); pk = bf2f(zp[512]); pv = bf2f(zp[1024]); }
#pragma unroll
      for (int t = 0; t < 16; ++t) {
        const bf16_t* zp = Z + (size_t)(tb + t) * EVEN_IN + 1536 + col;
        const float cr = bf2f(zp[0]), ck = bf2f(zp[512]), cv = bf2f(zp[1024]);
        const float rr = cr + (pr - cr) * mu_r, kr = ck + (pk - ck) * mu_k, vv = cv + (pv - cv) * mu_v; pr = cr; pk = ck; pv = cv;
        const float ew = 0.60653065971f * sigmoidf_(w0 + aw[t]);
        const float av = sigmoidf_(a0 + aa[t]);
        const float kkr = kr * k_k; const float ss = wave_sum(kkr * kkr);
        const float kk = kkr / fmaxf(sqrtf(ss), 1e-12f);
        const float kmod = kr * (1.f + (av - 1.f) * k_a);
        const size_t o = (size_t)(tb + t) * 512 + col;
        RW[0 * RW_STRIDE + o] = f2bf(ew); RW[1 * RW_STRIDE + o] = f2bf(kk); RW[2 * RW_STRIDE + o] = f2bf(kk * av);
        RW[3 * RW_STRIDE + o] = f2bf(kmod); RW[4 * RW_STRIDE + o] = f2bf(rr); RW[6 * RW_STRIDE + o] = f2bf(ag[t]);
        if (!vres) { const bf16_t vb = f2bf(vv); RW[5 * RW_STRIDE + o] = vb; VF[o] = vb; }
        else vt[(hf * 16 + t) * 512 + col] = vv;
      }
    }
    if (vres) {
      __syncthreads();
      { const int t = tid >> 4, m2 = tid & 15; float u0 = 0.f, u1 = 0.f; const LAS float* vr = vt + t * 512;
#pragma unroll 4
        for (int q = 0; q < 512; ++q) { const float x = vr[q]; u0 += x * v_down[q * 32 + m2]; u1 += x * v_down[q * 32 + m2 + 16]; }
        ut[t * 32 + m2] = u0; ut[t * 32 + m2 + 16] = u1; }
      __syncthreads();
      float vu[32];
#pragma unroll
      for (int m = 0; m < 32; ++m) vu[m] = v_up[(size_t)m * 512 + col];
      const float v0c = v0p[col];
#pragma unroll 2
      for (int t = 0; t < 32; ++t) { float s = v0c;
#pragma unroll
        for (int m = 0; m < 32; ++m) s += ut[t * 32 + m] * vu[m];
        const float vv = vt[t * 512 + col]; const size_t o = (size_t)(t0 + t) * 512 + col; const float vf = bf2f(VF[o]);
        RW[5 * RW_STRIDE + o] = f2bf(vv + (vf - vv) * sigmoidf_(s)); }
    }
  }
}

DI void rwkv_scan_item(const Ctx& c, int item) {
  const int bh = item >> 1, half = item & 1, b = bh >> 3, h = bh & 7;
  const bf16_t* RW = (const bf16_t*)(c.ws + WS_RW);
  bf16_t* MIX = (bf16_t*)(c.ws + WS_MIXE);
  const int tid = c.tid, lane = c.lane, rg = lane >> 4, c4 = lane & 15, row = c.wave * 4 + rg;
  constexpr int BUF_F = 32 * 320 + 32 * 32;
  LAS float* buf0 = (LAS float*)c.lds;
  LAS float* ybuf = (LAS float*)c.lds + 2 * BUF_F;
  const size_t tokbase = (size_t)b * SEQ;
  const int i2 = tid & 255;
  const int l_step = i2 >> 3, l_c8 = i2 & 7, l_arr = tid >> 8;
  const bf16_t* src01 = RW + (size_t)l_arr * RW_STRIDE + (tokbase + l_step) * 512 + h * 64 + l_c8 * 8;
  const int vid = tid - 256;
  const bf16_t* srcv = RW + 5 * RW_STRIDE + (tokbase + ((vid >> 2) & 31)) * 512 + h * 64 + half * 32 + (vid & 3) * 8;
  bf16x8 p0, p1, p2;
  auto issue = [&](int ch) {
    const size_t off = (size_t)ch * 32 * 512;
    p0 = *(const bf16x8*)(src01 + off); p1 = *(const bf16x8*)(src01 + 2 * RW_STRIDE + off);
    if (tid < 256) p2 = *(const bf16x8*)(src01 + 4 * RW_STRIDE + off);
    else if (tid < 384) p2 = *(const bf16x8*)(srcv + off);
  };
  auto stash = [&](int bsel) {
    LAS float* B = buf0 + bsel * BUF_F;
    float f[8];
    { unpack8(p0, f); LAS float* d = B + l_step * 320 + l_arr * 64 + l_c8 * 8;
      if (l_arr == 0) {
#pragma unroll
        for (int e = 0; e < 8; ++e) f[e] = __builtin_amdgcn_exp2f(-f[e] * LOG2E);
      } else {
#pragma unroll
        for (int e = 0; e < 8; ++e) f[e] = -f[e];
      }
      *(LAS f32x4*)d = (f32x4){f[0], f[1], f[2], f[3]}; *(LAS f32x4*)(d + 4) = (f32x4){f[4], f[5], f[6], f[7]}; }
    { unpack8(p1, f); LAS float* d = B + l_step * 320 + (l_arr + 2) * 64 + l_c8 * 8;
      *(LAS f32x4*)d = (f32x4){f[0], f[1], f[2], f[3]}; *(LAS f32x4*)(d + 4) = (f32x4){f[4], f[5], f[6], f[7]}; }
    if (tid < 256) { unpack8(p2, f); LAS float* d = B + l_step * 320 + 4 * 64 + l_c8 * 8;
      *(LAS f32x4*)d = (f32x4){f[0], f[1], f[2], f[3]}; *(LAS f32x4*)(d + 4) = (f32x4){f[4], f[5], f[6], f[7]}; }
    else if (tid < 384) { unpack8(p2, f); LAS float* d = B + 32 * 320 + (vid >> 2) * 32 + (vid & 3) * 8;
      *(LAS f32x4*)d = (f32x4){f[0], f[1], f[2], f[3]}; *(LAS f32x4*)(d + 4) = (f32x4){f[4], f[5], f[6], f[7]}; }
  };
  __syncthreads();
  issue(0); stash(0);
  __syncthreads();
  f32x4 S = {0.f, 0.f, 0.f, 0.f};
#pragma unroll 1
  for (int ch = 0; ch < SEQ / 32; ++ch) {
    if (ch + 1 < SEQ / 32) issue(ch + 1);
    const LAS float* B = buf0 + (ch & 1) * BUF_F;
    LAS float* yb = ybuf + (ch & 1) * 1024;
#pragma unroll 4
    for (int s = 0; s < 32; ++s) {
      const LAS float* L = B + s * 320 + c4 * 4;
      const f32x4 dw = *(const LAS f32x4*)(L), nk = *(const LAS f32x4*)(L + 64), ka = *(const LAS f32x4*)(L + 128), kv = *(const LAS f32x4*)(L + 192), rv = *(const LAS f32x4*)(L + 256);
      const float vv = B[32 * 320 + s * 32 + row];
      float sa = (S.x * nk.x + S.y * nk.y) + (S.z * nk.z + S.w * nk.w);
      sa = row16_sum(sa);
      S = S * dw + kv * vv + ka * sa;
      float y = (S.x * rv.x + S.y * rv.y) + (S.z * rv.z + S.w * rv.w);
      y = row16_sum(y);
      if (c4 == 0) yb[s * 32 + row] = y;
    }
    if (ch + 1 < SEQ / 32) stash((ch + 1) & 1);
    __syncthreads();
    { const int s = tid >> 4, r2 = (tid & 15) * 2; const float y0 = yb[s * 32 + r2], y1 = yb[s * 32 + r2 + 1];
      *(unsigned*)(MIX + (tokbase + ch * 32 + s) * 1024 + 512 + h * 64 + half * 32 + r2) = cvtpk(y0, y1); }
  }
}

DI void attn_unit(const Ctx& c, const Args& a, int j, int b, int h, int c2, float lam, float lam_init) {
  const bf16_t* Z = (const bf16_t*)(c.ws + WS_ZEVEN) + (size_t)b * SEQ * EVEN_IN;
  bf16_t* MIX = (bf16_t*)(c.ws + WS_MIXE) + (size_t)b * SEQ * 1024;
  const float* subln = a.in[c.z + IN_SUBLN] + (size_t)j * 128;
  const int tid = c.tid, lane = c.lane, wave = c.wave, l15 = lane & 15, quad = lane >> 4, q_ = l15 >> 2, p_ = l15 & 3;
  const int q0 = 128 * c2 + 16 * wave, my_chunk = 2 * c2 + (wave >> 2), nkt = 2 * c2 + 2;
  constexpr int RS = 272, IMG = 64 * RS, BUFB = 2 * IMG;
  bf16x8 qf[2][2];
#pragma unroll
  for (int m = 0; m < 2; ++m)
#pragma unroll
    for (int ks = 0; ks < 2; ++ks) qf[m][ks] = *(const bf16x8*)(Z + (size_t)(q0 + l15) * EVEN_IN + h * 128 + m * 64 + ks * 32 + quad * 8);
  f32x4 o[2][8];
#pragma unroll
  for (int m = 0; m < 2; ++m)
#pragma unroll
    for (int d = 0; d < 8; ++d) o[m][d] = (f32x4){0.f, 0.f, 0.f, 0.f};
  float mrun[2] = {-1e30f, -1e30f}, lrun[2] = {0.f, 0.f};
  const float slope2 = __builtin_amdgcn_exp2f(-2.f * (float)(h + 1)) * LOG2E, sc2 = 0.125f * LOG2E;
  u32x4 pf[4];
  const int prow = tid >> 4, pc16 = tid & 15;
  const bf16_t* ksrc = Z + (size_t)prow * EVEN_IN + 512 + h * 128 + pc16 * 8;
  auto issue = [&](int kt) {
    const bf16_t* s = ksrc + (size_t)kt * 64 * EVEN_IN;
    pf[0] = *(const u32x4*)(s); pf[1] = *(const u32x4*)(s + (size_t)32 * EVEN_IN);
    pf[2] = *(const u32x4*)(s + 512); pf[3] = *(const u32x4*)(s + (size_t)32 * EVEN_IN + 512);
  };
  auto stash = [&](int bsel) {
    LAS unsigned char* B = c.lds + bsel * BUFB + prow * RS + pc16 * 16;
    *(LAS u32x4*)(B) = pf[0]; *(LAS u32x4*)(B + 32 * RS) = pf[1]; *(LAS u32x4*)(B + IMG) = pf[2]; *(LAS u32x4*)(B + IMG + 32 * RS) = pf[3];
  };
  issue(0); stash(0);
  __syncthreads();
#pragma unroll 1
  for (int kt = 0; kt < nkt; ++kt) {
    const bool has_next = kt + 1 < nkt;
    if (has_next) issue(kt + 1);
    if (kt <= my_chunk) {
      const LAS unsigned char* Kb = c.lds + (kt & 1) * BUFB; const LAS unsigned char* Vb = Kb + IMG;
      f32x4 s[2][4];
#pragma unroll
      for (int m = 0; m < 2; ++m)
#pragma unroll
        for (int t16 = 0; t16 < 4; ++t16) { f32x4 acc = {0.f, 0.f, 0.f, 0.f};
#pragma unroll
          for (int ks = 0; ks < 2; ++ks) { const bf16x8 kf = *(const LAS bf16x8*)(Kb + (16 * t16 + l15) * RS + (m * 64 + ks * 32 + quad * 8) * 2); acc = MFMA16(kf, qf[m][ks], acc); }
          s[m][t16] = acc; }
      const float dbase = (float)(q0 + l15 - 64 * kt - 4 * quad);
      bf16x8 pfr[2][2];
#pragma unroll
      for (int m = 0; m < 2; ++m) {
        float mx = -1e30f;
#pragma unroll
        for (int t16 = 0; t16 < 4; ++t16)
#pragma unroll
          for (int e = 0; e < 4; ++e) { const float d = __builtin_fabsf(dbase - (float)(16 * t16 + e)); const float v = s[m][t16][e] * sc2 - slope2 * d; s[m][t16][e] = v; mx = fmaxf(mx, v); }
        mx = fmaxf(mx, __shfl_xor(mx, 16)); mx = fmaxf(mx, __shfl_xor(mx, 32));
        const float mnew = fmaxf(mrun[m], mx), alpha = __builtin_amdgcn_exp2f(mrun[m] - mnew); mrun[m] = mnew;
        float ps = 0.f;
#pragma unroll
        for (int t16 = 0; t16 < 4; ++t16)
#pragma unroll
          for (int e = 0; e < 4; ++e) { const float p = __builtin_amdgcn_exp2f(s[m][t16][e] - mnew); s[m][t16][e] = p; ps += p; }
        lrun[m] = lrun[m] * alpha + ps;
#pragma unroll
        for (int d = 0; d < 8; ++d) o[m][d] = o[m][d] * alpha;
#pragma unroll
        for (int s2 = 0; s2 < 2; ++s2) { u32x4 w; w.x = cvtpk(s[m][2 * s2][0], s[m][2 * s2][1]); w.y = cvtpk(s[m][2 * s2][2], s[m][2 * s2][3]);
          w.z = cvtpk(s[m][2 * s2 + 1][0], s[m][2 * s2 + 1][1]); w.w = cvtpk(s[m][2 * s2 + 1][2], s[m][2 * s2 + 1][3]); pfr[m][s2] = __builtin_bit_cast(bf16x8, w); }
      }
#pragma unroll
      for (int s2 = 0; s2 < 2; ++s2)
#pragma unroll
        for (int d = 0; d < 8; ++d) {
          const LAS unsigned char* vp = Vb + (32 * s2 + 4 * quad + q_) * RS + (16 * d + 4 * p_) * 2;
          const bf16x8 vf = comb8(tr_read(vp), tr_read(vp + 16 * RS));
          o[0][d] = MFMA16(vf, pfr[0][s2], o[0][d]); o[1][d] = MFMA16(vf, pfr[1][s2], o[1][d]);
        }
    }
    if (has_next) stash((kt + 1) & 1);
    __syncthreads();
  }
  float inv[2];
#pragma unroll
  for (int m = 0; m < 2; ++m) { float l = lrun[m]; l += __shfl_xor(l, 16); l += __shfl_xor(l, 32); inv[m] = 1.f / l; }
  const float i1 = lam * inv[1];
  float ss = 0.f;
#pragma unroll
  for (int d = 0; d < 8; ++d)
#pragma unroll
    for (int e = 0; e < 4; ++e) { const float v = o[0][d][e] * inv[0] - o[1][d][e] * i1; o[0][d][e] = v; ss += v * v; }
  ss += __shfl_xor(ss, 16); ss += __shfl_xor(ss, 32);
  const float rn = __builtin_amdgcn_rsqf(ss * (1.f / 128.f) + NORM_EPS) * (1.f - lam_init);
  bf16_t* orow = MIX + (size_t)(q0 + l15) * 1024 + h * 128 + 4 * quad;
#pragma unroll
  for (int d = 0; d < 8; ++d) { const f32x4 g = *(const f32x4*)(subln + 16 * d + 4 * quad);
    u32x2 w; w.x = cvtpk(o[0][d][0] * rn * g.x, o[0][d][1] * rn * g.y); w.y = cvtpk(o[0][d][2] * rn * g.z, o[0][d][3] * rn * g.w);
    *(u32x2*)(orow + 16 * d) = w; }
}

DI void even_mixer(const Ctx& c, const Args& a, int j, int layer, unsigned* counter) {
  const float* lv = a.in[c.z + IN_LAM] + (size_t)j * 4 * 64;
  const float lam_init = 0.8f - 0.6f * __expf(-0.3f * (float)layer);
  const float d1 = wave_sum(lv[c.lane] * lv[64 + c.lane]), d2 = wave_sum(lv[128 + c.lane] * lv[192 + c.lane]);
  const float lam = __expf(d1) - __expf(d2) + lam_init;
  LAS int* qw = (LAS int*)(c.lds + LDS_MAIN + 64);
  constexpr int N_SCAN = 128, N_ATT = 8 * 4 * 32;
  for (;;) {
    __syncthreads();
    if (c.tid == 0) *qw = (int)atomicAdd(counter, 1u);
    __syncthreads();
    const int item = *qw;
    if (item >= N_SCAN + N_ATT) break;
#ifndef SKIP_SCAN
    if (item < N_SCAN) rwkv_scan_item(c, item);
    else
#endif
#ifndef SKIP_ATT
 { const int r = item - N_SCAN; const int c2 = 31 - (r >> 5), bh = r & 31; attn_unit(c, a, j, bh >> 2, bh & 3, c2, lam, lam_init); }
#endif
 ;
  }
}

DI void rwkv_post(const Ctx& c, const Args& a, int j) {
  const bf16_t* RW = (const bf16_t*)(c.ws + WS_RW);
  bf16_t* MIX = (bf16_t*)(c.ws + WS_MIXE);
  const float* vec = a.in[c.z + IN_VEC] + (size_t)j * 7 * 512;
  const int gw = c.bid * NWAVES + c.wave, NGW = c.G * NWAVES;
  for (int p = gw; p < M_TOK * 8; p += NGW) {
    const int t = p >> 3, h = p & 7, cc = h * 64 + c.lane; const size_t o = (size_t)t * 512 + cc;
    const float y = bf2f(MIX[(size_t)t * 1024 + 512 + cc]);
    const float r = bf2f(RW[4 * RW_STRIDE + o]), k = bf2f(RW[3 * RW_STRIDE + o]), v = bf2f(RW[5 * RW_STRIDE + o]), g = bf2f(RW[6 * RW_STRIDE + o]);
    const float mean = wave_sum(y) * (1.f / 64.f), d = y - mean, var = wave_sum(d * d) * (1.f / 64.f);
    const float yn = d * __builtin_amdgcn_rsqf(var + 64e-5f) * vec[5 * 512 + cc] + vec[6 * 512 + cc];
    const float bonus = wave_sum(r * k * vec[4 * 512 + cc]) * v;
    MIX[(size_t)t * 1024 + 512 + cc] = f2bf((yn + bonus) * g);
  }
}

DI void retention_unit(const Ctx& c, int bh, int slice) {
  const int b = bh >> 2, h = bh & 3;
  const bf16_t* Z = (const bf16_t*)(c.ws + WS_ZODD) + (size_t)b * SEQ * ODD_IN;
  bf16_t* YB = (bf16_t*)(c.ws + WS_YB) + (size_t)b * SEQ * 2048 + h * 512 + slice * 64;
  const int tid = c.tid, lane = c.lane, wave = c.wave, l15 = lane & 15, quad = lane >> 4, q_ = l15 >> 2, p_ = l15 & 3;
  constexpr int RQ = 528, RV = 144;
  LAS unsigned char* Qi = c.lds; LAS unsigned char* Ki = c.lds + 33792; LAS unsigned char* Vi = c.lds + 67584; LAS unsigned char* Vdi = c.lds + 76800;
  LAS unsigned char* Sci = c.lds + 86016; LAS unsigned char* Si = c.lds + 95232;
  const float log2g = __log2f(1.f - __builtin_amdgcn_exp2f(-5.f - (float)h));
  const float cd = __builtin_amdgcn_exp2f(log2g * 64.f);
  f32x4 st[2][4];
#pragma unroll
  for (int mt = 0; mt < 2; ++mt)
#pragma unroll
    for (int nt = 0; nt < 4; ++nt) st[mt][nt] = (f32x4){0.f, 0.f, 0.f, 0.f};
  u32x4 pq[4], pk[4], pv;
  const int prow = tid >> 5, pc = tid & 31;
  const bf16_t* qsrc = Z + (size_t)prow * ODD_IN + h * 256 + pc * 8;
  const int vrow = tid >> 3, vc = tid & 7;
  const bf16_t* vsrc = Z + (size_t)vrow * ODD_IN + 2048 + h * 512 + slice * 64 + vc * 8;
  auto issue = [&](int ch) {
    const size_t off = (size_t)ch * 64 * ODD_IN;
#pragma unroll
    for (int i = 0; i < 4; ++i) { pq[i] = *(const u32x4*)(qsrc + off + (size_t)(16 * i) * ODD_IN); pk[i] = *(const u32x4*)(qsrc + off + (size_t)(16 * i) * ODD_IN + 1024); }
    pv = *(const u32x4*)(vsrc + off);
  };
  auto stash = [&]() {
#pragma unroll
    for (int i = 0; i < 4; ++i) { *(LAS u32x4*)(Qi + (prow + 16 * i) * RQ + pc * 16) = pq[i]; *(LAS u32x4*)(Ki + (prow + 16 * i) * RQ + pc * 16) = pk[i]; }
    *(LAS u32x4*)(Vi + vrow * RV + vc * 16) = pv;
  };
  __syncthreads();
  issue(0);
  for (int i = tid; i < 33792 / 16; i += NTHR) *(LAS u32x4*)(Si + i * 16) = (u32x4){0u, 0u, 0u, 0u};
  stash();
  __syncthreads();
#pragma unroll 1
  for (int ch = 0; ch < 64; ++ch) {
    if (ch + 1 < 64) issue(ch + 1);
    {
      const int it = wave >> 1;
#pragma unroll
      for (int jj2 = 0; jj2 < 2; ++jj2) { const int jt = 2 * (wave & 1) + jj2; f32x4 acc = {0.f, 0.f, 0.f, 0.f};
#pragma unroll
        for (int ks = 0; ks < 8; ++ks) { const bf16x8 kf = *(const LAS bf16x8*)(Ki + (16 * jt + l15) * RQ + (32 * ks + 8 * quad) * 2);
          const bf16x8 qf = *(const LAS bf16x8*)(Qi + (16 * it + l15) * RQ + (32 * ks + 8 * quad) * 2); acc = MFMA16(kf, qf, acc); }
        const int i = 16 * it + l15, j0 = 16 * jt + 4 * quad; float v[4];
#pragma unroll
        for (int e = 0; e < 4; ++e) v[e] = acc[e] * __builtin_amdgcn_exp2f(log2g * __builtin_fabsf((float)(i - j0 - e)));
        u32x2 w; w.x = cvtpk(v[0], v[1]); w.y = cvtpk(v[2], v[3]); *(LAS u32x2*)(Sci + i * RV + j0 * 2) = w; }
      { const bf16x8 v8 = *(const LAS bf16x8*)(Vi + vrow * RV + vc * 16); float f[8]; unpack8(v8, f); const float kd = __builtin_amdgcn_exp2f(log2g * (float)(63 - vrow));
        u32x4 w; w.x = cvtpk(f[0] * kd, f[1] * kd); w.y = cvtpk(f[2] * kd, f[3] * kd); w.z = cvtpk(f[4] * kd, f[5] * kd); w.w = cvtpk(f[6] * kd, f[7] * kd);
        *(LAS u32x4*)(Vdi + vrow * RV + vc * 16) = w; }
    }
    __syncthreads();
    {
      const int et = wave >> 1;
#pragma unroll
      for (int ii = 0; ii < 2; ++ii) { const int it2 = 2 * (wave & 1) + ii; f32x4 acc = {0.f, 0.f, 0.f, 0.f};
#pragma unroll
        for (int ks = 0; ks < 8; ++ks) { const bf16x8 sf = *(const LAS bf16x8*)(Si + (16 * et + l15) * RQ + (32 * ks + 8 * quad) * 2);
          const bf16x8 qf = *(const LAS bf16x8*)(Qi + (16 * it2 + l15) * RQ + (32 * ks + 8 * quad) * 2); acc = MFMA16(sf, qf, acc); }
        const float qd = __builtin_amdgcn_exp2f(log2g * (float)(16 * it2 + l15 + 1)); acc = acc * qd;
#pragma unroll
        for (int s = 0; s < 2; ++s) { const LAS unsigned char* vp = Vi + (32 * s + 8 * quad + q_) * RV + (16 * et + 4 * p_) * 2;
          const bf16x8 vf = comb8(tr_read(vp), tr_read(vp + 4 * RV));
          const bf16x8 sc = *(const LAS bf16x8*)(Sci + (16 * it2 + l15) * RV + (32 * s + 8 * quad) * 2); acc = MFMA16(vf, sc, acc); }
        u32x2 w; w.x = cvtpk(acc[0], acc[1]); w.y = cvtpk(acc[2], acc[3]);
        *(u32x2*)(YB + (size_t)(ch * 64 + 16 * it2 + l15) * 2048 + 16 * et + 4 * quad) = w; }
#pragma unroll
      for (int mt = 0; mt < 2; ++mt)
#pragma unroll
        for (int nt = 0; nt < 4; ++nt) st[mt][nt] = st[mt][nt] * cd;
#pragma unroll
      for (int s = 0; s < 2; ++s) { bf16x8 vd[4];
#pragma unroll
        for (int nt = 0; nt < 4; ++nt) { const LAS unsigned char* vp = Vdi + (32 * s + 8 * quad + q_) * RV + (16 * nt + 4 * p_) * 2; vd[nt] = comb8(tr_read(vp), tr_read(vp + 4 * RV)); }
#pragma unroll
        for (int mt = 0; mt < 2; ++mt) { const LAS unsigned char* kp = Ki + (32 * s + 8 * quad + q_) * RQ + (32 * wave + 16 * mt + 4 * p_) * 2;
          const bf16x8 kf = comb8(tr_read(kp), tr_read(kp + 4 * RQ));
#pragma unroll
          for (int nt = 0; nt < 4; ++nt) st[mt][nt] = MFMA16(kf, vd[nt], st[mt][nt]); } }
    }
    __syncthreads();
#pragma unroll
    for (int mt = 0; mt < 2; ++mt)
#pragma unroll
      for (int nt = 0; nt < 4; ++nt) { u32x2 w; w.x = cvtpk(st[mt][nt][0], st[mt][nt][1]); w.y = cvtpk(st[mt][nt][2], st[mt][nt][3]);
        *(LAS u32x2*)(Si + (16 * nt + l15) * RQ + (32 * wave + 16 * mt + 4 * quad) * 2) = w; }
    if (ch + 1 < 64) stash();
    __syncthreads();
  }
}

DI void retention_post(const Ctx& c) {
  const bf16_t* YB = (const bf16_t*)(c.ws + WS_YB);
  bf16_t* Z = (bf16_t*)(c.ws + WS_ZODD);
  const int gw = c.bid * NWAVES + c.wave, NGW = c.G * NWAVES;
  for (int p = gw; p < M_TOK * 4; p += NGW) {
    const int t = p >> 2, h = p & 3;
    const bf16x8 y8 = *(const bf16x8*)(YB + (size_t)t * 2048 + h * 512 + c.lane * 8);
    bf16_t* gp = Z + (size_t)t * ODD_IN + 4096 + h * 512 + c.lane * 8;
    const bf16x8 g8 = *(const bf16x8*)gp;
    float y[8], g[8]; unpack8(y8, y); unpack8(g8, g);
    float ss = 0.f;
#pragma unroll
    for (int e = 0; e < 8; ++e) ss += y[e] * y[e];
    const float rn = __builtin_amdgcn_rsqf(wave_sum(ss) * (1.f / 512.f) + NORM_EPS);
#pragma unroll
    for (int e = 0; e < 8; ++e) y[e] = siluf_(g[e]) * y[e] * rn;
    u32x4 w; w.x = cvtpk(y[0], y[1]); w.y = cvtpk(y[2], y[3]); w.z = cvtpk(y[4], y[5]); w.w = cvtpk(y[6], y[7]);
    *(u32x4*)gp = w;
  }
}

enum { T_CONV = 0, T_GU_A, T_DOWN_A, T_ROW1, T_WIN, T_PREP, T_MIX, T_POST, T_WOUT, T_ROW3, T_GU_B, T_DOWN_B, T_RET, T_RETPOST, T_FINAL };
__global__ void __launch_bounds__(NTHR, 2) fwd_megakernel(Args args) {
  extern __shared__ __attribute__((aligned(16))) unsigned char lds_raw[];
  cg::grid_group grid = cg::this_grid();
  const int lo = args.ph_lo, hi = args.ph_hi;
#pragma unroll 1
  for (int ph = lo; ph < hi; ++ph) {
    Ctx c;
    { int tid = threadIdx.x, bid = blockIdx.x, G = gridDim.x, z = 0; unsigned char* ws = args.ws; float* out = args.out;
      asm volatile("" : "+v"(tid)); asm volatile("" : "+s"(bid), "+s"(G), "+s"(z)); asm volatile("" : "+s"(ws), "+s"(out));
      c.lds = (LAS unsigned char*)lds_raw; c.tid = tid; c.lane = tid & 63; c.wave = __builtin_amdgcn_readfirstlane(tid >> 6);
      c.G = G; c.bid = bid; c.z = z; c.ws = ws; c.out = out; }
    int L, k;
    if (ph < 12) { L = 0; k = ph; } else if (ph < 23) { L = 1; k = ph - 12; } else if (ph < 35) { L = 2; k = ph - 23; } else if (ph < 46) { L = 3; k = ph - 35; } else { L = 4; k = 0; }
    int type;
    if (L == 4) type = T_FINAL;
    else if ((L & 1) == 0) type = k;
    else type = (k <= 4) ? k : (k == 5 ? T_RET : (k == 6 ? T_RETPOST : k + 1));
    const bool even = (L & 1) == 0; const int j = L >> 1;
    const bool is_gemm = (type == T_GU_A || type == T_DOWN_A || type == T_WIN || type == T_WOUT || type == T_GU_B || type == T_DOWN_B);
    if (is_gemm) {
      pg8::Gemm g; pg8::EpiRT E;
      bf16_t* XB = (bf16_t*)(c.ws + WS_XB); bf16_t* F = (bf16_t*)(c.ws + WS_F); bf16_t* H = (bf16_t*)(c.ws + WS_H);
      const float* RINV = (const float*)(c.ws + WS_RINV);
      g.M = M_TOK;
      if (type == T_GU_A || type == T_GU_B) { g.A = XB; g.Bt = (const bf16_t*)(c.ws + (type == T_GU_A ? WS_WGU0 : WS_WGU1)); g.N = 2 * DFF; g.K = DM; g.lda = DM; g.ldb = DM; E.mode = 2; E.O = H; E.ldc = DFF; E.rs = RINV; }
      else if (type == T_DOWN_A || type == T_DOWN_B) { g.A = H; g.Bt = (const bf16_t*)(c.ws + (type == T_DOWN_A ? WS_WD0 : WS_WD1)); g.N = DM; g.K = DFF; g.lda = DFF; g.ldb = DFF; E.mode = 0; E.O = F; E.ldc = DM; E.rs = RINV; }
      else if (type == T_WIN) { const int NIN = even ? EVEN_IN : ODD_IN; g.A = XB; g.Bt = (const bf16_t*)(c.ws + WS_WIN); g.N = NIN; g.K = DM; g.lda = DM; g.ldb = DM; E.mode = 1; E.O = (bf16_t*)(c.ws + (even ? WS_ZEVEN : WS_ZODD)); E.ldc = NIN; E.rs = RINV; }
      else { if (even) { g.A = (const bf16_t*)(c.ws + WS_MIXE); g.K = DM; g.lda = DM; g.ldb = DM; } else { g.A = (const bf16_t*)(c.ws + WS_ZODD) + 4096; g.K = 2048; g.lda = ODD_IN; g.ldb = 2048; }
        g.Bt = (const bf16_t*)(c.ws + WS_WOUT); g.N = DM; E.mode = 0; E.O = F; E.ldc = DM; E.rs = RINV; }
      pg8::StaticOrder S; S.init(M_TOK, g.N, c.G, c.bid);
#ifndef SKIP_GEMM
      pg8::gemm_phase(c.lds, g, S, E);
#endif
    } else if (type == T_CONV || type == T_ROW1 || type == T_ROW3 || type == T_FINAL) {
      const float* xin = c.out; const bf16_t* F = (const bf16_t*)(c.ws + WS_F); const float* gain = nullptr; float coef = 0.5f;
      if (type == T_CONV) {
#ifndef SKIP_CONV
        convert_layer(c, args, L);
#endif
        if (L == 0) { xin = args.in[c.z + IN_X]; F = nullptr; } else gain = args.in[c.z + IN_NORMS] + (size_t)(L - 1) * 6 * DM + 5 * DM;
      } else if (type == T_ROW1) gain = args.in[c.z + IN_NORMS] + (size_t)L * 6 * DM + 1 * DM;
      else if (type == T_ROW3) { gain = args.in[c.z + IN_NORMS] + (size_t)L * 6 * DM + 3 * DM; coef = 1.0f; }
      else gain = args.in[c.z + IN_NORMS] + (size_t)3 * 6 * DM + 5 * DM;
#ifndef SKIP_ROW
      rowpass(c, xin, F, gain, coef);
#endif
    } else if (type == T_PREP) {
#ifndef SKIP_PREP
      rwkv_prep(c, args, j);
#endif
    } else if (type == T_MIX) {
#ifndef SKIP_MIX
      even_mixer(c, args, j, L, (unsigned*)(c.ws + WS_CTL) + 64 * j);
#endif
    } else if (type == T_POST) {
#ifndef SKIP_POST
      rwkv_post(c, args, j);
#endif
    } else if (type == T_RET) {
#ifndef SKIP_RET
      for (int u = c.bid; u < 256; u += c.G) retention_unit(c, u >> 3, u & 7);
#endif
    } else if (type == T_RETPOST) {
#ifndef SKIP_RETPOST
      retention_post(c);
#endif
    }
    if (ph + 1 < hi) grid.sync();
  }
}
constexpr int N_PHASES = 12 + 11 + 12 + 11 + 1;

extern "C" void kernel_launch(void* const* d_in, const int* in_sizes, int n_in, void* d_out, int out_size, void* d_ws, size_t ws_size, hipStream_t stream) {
  static int grid = 0;
  if (grid == 0) {
    if (n_in != 18 || out_size != M_TOK * DM || ws_size < WS_END) { fprintf(stderr, "kernel_launch: unexpected shapes (n_in %d, out %d, ws %zu, need %zu)\n", n_in, out_size, ws_size, (size_t)WS_END); grid = -1; return; }
    int dev = 0, cus = 0, per_cu = 0;
    hipGetDevice(&dev); hipDeviceGetAttribute(&cus, hipDeviceAttributeMultiprocessorCount, dev);
    if (hipFuncSetAttribute((const void*)fwd_megakernel, hipFuncAttributeMaxDynamicSharedMemorySize, LDS_BYTES) != hipSuccess) { fprintf(stderr, "kernel_launch: hipFuncSetAttribute failed\n"); grid = -1; return; }
    if (hipOccupancyMaxActiveBlocksPerMultiprocessor(&per_cu, (const void*)fwd_megakernel, NTHR, LDS_BYTES) != hipSuccess || per_cu < 1) { fprintf(stderr, "kernel_launch: occupancy query gives %d\n", per_cu); per_cu = 1; }
    (void)hipGetLastError();
    grid = cus * per_cu;
    if (grid > 256) grid = 256;
  }
  if (grid < 0) return;
  hipMemsetAsync((char*)d_ws + WS_CTL, 0, CTL_BYTES, stream);
  Args a{};
  for (int i = 0; i < 18; ++i) a.in[i] = (const float*)d_in[i];
  a.out = (float*)d_out; a.ws = (unsigned char*)d_ws;
#if MK_PER_PHASE
  for (int p = 0; p < N_PHASES; ++p) { a.ph_lo = p; a.ph_hi = p + 1; hipLaunchKernelGGL(fwd_megakernel, dim3(grid), dim3(NTHR), LDS_BYTES, stream, a); }
#else
  a.ph_lo = 0; a.ph_hi = N_PHASES;
  void* kargs[] = {&a};
  hipError_t e = hipLaunchCooperativeKernel((const void*)fwd_megakernel, dim3(grid), dim3(NTHR), kargs, LDS_BYTES, stream);
  if (e != hipSuccess) fprintf(stderr, "cooperative launch failed: %s (grid %d)\n", hipGetErrorString(e), grid);
#endif
}
```

```cpp
#include <hip/hip_runtime.h>
#include <hip/hip_cooperative_groups.h>
#include <cstdio>
#include <cstdint>
namespace cg = cooperative_groups;

#define LAS __attribute__((address_space(3)))
#define DI __device__ __forceinline__
typedef unsigned short bf16_t;
typedef short bf16x8 __attribute__((ext_vector_type(8)));
typedef short s16x4 __attribute__((ext_vector_type(4)));
typedef float f32x4 __attribute__((ext_vector_type(4)));
typedef float f32x2 __attribute__((ext_vector_type(2)));
typedef unsigned u32x4 __attribute__((ext_vector_type(4)));
typedef unsigned u32x2 __attribute__((ext_vector_type(2)));
typedef __bf16 bf16x2_t __attribute__((ext_vector_type(2)));

#ifndef DUP_MASK
#define DUP_MASK 0
#endif
#ifndef MK_PER_PHASE
#define MK_PER_PHASE 0
#endif

constexpr int M_TOK = 32768, SEQ = 4096, DM = 1024, DFF = 2816, NWAVES = 8, NTHR = 512;
constexpr int EVEN_IN = 3328, ODD_IN = 6144;
constexpr float NORM_EPS = 1e-6f;
constexpr float LOG2E = 1.4426950408889634f;

constexpr size_t MiB = 1u << 20;
constexpr size_t WS_CTL = 0, CTL_BYTES = 4096;
constexpr size_t WS_RINV = 1 * MiB;
constexpr size_t WS_WGU0 = 2 * MiB, WS_WD0 = 13 * MiB, WS_WIN = 19 * MiB, WS_WOUT = 31 * MiB, WS_WGU1 = 35 * MiB, WS_WD1 = 46 * MiB;
constexpr size_t WS_LORA = 51 * MiB + 512 * 1024;
constexpr size_t WS_VFIRST = 52 * MiB;
constexpr size_t WS_TMP = 84 * MiB;
constexpr size_t WS_XB = WS_TMP, WS_F = WS_TMP + 64 * MiB;
constexpr size_t WS_BIG = 212 * MiB;
constexpr size_t WS_H = WS_BIG, WS_ZODD = WS_BIG, WS_MIXE = WS_BIG + 112 * MiB, WS_ZEVEN = WS_BIG + 176 * MiB;
constexpr size_t WS_RW = WS_TMP;
constexpr size_t RW_STRIDE = (size_t)M_TOK * 512;
constexpr size_t WS_YB = WS_TMP;
constexpr size_t WS_END = 596 * MiB;

constexpr int LDS_MAIN = 131072, LDS_BYTES = LDS_MAIN + 256;

DI float bf2f(unsigned short b) { return __uint_as_float((unsigned)b << 16); }
DI unsigned cvtpk(float lo, float hi) { f32x2 v = {lo, hi}; bf16x2_t b = __builtin_convertvector(v, bf16x2_t); return __builtin_bit_cast(unsigned, b); }
DI bf16_t f2bf(float f) { return (bf16_t)(cvtpk(f, 0.f) & 0xffffu); }
DI float wave_sum(float v) {
#pragma unroll
  for (int o = 1; o < 64; o <<= 1) v += __shfl_xor(v, o);
  return v;
}
DI float sigmoidf_(float x) { return __builtin_amdgcn_rcpf(1.f + __builtin_amdgcn_exp2f(-x * LOG2E)); }
DI float siluf_(float x) { return x * sigmoidf_(x); }
DI float tanhf_(float x) { return 2.f * sigmoidf_(2.f * x) - 1.f; }
DI void unpack8(const bf16x8 v, float (&f)[8]) {
#pragma unroll
  for (int e = 0; e < 8; ++e) f[e] = bf2f((unsigned short)v[e]);
}
#define MFMA16(a, b, c) __builtin_amdgcn_mfma_f32_16x16x32_bf16((a), (b), (c), 0, 0, 0)
typedef short v4i16_t __attribute__((ext_vector_type(4)));
DI s16x4 tr_read(const LAS unsigned char* p) { return __builtin_bit_cast(s16x4, __builtin_amdgcn_ds_read_tr16_b64_v4i16((LAS v4i16_t*)p)); }
DI bf16x8 comb8(s16x4 lo, s16x4 hi) { return __builtin_shufflevector(lo, hi, 0, 1, 2, 3, 4, 5, 6, 7); }
template <int CTRL> DI float dppf(float v) { return __builtin_bit_cast(float, __builtin_amdgcn_update_dpp(0, __builtin_bit_cast(int, v), CTRL, 0xF, 0xF, true)); }
DI float row16_sum(float v) {
  v += dppf<0xB1>(v); v += dppf<0x4E>(v); v += dppf<0x141>(v); v += dppf<0x140>(v); return v;
}

namespace pg8 {
constexpr int BM = 256, BK = 64, HALF = 128, HTB = HALF * BK * 2, STAGE_BYTES = 8 * HTB, NXCD = 8, WGM = 8;
__host__ __device__ __forceinline__ int lds_byte(int r, int c) { const int st = (r >> 4) * 2 + (c >> 5), rr = r & 15, cc = c & 31, ob = rr * 64 + cc * 2; return st * 1024 + (ob ^ (((ob >> 9) & 1) << 5)); }
__host__ __device__ __forceinline__ void stage_rc(int b, int& R, int& C) { const int st = b / 1024, sb = b % 1024, swz = sb ^ (((sb >> 9) & 1) << 5); R = (st >> 1) * 16 + swz / 64; C = (st & 1) * 32 + (swz % 64) / 2; }
__host__ __device__ __forceinline__ int perm32(int rho) { const int n = rho >> 4, i = rho & 15; return 8 * (i >> 2) + 4 * n + (i & 3); }
struct Unit { int pm, pn; };
struct Gemm { const bf16_t* A; const bf16_t* Bt; int M, N, K, lda, ldb; };
struct StaticOrder {
  int nM, nN, nwg, G, c;
  __device__ void init(int M, int N, int G_, int c_) { nM = M / BM; nN = N / BM; nwg = nM * nN; G = G_; c = c_; }
  __device__ bool next(int i, Unit& u) const {
    const long L = (long)i * G + c; if (L >= nwg) return false;
    int wgid = (int)L; { const int q = nwg / NXCD, r = nwg % NXCD, xcd = wgid % NXCD, off = wgid / NXCD; wgid = (xcd < r ? xcd * (q + 1) : r * (q + 1) + (xcd - r) * q) + off; }
    const int nig = WGM * nN, gid = wgid / nig, fm = gid * WGM, gsz = (nM - fm) < WGM ? (nM - fm) : WGM;
    u.pm = fm + ((wgid % nig) % gsz); u.pn = (wgid % nig) / gsz; return true;
  }
};
template <int MODE> struct Epi {
  static constexpr bool PERM = true;
  bf16_t* O; int ldc; const float* rs;
  DI void operator()(const f32x4 (&acc)[2][2][4][2], const Unit& u, int wr, int wc, int fr, int fq) const {
    const int row0 = u.pm * BM + wr * 64 + fr;
    if constexpr (MODE == 2) {
      const int col0 = u.pn * HALF + wc * 32 + 8 * fq;
#pragma unroll
      for (int ai = 0; ai < 2; ++ai)
#pragma unroll
        for (int m = 0; m < 4; ++m) {
          const int row = row0 + ai * HALF + m * 16; const float r = rs[row];
          f32x4 g0 = acc[ai][0][m][0] * r, g1 = acc[ai][0][m][1] * r, u0 = acc[ai][1][m][0] * r, u1 = acc[ai][1][m][1] * r;
          float h[8];
#pragma unroll
          for (int e = 0; e < 4; ++e) { h[e] = siluf_(g0[e]) * u0[e]; h[4 + e] = siluf_(g1[e]) * u1[e]; }
          u32x4 w; w.x = cvtpk(h[0], h[1]); w.y = cvtpk(h[2], h[3]); w.z = cvtpk(h[4], h[5]); w.w = cvtpk(h[6], h[7]);
          *(u32x4*)(O + (size_t)row * ldc + col0) = w;
        }
    } else {
      const int col0 = u.pn * BM + wc * 32 + 8 * fq;
#pragma unroll
      for (int ai = 0; ai < 2; ++ai)
#pragma unroll
        for (int m = 0; m < 4; ++m) {
          const int row = row0 + ai * HALF + m * 16; float r = 1.f; if constexpr (MODE == 1) r = rs[row];
          bf16_t* rowp = O + (size_t)row * ldc + col0;
#pragma unroll
          for (int bj = 0; bj < 2; ++bj) { f32x4 v0 = acc[ai][bj][m][0] * r, v1 = acc[ai][bj][m][1] * r;
            u32x4 w; w.x = cvtpk(v0[0], v0[1]); w.y = cvtpk(v0[2], v0[3]); w.z = cvtpk(v1[0], v1[1]); w.w = cvtpk(v1[2], v1[3]);
            *(u32x4*)(rowp + bj * HALF) = w; }
        }
    }
  }
};

struct EpiRT {
  static constexpr bool PERM = true;
  int mode; bf16_t* O; int ldc; const float* rs;
  DI void operator()(const f32x4 (&acc)[2][2][4][2], const Unit& u, int wr, int wc, int fr, int fq) const {
    if (mode == 2) { Epi<2> e{O, ldc, rs}; e(acc, u, wr, wc, fr, fq); }
    else if (mode == 1) { Epi<1> e{O, ldc, rs}; e(acc, u, wr, wc, fr, fq); }
    else { Epi<0> e{O, ldc, rs}; e(acc, u, wr, wc, fr, fq); }
  }
};

template <class EpiT>
DI void gemm_phase(LAS unsigned char* lds, const Gemm g, const StaticOrder& S, const EpiT& E) {
  const int tid = threadIdx.x, wid = __builtin_amdgcn_readfirstlane(tid >> 6), lane = tid & 63, wr = wid >> 2, wc = wid & 3, fr = lane & 15, fq = lane >> 4;
  const int K = g.K, nt = K / BK;
  unsigned voffA[2], voffB[2];
#pragma unroll
  for (int i = 0; i < 2; ++i) { int R, C; stage_rc(tid * 16 + i * 8192, R, C); const int Rb = EpiT::PERM ? ((R & ~31) + perm32(R & 31)) : R;
    voffA[i] = (unsigned)(R * g.lda + C) * 2u; voffB[i] = (unsigned)(Rb * g.ldb + C) * 2u; }
  const size_t kstep = (size_t)(BK * 2);
  const size_t hstepA = (size_t)HALF * g.lda * 2, hstepB = (size_t)HALF * g.ldb * 2;
  const size_t tstepA = 2 * hstepA, tstepB = 2 * hstepB;
  const unsigned ldsw = (unsigned)wid * 1024u;
  const int aoff = lds_byte(wr * 64 + fr, fq * 8), boff = lds_byte(wc * 32 + fr, fq * 8);
#define PG8_SA(b, h) (((b) * 2 + (h)) * HTB)
#define PG8_SB(b, h) ((4 + (b) * 2 + (h)) * HTB)
#define PG8_STAGE(bufoff, gbase, voff) do { _Pragma("unroll") for (int _i = 0; _i < 2; ++_i) \
    __builtin_amdgcn_global_load_lds((const unsigned*)((const char*)(gbase) + (voff)[_i]), (LAS unsigned*)(lds + (bufoff) + ldsw + _i * 8192), 16, 0, 0); } while (0)
#define PG8_LDA(dst, b, h) do { _Pragma("unroll") for (int m = 0; m < 4; ++m) _Pragma("unroll") for (int k = 0; k < 2; ++k) dst[m][k] = *(const LAS bf16x8*)(lds + PG8_SA(b, h) + aoff + m * 2048 + k * 1024); } while (0)
#define PG8_LDB(dst, b, h) do { _Pragma("unroll") for (int n = 0; n < 2; ++n) _Pragma("unroll") for (int k = 0; k < 2; ++k) dst[n][k] = *(const LAS bf16x8*)(lds + PG8_SB(b, h) + boff + n * 2048 + k * 1024); } while (0)
#define PG8_MMA(ai, bj, At, Bt) do { __builtin_amdgcn_s_setprio(1); _Pragma("unroll") for (int m = 0; m < 4; ++m) _Pragma("unroll") for (int n = 0; n < 2; ++n) _Pragma("unroll") for (int k = 0; k < 2; ++k) \
    acc[ai][bj][m][n] = __builtin_amdgcn_mfma_f32_16x16x32_bf16(Bt[n][k], At[m][k], acc[ai][bj][m][n], 0, 0, 0); __builtin_amdgcn_s_setprio(0); } while (0)
#define PG8_WAIT_V(n) asm volatile("s_waitcnt vmcnt(" #n ")" ::: "memory")
#define PG8_WAIT_L(n) asm volatile("s_waitcnt lgkmcnt(" #n ")" ::: "memory")
#define PG8_BAR __builtin_amdgcn_s_barrier()
#define PG8_SCHED __builtin_amdgcn_sched_barrier(0)
  Unit cur, nxt; int ui = 0;
  if (!S.next(0, cur)) return;
  f32x4 acc[2][2][4][2];
#pragma unroll
  for (int a = 0; a < 2; ++a)
#pragma unroll
    for (int b = 0; b < 2; ++b)
#pragma unroll
      for (int m = 0; m < 4; ++m)
#pragma unroll
        for (int n = 0; n < 2; ++n) acc[a][b][m][n] = (f32x4){0.f, 0.f, 0.f, 0.f};
  bf16x8 At[4][2], B0[2][2], B1[2][2];
  const char* cA = (const char*)g.A + (size_t)cur.pm * tstepA; const char* cB = (const char*)g.Bt + (size_t)cur.pn * tstepB;
  PG8_STAGE(PG8_SB(0, 0), cB, voffB); PG8_STAGE(PG8_SB(0, 1), cB + hstepB, voffB); PG8_STAGE(PG8_SA(0, 0), cA, voffA); PG8_STAGE(PG8_SA(0, 1), cA + hstepA, voffA);
  if (wr == 1) PG8_BAR;
  PG8_WAIT_V(2); PG8_BAR;
  PG8_STAGE(PG8_SB(1, 0), cB + kstep, voffB); PG8_STAGE(PG8_SA(1, 0), cA + kstep, voffA); PG8_STAGE(PG8_SB(1, 1), cB + hstepB + kstep, voffB);
  PG8_WAIT_V(6); PG8_BAR;
  for (;;) {
    const bool has_next = S.next(ui + 1, nxt);
    const char* nA = has_next ? (const char*)g.A + (size_t)nxt.pm * tstepA : cA; const char* nB = has_next ? (const char*)g.Bt + (size_t)nxt.pn * tstepB : cB;
    for (int t = 0; t < nt; t += 2) {
      const bool last = (t == nt - 2);
      const char* a1 = cA + (size_t)(t + 1) * kstep;
      const char* a2 = last ? nA : cA + (size_t)(t + 2) * kstep; const char* b2 = last ? nB : cB + (size_t)(t + 2) * kstep;
      const char* a3 = a2 + kstep; const char* b3 = b2 + kstep;
      PG8_LDB(B0, 0, 0); PG8_LDB(B1, 0, 1); PG8_SCHED; PG8_LDA(At, 0, 0); PG8_STAGE(PG8_SA(1, 1), a1 + hstepA, voffA);
      PG8_WAIT_V(8); PG8_WAIT_L(0); PG8_BAR; PG8_MMA(0, 0, At, B0); PG8_MMA(0, 1, At, B1); PG8_BAR; PG8_SCHED;
      PG8_LDA(At, 0, 1); PG8_STAGE(PG8_SB(0, 0), b2, voffB); PG8_STAGE(PG8_SB(0, 1), b2 + hstepB, voffB); PG8_STAGE(PG8_SA(0, 0), a2, voffA);
      PG8_WAIT_V(8); PG8_WAIT_L(0); PG8_BAR; PG8_MMA(1, 0, At, B0); PG8_MMA(1, 1, At, B1); PG8_BAR; PG8_SCHED;
      PG8_LDB(B0, 1, 0); PG8_LDB(B1, 1, 1); PG8_SCHED; PG8_LDA(At, 1, 0); PG8_STAGE(PG8_SA(0, 1), a2 + hstepA, voffA);
      PG8_WAIT_V(8); PG8_WAIT_L(0); PG8_BAR; PG8_MMA(0, 0, At, B0); PG8_MMA(0, 1, At, B1); PG8_BAR; PG8_SCHED;
      PG8_LDA(At, 1, 1); PG8_STAGE(PG8_SB(1, 0), b3, voffB); PG8_STAGE(PG8_SB(1, 1), b3 + hstepB, voffB); PG8_STAGE(PG8_SA(1, 0), a3, voffA);
      PG8_WAIT_V(8); PG8_WAIT_L(0); PG8_BAR; PG8_MMA(1, 0, At, B0); PG8_MMA(1, 1, At, B1); PG8_BAR; PG8_SCHED;
    }
    if (wr == 0) PG8_BAR;
    E(acc, cur, wr, wc, fr, fq);
    if (!has_next) break;
#pragma unroll
    for (int a = 0; a < 2; ++a)
#pragma unroll
      for (int b = 0; b < 2; ++b)
#pragma unroll
        for (int m = 0; m < 4; ++m)
#pragma unroll
          for (int n = 0; n < 2; ++n) acc[a][b][m][n] = (f32x4){0.f, 0.f, 0.f, 0.f};
    cur = nxt; cA = nA; cB = nB; ++ui;
    if (wr == 1) PG8_BAR;
  }
  PG8_WAIT_V(0);
  PG8_BAR;
#undef PG8_SA
#undef PG8_SB
#undef PG8_STAGE
#undef PG8_LDA
#undef PG8_LDB
#undef PG8_MMA
#undef PG8_WAIT_V
#undef PG8_WAIT_L
#undef PG8_BAR
#undef PG8_SCHED
}
}

struct Args { const float* in[18]; float* out; unsigned char* ws; int ph_lo, ph_hi; };
struct Ctx {
  LAS unsigned char* lds;
  int tid, lane, wave, G, bid, z;
  unsigned char* ws; float* out;
};
enum { IN_X = 0, IN_NORMS, IN_WGU, IN_WD, IN_EWIN, IN_EWOUT, IN_LAM, IN_SUBLN, IN_MU, IN_VEC, IN_WUP, IN_AUP, IN_GUP, IN_V0, IN_VDOWN, IN_VUP, IN_OWIN, IN_OWOUT };

DI void transpose_item(const float* W, int K, int N, bf16_t* WT, int mode, const float* gain, int sc_lo, int sc_hi, float sc, LAS float* scr, int item, int lane) {
  const int nblk = N / 32, kb = item / nblk, nb = item % nblk, k0 = 64 * kb, n0 = 32 * nb;
  const float cs = (n0 >= sc_lo && n0 < sc_hi) ? sc : 1.f;
#pragma unroll 8
  for (int i = 0; i < 32; ++i) { const int kk = 2 * i + (lane >> 5); const float gk = gain ? gain[k0 + kk] * cs : cs;
    scr[kk * 33 + (lane & 31)] = W[(size_t)(k0 + kk) * N + n0 + (lane & 31)] * gk; }
  asm volatile("s_waitcnt lgkmcnt(0)" ::: "memory");
  int d0 = n0;
  if (mode == 1) d0 = (n0 < DFF) ? 256 * (n0 / 128) + (n0 % 128) : 256 * ((n0 - DFF) / 128) + 128 + ((n0 - DFF) % 128);
  const int c = lane & 7;
#pragma unroll
  for (int j = 0; j < 4; ++j) { const int n = (lane >> 3) + 8 * j; const LAS float* s = scr + (8 * c) * 33 + n;
    u32x4 o; o.x = cvtpk(s[0 * 33], s[1 * 33]); o.y = cvtpk(s[2 * 33], s[3 * 33]); o.z = cvtpk(s[4 * 33], s[5 * 33]); o.w = cvtpk(s[6 * 33], s[7 * 33]);
    *(u32x4*)(WT + (size_t)(d0 + n) * K + k0 + 8 * c) = o; }
  asm volatile("s_waitcnt lgkmcnt(0)" ::: "memory");
}

DI void convert_layer(const Ctx& c, const Args& a, int L) {
  LAS float* scr = (LAS float*)(c.lds + c.wave * 16384);
  const int gw = c.bid * NWAVES + c.wave, NGW = c.G * NWAVES;
  const bool even = (L & 1) == 0; const int j = L >> 1;
  const float* norms = a.in[c.z + IN_NORMS] + (size_t)L * 6 * DM;
  const float* wgu0 = a.in[c.z + IN_WGU] + (size_t)(L * 2 + 0) * DM * 2 * DFF; const float* wgu1 = a.in[c.z + IN_WGU] + (size_t)(L * 2 + 1) * DM * 2 * DFF;
  const float* wd0 = a.in[c.z + IN_WD] + (size_t)(L * 2 + 0) * DFF * DM; const float* wd1 = a.in[c.z + IN_WD] + (size_t)(L * 2 + 1) * DFF * DM;
  const float* win = even ? a.in[c.z + IN_EWIN] + (size_t)j * DM * EVEN_IN : a.in[c.z + IN_OWIN] + (size_t)j * DM * ODD_IN;
  const float* wout = even ? a.in[c.z + IN_EWOUT] + (size_t)j * DM * DM : a.in[c.z + IN_OWOUT] + (size_t)j * 2048 * DM;
  const int NIN = even ? EVEN_IN : ODD_IN, KOUT = even ? DM : 2048;
  const int I_GU = (DM / 64) * (2 * DFF / 32), I_D = (DFF / 64) * (DM / 32), I_IN = (DM / 64) * (NIN / 32), I_OUT = (KOUT / 64) * (DM / 32);
  const int NIT = 2 * I_GU + 2 * I_D + I_IN + I_OUT;
  bf16_t* WGU0 = (bf16_t*)(c.ws + WS_WGU0); bf16_t* WGU1 = (bf16_t*)(c.ws + WS_WGU1); bf16_t* WD0 = (bf16_t*)(c.ws + WS_WD0); bf16_t* WD1 = (bf16_t*)(c.ws + WS_WD1);
  bf16_t* WIN = (bf16_t*)(c.ws + WS_WIN); bf16_t* WOUT = (bf16_t*)(c.ws + WS_WOUT);
  if (even) {
    bf16_t* WUPT = (bf16_t*)(c.ws + WS_LORA); bf16_t* AUPT = WUPT + 512 * 64; bf16_t* GUPT = AUPT + 512 * 64; bf16_t* VDT = GUPT + 512 * 128; bf16_t* VUPT = VDT + 32 * 512;
    const float* w_up = a.in[c.z + IN_WUP] + (size_t)j * 64 * 512; const float* a_up = a.in[c.z + IN_AUP] + (size_t)j * 64 * 512; const float* g_up = a.in[c.z + IN_GUP] + (size_t)j * 128 * 512;
    const int NS = 16 + 16 + 32 + (j > 0 ? 8 : 0);
    for (int it = gw; it < NS; it += NGW) {
      int r = it;
      if (r < 16) { transpose_item(w_up, 64, 512, WUPT, 0, nullptr, 0, 0, 1.f, scr, r, c.lane); continue; } r -= 16;
      if (r < 16) { transpose_item(a_up, 64, 512, AUPT, 0, nullptr, 0, 0, 1.f, scr, r, c.lane); continue; } r -= 16;
      if (r < 32) { transpose_item(g_up, 128, 512, GUPT, 0, nullptr, 0, 0, 1.f, scr, r, c.lane); continue; } r -= 32;
      transpose_item(a.in[c.z + IN_VDOWN] + (size_t)(j - 1) * 512 * 32, 512, 32, VDT, 0, nullptr, 0, 0, 1.f, scr, r, c.lane);
    }
    if (j > 0) { const float* v_up = a.in[c.z + IN_VUP] + (size_t)(j - 1) * 32 * 512;
      for (int e = c.bid * NTHR + c.tid; e < 32 * 512; e += c.G * NTHR) { const int n = e >> 5, k = e & 31; VUPT[e] = f2bf(v_up[(size_t)k * 512 + n]); } }
  }
  for (int it = gw; it < NIT; it += NGW) {
    int r = it;
    if (r < I_GU) { transpose_item(wgu0, DM, 2 * DFF, WGU0, 1, norms + 0 * DM, 0, 0, 1.f, scr, r, c.lane); continue; } r -= I_GU;
    if (r < I_GU) { transpose_item(wgu1, DM, 2 * DFF, WGU1, 1, norms + 4 * DM, 0, 0, 1.f, scr, r, c.lane); continue; } r -= I_GU;
    if (r < I_D) { transpose_item(wd0, DFF, DM, WD0, 0, nullptr, 0, 0, 1.f, scr, r, c.lane); continue; } r -= I_D;
    if (r < I_D) { transpose_item(wd1, DFF, DM, WD1, 0, nullptr, 0, 0, 1.f, scr, r, c.lane); continue; } r -= I_D;
    if (r < I_IN) { transpose_item(win, DM, NIN, WIN, 0, norms + 2 * DM, even ? 0 : 1024, even ? 0 : 2048, 0.0625f, scr, r, c.lane); continue; } r -= I_IN;
    transpose_item(wout, KOUT, DM, WOUT, 0, nullptr, 0, 0, 1.f, scr, r, c.lane);
  }
}

DI void rowpass(const Ctx& c, const float* xin, const bf16_t* F, const float* gain, float coef) {
  const int gw = c.bid * NWAVES + c.wave, NGW = c.G * NWAVES;
  bf16_t* XB = (bf16_t*)(c.ws + WS_XB); float* RINV = (float*)(c.ws + WS_RINV);
  f32x4 gv[4];
  if (F) {
#pragma unroll
    for (int j = 0; j < 4; ++j) gv[j] = *(const f32x4*)(gain + 256 * j + 4 * c.lane);
  }
  for (int row = gw; row < M_TOK; row += NGW) {
    const f32x4* xr = (const f32x4*)(xin + (size_t)row * DM) + c.lane;
    f32x4 v[4];
#pragma unroll
    for (int j = 0; j < 4; ++j) v[j] = xr[64 * j];
    if (F) {
      const u32x2* fr = (const u32x2*)(F + (size_t)row * DM) + c.lane;
      f32x4 f[4]; float ss = 0.f;
#pragma unroll
      for (int j = 0; j < 4; ++j) { const u32x2 w = fr[64 * j];
        f[j] = (f32x4){__uint_as_float(w.x << 16), __uint_as_float(w.x & 0xffff0000u), __uint_as_float(w.y << 16), __uint_as_float(w.y & 0xffff0000u)};
        ss += (f[j].x * f[j].x + f[j].y * f[j].y) + (f[j].z * f[j].z + f[j].w * f[j].w); }
      const float r = coef * __builtin_amdgcn_rsqf(wave_sum(ss) * (1.f / DM) + NORM_EPS);
#pragma unroll
      for (int j = 0; j < 4; ++j) v[j] = v[j] + f[j] * gv[j] * r;
    }
    float s2 = 0.f;
#pragma unroll
    for (int j = 0; j < 4; ++j) s2 += (v[j].x * v[j].x + v[j].y * v[j].y) + (v[j].z * v[j].z + v[j].w * v[j].w);
    s2 = wave_sum(s2);
    f32x4* xo = (f32x4*)(c.out + (size_t)row * DM) + c.lane;
    u32x2* xb = (u32x2*)(XB + (size_t)row * DM) + c.lane;
#pragma unroll
    for (int j = 0; j < 4; ++j) { xo[64 * j] = v[j]; u32x2 w; w.x = cvtpk(v[j].x, v[j].y); w.y = cvtpk(v[j].z, v[j].w); xb[64 * j] = w; }
    if (c.lane == 0) RINV[row] = __builtin_amdgcn_rsqf(s2 * (1.f / DM) + NORM_EPS);
  }
}

DI f32x4 ld_bf4(const bf16_t* p) { const u32x2 w = *(const u32x2*)p; return (f32x4){__uint_as_float(w.x << 16), __uint_as_float(w.x & 0xffff0000u), __uint_as_float(w.y << 16), __uint_as_float(w.y & 0xffff0000u)}; }
DI void st_bf4(bf16_t* p, f32x4 v) { u32x2 w; w.x = cvtpk(v.x, v.y); w.y = cvtpk(v.z, v.w); *(u32x2*)p = w; }
DI void rwkv_prep(const Ctx& c, const Args& a, int j) {
  const bf16_t* Z = (const bf16_t*)(c.ws + WS_ZEVEN);
  bf16_t* RW = (bf16_t*)(c.ws + WS_RW);
  bf16_t* VF = (bf16_t*)(c.ws + WS_VFIRST);
  const bf16_t* WUPT = (const bf16_t*)(c.ws + WS_LORA); const bf16_t* AUPT = WUPT + 512 * 64; const bf16_t* GUPT = AUPT + 512 * 64;
  const bf16_t* VDT = GUPT + 512 * 128; const bf16_t* VUPT = VDT + 32 * 512;
  const float* mu = a.in[c.z + IN_MU] + (size_t)j * 1792;
  const float* vec = a.in[c.z + IN_VEC] + (size_t)j * 7 * 512;
  const bool vres = j > 0;
  const float* v0p = a.in[c.z + IN_V0] + (size_t)(j > 0 ? j - 1 : 0) * 512;
  constexpr int XS = 528, VS = 1040, US = 80;
  LAS unsigned char* xsb = c.lds; LAS unsigned char* vsb = c.lds + 16896; LAS unsigned char* ub = c.lds + 50176;
  const int tid = c.tid, lane = c.lane, w = c.wave, l15 = lane & 15, quad = lane >> 4;
  for (int u = c.bid; u < M_TOK / 32; u += c.G) {
    const int t0 = u * 32; const bool first = (t0 % SEQ) == 0;
    __syncthreads();
    {
      const int cc = tid & 255, tg = tid >> 8; const float m = mu[1536 + cc];
      const int tb = t0 + tg * 16;
      float prev = (first && tg == 0) ? 0.f : bf2f(Z[(size_t)(tb - 1) * EVEN_IN + 3072 + cc]);
#pragma unroll 4
      for (int i = 0; i < 16; ++i) { const float cur = bf2f(Z[(size_t)(tb + i) * EVEN_IN + 3072 + cc]); const float zs = cur + (prev - cur) * m; prev = cur;
        const float val = cc < 64 ? tanhf_(zs) : (cc < 128 ? zs : sigmoidf_(zs)); *(LAS bf16_t*)(xsb + (tg * 16 + i) * XS + cc * 2) = f2bf(val); }
    }
    __syncthreads();
#pragma unroll 1
    for (int tt = 0; tt < 2; ++tt) {
      const int t = t0 + 16 * tt + l15; const bool tfirst = (t % SEQ) == 0;
      const LAS unsigned char* xr = xsb + (16 * tt + l15) * XS + quad * 16;
      float ss = 0.f;
#pragma unroll 1
      for (int ct = 0; ct < 4; ++ct) {
        const int col = 64 * w + 16 * ct + 4 * quad;
        const size_t wr = (size_t)(64 * w + 16 * ct + l15);
        f32x4 x = {0.f, 0.f, 0.f, 0.f}, z = x;
#pragma unroll
        for (int ks = 0; ks < 2; ++ks) x = MFMA16(*(const bf16x8*)(WUPT + wr * 64 + 32 * ks + 8 * quad), *(const LAS bf16x8*)(xr + ks * 64), x);
#pragma unroll
        for (int ks = 0; ks < 4; ++ks) z = MFMA16(*(const bf16x8*)(GUPT + wr * 128 + 32 * ks + 8 * quad), *(const LAS bf16x8*)(xr + 256 + ks * 64), z);
        const bf16_t* zp = Z + (size_t)t * EVEN_IN + 1536 + col;
        const f32x4 cr = ld_bf4(zp), ck = ld_bf4(zp + 512), cv = ld_bf4(zp + 1024);
        f32x4 pr = {0.f, 0.f, 0.f, 0.f}, pk = pr, pv = pr;
        if (!tfirst) { pr = ld_bf4(zp - EVEN_IN); pk = ld_bf4(zp - EVEN_IN + 512); pv = ld_bf4(zp - EVEN_IN + 1024); }
        const f32x4 mr = *(const f32x4*)(mu + col), mk = *(const f32x4*)(mu + 512 + col), mv = *(const f32x4*)(mu + 1024 + col);
        const f32x4 w0 = *(const f32x4*)(vec + col), k_k = *(const f32x4*)(vec + 1024 + col);
        const f32x4 rr = cr + (pr - cr) * mr, k1 = ck + (pk - ck) * mk, vv = cv + (pv - cv) * mv;
        f32x4 ew;
#pragma unroll
        for (int e = 0; e < 4; ++e) ew[e] = 0.60653065971f * sigmoidf_(w0[e] + x[e]);
        const f32x4 kkr = k1 * k_k; ss += (kkr.x * kkr.x + kkr.y * kkr.y) + (kkr.z * kkr.z + kkr.w * kkr.w);
        const size_t o = (size_t)t * 512 + col;
        st_bf4(RW + 0 * RW_STRIDE + o, ew); st_bf4(RW + 4 * RW_STRIDE + o, rr); st_bf4(RW + 6 * RW_STRIDE + o, z);
        if (!vres) { st_bf4(RW + 5 * RW_STRIDE + o, vv); st_bf4(VF + o, vv); }
        else { u32x2 wv; wv.x = cvtpk(vv.x, vv.y); wv.y = cvtpk(vv.z, vv.w); *(LAS u32x2*)(vsb + (16 * tt + l15) * VS + col * 2) = wv; }
      }
      ss += __shfl_xor(ss, 16); ss += __shfl_xor(ss, 32);
      const float rinv = 1.f / fmaxf(sqrtf(ss), 1e-12f);
#pragma unroll 1
      for (int ct = 0; ct < 4; ++ct) {
        const int col = 64 * w + 16 * ct + 4 * quad;
        const size_t wr = (size_t)(64 * w + 16 * ct + l15);
        f32x4 y = {0.f, 0.f, 0.f, 0.f};
#pragma unroll
        for (int ks = 0; ks < 2; ++ks) y = MFMA16(*(const bf16x8*)(AUPT + wr * 64 + 32 * ks + 8 * quad), *(const LAS bf16x8*)(xr + 128 + ks * 64), y);
        const bf16_t* zp = Z + (size_t)t * EVEN_IN + 1536 + 512 + col;
        const f32x4 ck = ld_bf4(zp); f32x4 pk = {0.f, 0.f, 0.f, 0.f};
        if (!tfirst) pk = ld_bf4(zp - EVEN_IN);
        const f32x4 mk = *(const f32x4*)(mu + 512 + col), a0 = *(const f32x4*)(vec + 512 + col);
        const f32x4 k_k = *(const f32x4*)(vec + 1024 + col), k_a = *(const f32x4*)(vec + 1536 + col);
        const f32x4 k1 = ck + (pk - ck) * mk;
        f32x4 a1;
#pragma unroll
        for (int e = 0; e < 4; ++e) a1[e] = sigmoidf_(a0[e] + y[e]);
        const f32x4 kk = k1 * k_k * rinv;
        const f32x4 kmod = k1 * (1.f + (a1 - 1.f) * k_a);
        const size_t o = (size_t)t * 512 + col;
        st_bf4(RW + 1 * RW_STRIDE + o, kk); st_bf4(RW + 2 * RW_STRIDE + o, kk * a1); st_bf4(RW + 3 * RW_STRIDE + o, kmod);
      }
    }
    if (vres) {
      __syncthreads();
      if (w < 4) { const int mt = w >> 1, tt = w & 1; f32x4 acc = {0.f, 0.f, 0.f, 0.f};
#pragma unroll 4
        for (int ks = 0; ks < 16; ++ks) acc = MFMA16(*(const bf16x8*)(VDT + (size_t)(16 * mt + l15) * 512 + 32 * ks + 8 * quad), *(const LAS bf16x8*)(vsb + (16 * tt + l15) * VS + (32 * ks + 8 * quad) * 2), acc);
        u32x2 wv; wv.x = cvtpk(acc.x, acc.y); wv.y = cvtpk(acc.z, acc.w); *(LAS u32x2*)(ub + (16 * tt + l15) * US + (16 * mt + 4 * quad) * 2) = wv; }
      __syncthreads();
#pragma unroll 1
      for (int ct = 0; ct < 4; ++ct) {
        const int col = 64 * w + 16 * ct + 4 * quad;
        const bf16x8 fu = *(const bf16x8*)(VUPT + (size_t)(64 * w + 16 * ct + l15) * 32 + 8 * quad);
        const f32x4 v0 = *(const f32x4*)(v0p + col);
#pragma unroll
        for (int tt = 0; tt < 2; ++tt) {
          f32x4 sacc = {0.f, 0.f, 0.f, 0.f};
          sacc = MFMA16(fu, *(const LAS bf16x8*)(ub + (16 * tt + l15) * US + quad * 16), sacc);
          const size_t o = (size_t)(t0 + 16 * tt + l15) * 512 + col;
          const u32x2 wv = *(const LAS u32x2*)(vsb + (16 * tt + l15) * VS + col * 2);
          const f32x4 vv = {__uint_as_float(wv.x << 16), __uint_as_float(wv.x & 0xffff0000u), __uint_as_float(wv.y << 16), __uint_as_float(wv.y & 0xffff0000u)};
          const f32x4 vf = ld_bf4(VF + o); f32x4 r;
#pragma unroll
          for (int e = 0; e < 4; ++e) r[e] = vv[e] + (vf[e] - vv[e]) * sigmoidf_(v0[e] + sacc[e]);
          st_bf4(RW + 5 * RW_STRIDE + o, r);
        }
      }
    }
  }
}

DI void rwkv_scan_item(const Ctx& c, int item) {
  const int bh = item >> 1, half = item & 1, b = bh >> 3, h = bh & 7;
  const bf16_t* RW = (const bf16_t*)(c.ws + WS_RW);
  bf16_t* MIX = (bf16_t*)(c.ws + WS_MIXE);
  const int tid = c.tid, lane = c.lane, rg = lane >> 4, c4 = lane & 15, row = c.wave * 4 + rg;
  constexpr int BUF_F = 32 * 320 + 32 * 32;
  LAS float* buf0 = (LAS float*)c.lds;
  LAS float* ybuf = (LAS float*)c.lds + 2 * BUF_F;
  const size_t tokbase = (size_t)b * SEQ;
  const int i2 = tid & 255;
  const int l_step = i2 >> 3, l_c8 = i2 & 7, l_arr = tid >> 8;
  const bf16_t* src01 = RW + (size_t)l_arr * RW_STRIDE + (tokbase + l_step) * 512 + h * 64 + l_c8 * 8;
  const int vid = tid - 256;
  const bf16_t* srcv = RW + 5 * RW_STRIDE + (tokbase + ((vid >> 2) & 31)) * 512 + h * 64 + half * 32 + (vid & 3) * 8;
  bf16x8 p0, p1, p2;
  auto issue = [&](int ch) {
    const size_t off = (size_t)ch * 32 * 512;
    p0 = *(const bf16x8*)(src01 + off); p1 = *(const bf16x8*)(src01 + 2 * RW_STRIDE + off);
    if (tid < 256) p2 = *(const bf16x8*)(src01 + 4 * RW_STRIDE + off);
    else if (tid < 384) p2 = *(const bf16x8*)(srcv + off);
  };
  auto stash = [&](int bsel) {
    LAS float* B = buf0 + bsel * BUF_F;
    float f[8];
    { unpack8(p0, f); LAS float* d = B + l_step * 320 + l_arr * 64 + l_c8 * 8;
      if (l_arr == 0) {
#pragma unroll
        for (int e = 0; e < 8; ++e) f[e] = __builtin_amdgcn_exp2f(-f[e] * LOG2E);
      } else {
#pragma unroll
        for (int e = 0; e < 8; ++e) f[e] = -f[e];
      }
      *(LAS f32x4*)d = (f32x4){f[0], f[1], f[2], f[3]}; *(LAS f32x4*)(d + 4) = (f32x4){f[4], f[5], f[6], f[7]}; }
    { unpack8(p1, f); LAS float* d = B + l_step * 320 + (l_arr + 2) * 64 + l_c8 * 8;
      *(LAS f32x4*)d = (f32x4){f[0], f[1], f[2], f[3]}; *(LAS f32x4*)(d + 4) = (f32x4){f[4], f[5], f[6], f[7]}; }
    if (tid < 256) { unpack8(p2, f); LAS float* d = B + l_step * 320 + 4 * 64 + l_c8 * 8;
      *(LAS f32x4*)d = (f32x4){f[0], f[1], f[2], f[3]}; *(LAS f32x4*)(d + 4) = (f32x4){f[4], f[5], f[6], f[7]}; }
    else if (tid < 384) { unpack8(p2, f); LAS float* d = B + 32 * 320 + (vid >> 2) * 32 + (vid & 3) * 8;
      *(LAS f32x4*)d = (f32x4){f[0], f[1], f[2], f[3]}; *(LAS f32x4*)(d + 4) = (f32x4){f[4], f[5], f[6], f[7]}; }
  };
  __syncthreads();
  issue(0); stash(0);
  __syncthreads();
  f32x4 S = {0.f, 0.f, 0.f, 0.f};
#pragma unroll 1
  for (int ch = 0; ch < SEQ / 32; ++ch) {
    if (ch + 1 < SEQ / 32) issue(ch + 1);
    const LAS float* B = buf0 + (ch & 1) * BUF_F;
    LAS float* yb = ybuf + (ch & 1) * 1024;
#pragma unroll 4
    for (int s = 0; s < 32; ++s) {
      const LAS float* L = B + s * 320 + c4 * 4;
      const f32x4 dw = *(const LAS f32x4*)(L), nk = *(const LAS f32x4*)(L + 64), ka = *(const LAS f32x4*)(L + 128), kv = *(const LAS f32x4*)(L + 192), rv = *(const LAS f32x4*)(L + 256);
      const float vv = B[32 * 320 + s * 32 + row];
      float sa = (S.x * nk.x + S.y * nk.y) + (S.z * nk.z + S.w * nk.w);
      sa = row16_sum(sa);
      S = S * dw + kv * vv + ka * sa;
      float y = (S.x * rv.x + S.y * rv.y) + (S.z * rv.z + S.w * rv.w);
      y = row16_sum(y);
      if (c4 == 0) yb[s * 32 + row] = y;
    }
    if (ch + 1 < SEQ / 32) stash((ch + 1) & 1);
    __syncthreads();
    { const int s = tid >> 4, r2 = (tid & 15) * 2; const float y0 = yb[s * 32 + r2], y1 = yb[s * 32 + r2 + 1];
      *(unsigned*)(MIX + (tokbase + ch * 32 + s) * 1024 + 512 + h * 64 + half * 32 + r2) = cvtpk(y0, y1); }
  }
}

DI void attn_unit(const Ctx& c, const Args& a, int j, int b, int h, int c2, float lam, float lam_init) {
  const bf16_t* Z = (const bf16_t*)(c.ws + WS_ZEVEN) + (size_t)b * SEQ * EVEN_IN;
  bf16_t* MIX = (bf16_t*)(c.ws + WS_MIXE) + (size_t)b * SEQ * 1024;
  const float* subln = a.in[c.z + IN_SUBLN] + (size_t)j * 128;
  const int tid = c.tid, lane = c.lane, wave = c.wave, l15 = lane & 15, quad = lane >> 4, q_ = l15 >> 2, p_ = l15 & 3;
  const int q0 = 128 * c2 + 16 * wave, my_chunk = 2 * c2 + (wave >> 2), nkt = 2 * c2 + 2;
  constexpr int RS = 272, IMG = 64 * RS, BUFB = 2 * IMG;
  bf16x8 qf[2][2];
#pragma unroll
  for (int m = 0; m < 2; ++m)
#pragma unroll
    for (int ks = 0; ks < 2; ++ks) qf[m][ks] = *(const bf16x8*)(Z + (size_t)(q0 + l15) * EVEN_IN + h * 128 + m * 64 + ks * 32 + quad * 8);
  f32x4 o[2][8];
#pragma unroll
  for (int m = 0; m < 2; ++m)
#pragma unroll
    for (int d = 0; d < 8; ++d) o[m][d] = (f32x4){0.f, 0.f, 0.f, 0.f};
  float mrun[2] = {-1e30f, -1e30f}, lrun[2] = {0.f, 0.f};
  const float slope2 = __builtin_amdgcn_exp2f(-2.f * (float)(h + 1)) * LOG2E, sc2 = 0.125f * LOG2E;
  u32x4 pf[4];
  const int prow = tid >> 4, pc16 = tid & 15;
  const bf16_t* ksrc = Z + (size_t)prow * EVEN_IN + 512 + h * 128 + pc16 * 8;
  auto issue = [&](int kt) {
    const bf16_t* s = ksrc + (size_t)kt * 64 * EVEN_IN;
    pf[0] = *(const u32x4*)(s); pf[1] = *(const u32x4*)(s + (size_t)32 * EVEN_IN);
    pf[2] = *(const u32x4*)(s + 512); pf[3] = *(const u32x4*)(s + (size_t)32 * EVEN_IN + 512);
  };
  auto stash = [&](int bsel) {
    LAS unsigned char* B = c.lds + bsel * BUFB + prow * RS + pc16 * 16;
    *(LAS u32x4*)(B) = pf[0]; *(LAS u32x4*)(B + 32 * RS) = pf[1]; *(LAS u32x4*)(B + IMG) = pf[2]; *(LAS u32x4*)(B + IMG + 32 * RS) = pf[3];
  };
  issue(0); stash(0);
  __syncthreads();
#pragma unroll 1
  for (int kt = 0; kt < nkt; ++kt) {
    const bool has_next = kt + 1 < nkt;
    if (has_next) issue(kt + 1);
    if (kt <= my_chunk) {
      const LAS unsigned char* Kb = c.lds + (kt & 1) * BUFB; const LAS unsigned char* Vb = Kb + IMG;
      f32x4 s[2][4];
#pragma unroll
      for (int m = 0; m < 2; ++m)
#pragma unroll
        for (int t16 = 0; t16 < 4; ++t16) { f32x4 acc = {0.f, 0.f, 0.f, 0.f};
#pragma unroll
          for (int ks = 0; ks < 2; ++ks) { const bf16x8 kf = *(const LAS bf16x8*)(Kb + (16 * t16 + l15) * RS + (m * 64 + ks * 32 + quad * 8) * 2); acc = MFMA16(kf, qf[m][ks], acc); }
          s[m][t16] = acc; }
      const float dbase = (float)(q0 + l15 - 64 * kt - 4 * quad);
      bf16x8 pfr[2][2];
#pragma unroll
      for (int m = 0; m < 2; ++m) {
        float mx = -1e30f;
#pragma unroll
        for (int t16 = 0; t16 < 4; ++t16)
#pragma unroll
          for (int e = 0; e < 4; ++e) { const float d = __builtin_fabsf(dbase - (float)(16 * t16 + e)); const float v = s[m][t16][e] * sc2 - slope2 * d; s[m][t16][e] = v; mx = fmaxf(mx, v); }
        mx = fmaxf(mx, __shfl_xor(mx, 16)); mx = fmaxf(mx, __shfl_xor(mx, 32));
        const float mnew = fmaxf(mrun[m], mx), alpha = __builtin_amdgcn_exp2f(mrun[m] - mnew); mrun[m] = mnew;
        float ps = 0.f;
#pragma unroll
        for (int t16 = 0; t16 < 4; ++t16)
#pragma unroll
          for (int e = 0; e < 4; ++e) { const float p = __builtin_amdgcn_exp2f(s[m][t16][e] - mnew); s[m][t16][e] = p; ps += p; }
        lrun[m] = lrun[m] * alpha + ps;
#pragma unroll
        for (int d = 0; d < 8; ++d) o[m][d] = o[m][d] * alpha;
#pragma unroll
        for (int s2 = 0; s2 < 2; ++s2) { u32x4 w; w.x = cvtpk(s[m][2 * s2][0], s[m][2 * s2][1]); w.y = cvtpk(s[m][2 * s2][2], s[m][2 * s2][3]);
          w.z = cvtpk(s[m][2 * s2 + 1][0], s[m][2 * s2 + 1][1]); w.w = cvtpk(s[m][2 * s2 + 1][2], s[m][2 * s2 + 1][3]); pfr[m][s2] = __builtin_bit_cast(bf16x8, w); }
      }
#pragma unroll
      for (int s2 = 0; s2 < 2; ++s2)
#pragma unroll
        for (int d = 0; d < 8; ++d) {
          const LAS unsigned char* vp = Vb + (32 * s2 + 4 * quad + q_) * RS + (16 * d + 4 * p_) * 2;
          const bf16x8 vf = comb8(tr_read(vp), tr_read(vp + 16 * RS));
          o[0][d] = MFMA16(vf, pfr[0][s2], o[0][d]); o[1][d] = MFMA16(vf, pfr[1][s2], o[1][d]);
        }
    }
    if (has_next) stash((kt + 1) & 1);
    __syncthreads();
  }
  float inv[2];
#pragma unroll
  for (int m = 0; m < 2; ++m) { float l = lrun[m]; l += __shfl_xor(l, 16); l += __shfl_xor(l, 32); inv[m] = 1.f / l; }
  const float i1 = lam * inv[1];
  float ss = 0.f;
#pragma unroll
  for (int d = 0; d < 8; ++d)
#pragma unroll
    for (int e = 0; e < 4; ++e) { const float v = o[0][d][e] * inv[0] - o[1][d][e] * i1; o[0][d][e] = v; ss += v * v; }
  ss += __shfl_xor(ss, 16); ss += __shfl_xor(ss, 32);
  const float rn = __builtin_amdgcn_rsqf(ss * (1.f / 128.f) + NORM_EPS) * (1.f - lam_init);
  bf16_t* orow = MIX + (size_t)(q0 + l15) * 1024 + h * 128 + 4 * quad;
#pragma unroll
  for (int d = 0; d < 8; ++d) { const f32x4 g = *(const f32x4*)(subln + 16 * d + 4 * quad);
    u32x2 w; w.x = cvtpk(o[0][d][0] * rn * g.x, o[0][d][1] * rn * g.y); w.y = cvtpk(o[0][d][2] * rn * g.z, o[0][d][3] * rn * g.w);
    *(u32x2*)(orow + 16 * d) = w; }
}

DI void even_mixer(const Ctx& c, const Args& a, int j, int layer, unsigned* counter, int it_lo, int it_hi) {
  const float* lv = a.in[c.z + IN_LAM] + (size_t)j * 4 * 64;
  const float lam_init = 0.8f - 0.6f * __expf(-0.3f * (float)layer);
  const float d1 = wave_sum(lv[c.lane] * lv[64 + c.lane]), d2 = wave_sum(lv[128 + c.lane] * lv[192 + c.lane]);
  const float lam = __expf(d1) - __expf(d2) + lam_init;
  LAS int* qw = (LAS int*)(c.lds + LDS_MAIN + 64);
  const int x = c.bid & 7;
  unsigned* cnt = counter + x;
  for (;;) {
    __syncthreads();
    if (c.tid == 0) *qw = (int)atomicAdd(cnt, 1u);
    __syncthreads();
    const int item = *qw;
    if (item >= it_hi) break;
    if (item < it_lo) continue;
    if (item < 16) rwkv_scan_item(c, (x * 8 + (item >> 1)) * 2 + (item & 1));
    else { const int r = item - 16; const int c2 = 31 - (r & 31), bh = x * 4 + (r >> 5); attn_unit(c, a, j, bh >> 2, bh & 3, c2, lam, lam_init); }
  }
}

DI void rwkv_post(const Ctx& c, const Args& a, int j) {
  const bf16_t* RW = (const bf16_t*)(c.ws + WS_RW);
  bf16_t* MIX = (bf16_t*)(c.ws + WS_MIXE);
  const float* vec = a.in[c.z + IN_VEC] + (size_t)j * 7 * 512;
  const int gw = c.bid * NWAVES + c.wave, NGW = c.G * NWAVES;
  for (int p = gw; p < M_TOK * 8; p += NGW) {
    const int t = p >> 3, h = p & 7, cc = h * 64 + c.lane; const size_t o = (size_t)t * 512 + cc;
    const float y = bf2f(MIX[(size_t)t * 1024 + 512 + cc]);
    const float r = bf2f(RW[4 * RW_STRIDE + o]), k = bf2f(RW[3 * RW_STRIDE + o]), v = bf2f(RW[5 * RW_STRIDE + o]), g = bf2f(RW[6 * RW_STRIDE + o]);
    const float mean = wave_sum(y) * (1.f / 64.f), d = y - mean, var = wave_sum(d * d) * (1.f / 64.f);
    const float yn = d * __builtin_amdgcn_rsqf(var + 64e-5f) * vec[5 * 512 + cc] + vec[6 * 512 + cc];
    const float bonus = wave_sum(r * k * vec[4 * 512 + cc]) * v;
    MIX[(size_t)t * 1024 + 512 + cc] = f2bf((yn + bonus) * g);
  }
}

DI void retention_unit(const Ctx& c, int bh, int slice) {
  const int b = bh >> 2, h = bh & 3;
  const bf16_t* Z = (const bf16_t*)(c.ws + WS_ZODD) + (size_t)b * SEQ * ODD_IN;
  bf16_t* YB = (bf16_t*)(c.ws + WS_YB) + (size_t)b * SEQ * 2048 + h * 512 + slice * 64;
  const int tid = c.tid, lane = c.lane, wave = c.wave, l15 = lane & 15, quad = lane >> 4, q_ = l15 >> 2, p_ = l15 & 3;
  constexpr int RQ = 528, RV = 144;
  LAS unsigned char* Qi = c.lds; LAS unsigned char* Ki = c.lds + 33792; LAS unsigned char* Vi = c.lds + 67584; LAS unsigned char* Vdi = c.lds + 76800;
  LAS unsigned char* Sci = c.lds + 86016; LAS unsigned char* Si = c.lds + 95232;
  const float log2g = __log2f(1.f - __builtin_amdgcn_exp2f(-5.f - (float)h));
  const float cd = __builtin_amdgcn_exp2f(log2g * 64.f);
  f32x4 st[2][4];
#pragma unroll
  for (int mt = 0; mt < 2; ++mt)
#pragma unroll
    for (int nt = 0; nt < 4; ++nt) st[mt][nt] = (f32x4){0.f, 0.f, 0.f, 0.f};
  u32x4 pq[4], pk[4], pv;
  const int prow = tid >> 5, pc = tid & 31;
  const bf16_t* qsrc = Z + (size_t)prow * ODD_IN + h * 256 + pc * 8;
  const int vrow = tid >> 3, vc = tid & 7;
  const bf16_t* vsrc = Z + (size_t)vrow * ODD_IN + 2048 + h * 512 + slice * 64 + vc * 8;
  auto issue = [&](int ch) {
    const size_t off = (size_t)ch * 64 * ODD_IN;
#pragma unroll
    for (int i = 0; i < 4; ++i) { pq[i] = *(const u32x4*)(qsrc + off + (size_t)(16 * i) * ODD_IN); pk[i] = *(const u32x4*)(qsrc + off + (size_t)(16 * i) * ODD_IN + 1024); }
    pv = *(const u32x4*)(vsrc + off);
  };
  auto stash = [&]() {
#pragma unroll
    for (int i = 0; i < 4; ++i) { *(LAS u32x4*)(Qi + (prow + 16 * i) * RQ + pc * 16) = pq[i]; *(LAS u32x4*)(Ki + (prow + 16 * i) * RQ + pc * 16) = pk[i]; }
    *(LAS u32x4*)(Vi + vrow * RV + vc * 16) = pv;
  };
  __syncthreads();
  issue(0);
  for (int i = tid; i < 33792 / 16; i += NTHR) *(LAS u32x4*)(Si + i * 16) = (u32x4){0u, 0u, 0u, 0u};
  stash();
  __syncthreads();
#pragma unroll 1
  for (int ch = 0; ch < 64; ++ch) {
    if (ch + 1 < 64) issue(ch + 1);
    {
      const int it = wave >> 1;
#pragma unroll
      for (int jj2 = 0; jj2 < 2; ++jj2) { const int jt = 2 * (wave & 1) + jj2; f32x4 acc = {0.f, 0.f, 0.f, 0.f};
#pragma unroll
        for (int ks = 0; ks < 8; ++ks) { const bf16x8 kf = *(const LAS bf16x8*)(Ki + (16 * jt + l15) * RQ + (32 * ks + 8 * quad) * 2);
          const bf16x8 qf = *(const LAS bf16x8*)(Qi + (16 * it + l15) * RQ + (32 * ks + 8 * quad) * 2); acc = MFMA16(kf, qf, acc); }
        const int i = 16 * it + l15, j0 = 16 * jt + 4 * quad; float v[4];
#pragma unroll
        for (int e = 0; e < 4; ++e) v[e] = acc[e] * __builtin_amdgcn_exp2f(log2g * __builtin_fabsf((float)(i - j0 - e)));
        u32x2 w; w.x = cvtpk(v[0], v[1]); w.y = cvtpk(v[2], v[3]); *(LAS u32x2*)(Sci + i * RV + j0 * 2) = w; }
      { const bf16x8 v8 = *(const LAS bf16x8*)(Vi + vrow * RV + vc * 16); float f[8]; unpack8(v8, f); const float kd = __builtin_amdgcn_exp2f(log2g * (float)(63 - vrow));
        u32x4 w; w.x = cvtpk(f[0] * kd, f[1] * kd); w.y = cvtpk(f[2] * kd, f[3] * kd); w.z = cvtpk(f[4] * kd, f[5] * kd); w.w = cvtpk(f[6] * kd, f[7] * kd);
        *(LAS u32x4*)(Vdi + vrow * RV + vc * 16) = w; }
    }
    __syncthreads();
    {
      const int et = wave >> 1;
#pragma unroll
      for (int ii = 0; ii < 2; ++ii) { const int it2 = 2 * (wave & 1) + ii; f32x4 acc = {0.f, 0.f, 0.f, 0.f};
#pragma unroll
        for (int ks = 0; ks < 8; ++ks) { const bf16x8 sf = *(const LAS bf16x8*)(Si + (16 * et + l15) * RQ + (32 * ks + 8 * quad) * 2);
          const bf16x8 qf = *(const LAS bf16x8*)(Qi + (16 * it2 + l15) * RQ + (32 * ks + 8 * quad) * 2); acc = MFMA16(sf, qf, acc); }
        const float qd = __builtin_amdgcn_exp2f(log2g * (float)(16 * it2 + l15 + 1)); acc = acc * qd;
#pragma unroll
        for (int s = 0; s < 2; ++s) { const LAS unsigned char* vp = Vi + (32 * s + 8 * quad + q_) * RV + (16 * et + 4 * p_) * 2;
          const bf16x8 vf = comb8(tr_read(vp), tr_read(vp + 4 * RV));
          const bf16x8 sc = *(const LAS bf16x8*)(Sci + (16 * it2 + l15) * RV + (32 * s + 8 * quad) * 2); acc = MFMA16(vf, sc, acc); }
        u32x2 w; w.x = cvtpk(acc[0], acc[1]); w.y = cvtpk(acc[2], acc[3]);
        *(u32x2*)(YB + (size_t)(ch * 64 + 16 * it2 + l15) * 2048 + 16 * et + 4 * quad) = w; }
#pragma unroll
      for (int mt = 0; mt < 2; ++mt)
#pragma unroll
        for (int nt = 0; nt < 4; ++nt) st[mt][nt] = st[mt][nt] * cd;
#pragma unroll
      for (int s = 0; s < 2; ++s) { bf16x8 vd[4];
#pragma unroll
        for (int nt = 0; nt < 4; ++nt) { const LAS unsigned char* vp = Vdi + (32 * s + 8 * quad + q_) * RV + (16 * nt + 4 * p_) * 2; vd[nt] = comb8(tr_read(vp), tr_read(vp + 4 * RV)); }
#pragma unroll
        for (int mt = 0; mt < 2; ++mt) { const LAS unsigned char* kp = Ki + (32 * s + 8 * quad + q_) * RQ + (32 * wave + 16 * mt + 4 * p_) * 2;
          const bf16x8 kf = comb8(tr_read(kp), tr_read(kp + 4 * RQ));
#pragma unroll
          for (int nt = 0; nt < 4; ++nt) st[mt][nt] = MFMA16(kf, vd[nt], st[mt][nt]); } }
    }
    __syncthreads();
#pragma unroll
    for (int mt = 0; mt < 2; ++mt)
#pragma unroll
      for (int nt = 0; nt < 4; ++nt) { u32x2 w; w.x = cvtpk(st[mt][nt][0], st[mt][nt][1]); w.y = cvtpk(st[mt][nt][2], st[mt][nt][3]);
        *(LAS u32x2*)(Si + (16 * nt + l15) * RQ + (32 * wave + 16 * mt + 4 * quad) * 2) = w; }
    if (ch + 1 < 64) stash();
    __syncthreads();
  }
}

DI void retention_post(const Ctx& c) {
  const bf16_t* YB = (const bf16_t*)(c.ws + WS_YB);
  bf16_t* Z = (bf16_t*)(c.ws + WS_ZODD);
  const int gw = c.bid * NWAVES + c.wave, NGW = c.G * NWAVES;
  for (int p = gw; p < M_TOK * 4; p += NGW) {
    const int t = p >> 2, h = p & 3;
    const bf16x8 y8 = *(const bf16x8*)(YB + (size_t)t * 2048 + h * 512 + c.lane * 8);
    bf16_t* gp = Z + (size_t)t * ODD_IN + 4096 + h * 512 + c.lane * 8;
    const bf16x8 g8 = *(const bf16x8*)gp;
    float y[8], g[8]; unpack8(y8, y); unpack8(g8, g);
    float ss = 0.f;
#pragma unroll
    for (int e = 0; e < 8; ++e) ss += y[e] * y[e];
    const float rn = __builtin_amdgcn_rsqf(wave_sum(ss) * (1.f / 512.f) + NORM_EPS);
#pragma unroll
    for (int e = 0; e < 8; ++e) y[e] = siluf_(g[e]) * y[e] * rn;
    u32x4 w; w.x = cvtpk(y[0], y[1]); w.y = cvtpk(y[2], y[3]); w.z = cvtpk(y[4], y[5]); w.w = cvtpk(y[6], y[7]);
    *(u32x4*)gp = w;
  }
}

enum { T_CONV = 0, T_GU_A, T_DOWN_A, T_ROW1, T_WIN, T_PREP, T_MIX, T_POST, T_WOUT, T_ROW3, T_GU_B, T_DOWN_B, T_RET, T_RETPOST, T_FINAL };
__global__ void __launch_bounds__(NTHR, 2) fwd_megakernel(Args args) {
  extern __shared__ __attribute__((aligned(16))) unsigned char lds_raw[];
  cg::grid_group grid = cg::this_grid();
  const int lo = args.ph_lo, hi = args.ph_hi;
#pragma unroll 1
  for (int ph = lo; ph < hi; ++ph) {
    Ctx c;
    { int tid = threadIdx.x, bid = blockIdx.x, G = gridDim.x, z = 0;
      asm volatile("" : "+v"(tid)); asm volatile("" : "+s"(bid), "+s"(G), "+s"(z));
      unsigned char* ws = args.ws + z; float* out = args.out + z;
      c.lds = (LAS unsigned char*)lds_raw; c.tid = tid; c.lane = tid & 63; c.wave = __builtin_amdgcn_readfirstlane(tid >> 6);
      c.G = G; c.bid = bid; c.z = z; c.ws = ws; c.out = out; }
    int L, k;
    if (ph < 12) { L = 0; k = ph; } else if (ph < 23) { L = 1; k = ph - 12; } else if (ph < 35) { L = 2; k = ph - 23; } else if (ph < 46) { L = 3; k = ph - 35; } else { L = 4; k = 0; }
    int type;
    if (L == 4) type = T_FINAL;
    else if ((L & 1) == 0) type = k;
    else type = (k <= 4) ? k : (k == 5 ? T_RET : (k == 6 ? T_RETPOST : k + 1));
    const bool even = (L & 1) == 0; const int j = L >> 1;
    const bool is_gemm = (type == T_GU_A || type == T_DOWN_A || type == T_WIN || type == T_WOUT || type == T_GU_B || type == T_DOWN_B);
    if (is_gemm) {
      pg8::Gemm g; pg8::EpiRT E;
      bf16_t* XB = (bf16_t*)(c.ws + WS_XB); bf16_t* F = (bf16_t*)(c.ws + WS_F); bf16_t* H = (bf16_t*)(c.ws + WS_H);
      const float* RINV = (const float*)(c.ws + WS_RINV);
      g.M = M_TOK;
      if (type == T_GU_A || type == T_GU_B) { g.A = XB; g.Bt = (const bf16_t*)(c.ws + (type == T_GU_A ? WS_WGU0 : WS_WGU1)); g.N = 2 * DFF; g.K = DM; g.lda = DM; g.ldb = DM; E.mode = 2; E.O = H; E.ldc = DFF; E.rs = RINV; }
      else if (type == T_DOWN_A || type == T_DOWN_B) { g.A = H; g.Bt = (const bf16_t*)(c.ws + (type == T_DOWN_A ? WS_WD0 : WS_WD1)); g.N = DM; g.K = DFF; g.lda = DFF; g.ldb = DFF; E.mode = 0; E.O = F; E.ldc = DM; E.rs = RINV; }
      else if (type == T_WIN) { const int NIN = even ? EVEN_IN : ODD_IN; g.A = XB; g.Bt = (const bf16_t*)(c.ws + WS_WIN); g.N = NIN; g.K = DM; g.lda = DM; g.ldb = DM; E.mode = 1; E.O = (bf16_t*)(c.ws + (even ? WS_ZEVEN : WS_ZODD)); E.ldc = NIN; E.rs = RINV; }
      else { if (even) { g.A = (const bf16_t*)(c.ws + WS_MIXE); g.K = DM; g.lda = DM; g.ldb = DM; } else { g.A = (const bf16_t*)(c.ws + WS_ZODD) + 4096; g.K = 2048; g.lda = ODD_IN; g.ldb = 2048; }
        g.Bt = (const bf16_t*)(c.ws + WS_WOUT); g.N = DM; E.mode = 0; E.O = F; E.ldc = DM; E.rs = RINV; }
      pg8::StaticOrder S; S.init(M_TOK, g.N, c.G, c.bid);
      pg8::gemm_phase(c.lds, g, S, E);
      if ((DUP_MASK >> type) & 1) pg8::gemm_phase(c.lds, g, S, E);
    } else if (type == T_CONV || type == T_ROW1 || type == T_ROW3 || type == T_FINAL) {
      const float* xin = c.out; const bf16_t* F = (const bf16_t*)(c.ws + WS_F); const float* gain = nullptr; float coef = 0.5f;
      if (type == T_CONV) {
        convert_layer(c, args, L);
        if ((DUP_MASK >> T_CONV) & 1) convert_layer(c, args, L);
        if (L == 0) { xin = args.in[c.z + IN_X]; F = nullptr; } else gain = args.in[c.z + IN_NORMS] + (size_t)(L - 1) * 6 * DM + 5 * DM;
      } else if (type == T_ROW1) gain = args.in[c.z + IN_NORMS] + (size_t)L * 6 * DM + 1 * DM;
      else if (type == T_ROW3) { gain = args.in[c.z + IN_NORMS] + (size_t)L * 6 * DM + 3 * DM; coef = 1.0f; }
      else gain = args.in[c.z + IN_NORMS] + (size_t)3 * 6 * DM + 5 * DM;
      rowpass(c, xin, F, gain, coef);
    } else if (type == T_PREP) {
      rwkv_prep(c, args, j);
      if ((DUP_MASK >> T_PREP) & 1) rwkv_prep(c, args, j);
    } else if (type == T_MIX) {
      if (DUP_MASK & 0x10000) even_mixer(c, args, j, L, (unsigned*)(c.ws + WS_CTL) + 64 * j + 32, 0, 16);
      if (DUP_MASK & 0x20000) even_mixer(c, args, j, L, (unsigned*)(c.ws + WS_CTL) + 64 * j + 48, 16, 144);
      even_mixer(c, args, j, L, (unsigned*)(c.ws + WS_CTL) + 64 * j, 0, 144);
    } else if (type == T_POST) {
      rwkv_post(c, args, j);
    } else if (type == T_RET) {
      for (int u = c.bid; u < 256; u += c.G) { const int x = u & 7, slot = u >> 3; retention_unit(c, x * 4 + (slot >> 3), slot & 7); }
    } else if (type == T_RETPOST) {
      retention_post(c);
    }
    if (ph + 1 < hi) grid.sync();
  }
}
constexpr int N_PHASES = 12 + 11 + 12 + 11 + 1;

extern "C" void kernel_launch(void* const* d_in, const int* in_sizes, int n_in, void* d_out, int out_size, void* d_ws, size_t ws_size, hipStream_t stream) {
  static int grid = 0;
  if (grid == 0) {
    if (n_in != 18 || out_size != M_TOK * DM || ws_size < WS_END) { fprintf(stderr, "kernel_launch: unexpected shapes (n_in %d, out %d, ws %zu, need %zu)\n", n_in, out_size, ws_size, (size_t)WS_END); grid = -1; return; }
    int dev = 0, cus = 0, per_cu = 0;
    hipGetDevice(&dev); hipDeviceGetAttribute(&cus, hipDeviceAttributeMultiprocessorCount, dev);
    if (hipFuncSetAttribute((const void*)fwd_megakernel, hipFuncAttributeMaxDynamicSharedMemorySize, LDS_BYTES) != hipSuccess) { fprintf(stderr, "kernel_launch: hipFuncSetAttribute failed\n"); grid = -1; return; }
    if (hipOccupancyMaxActiveBlocksPerMultiprocessor(&per_cu, (const void*)fwd_megakernel, NTHR, LDS_BYTES) != hipSuccess || per_cu < 1) { fprintf(stderr, "kernel_launch: occupancy query gives %d\n", per_cu); per_cu = 1; }
    (void)hipGetLastError();
    grid = cus * per_cu;
    if (grid > 256) grid = 256;
  }
  if (grid < 0) return;
  hipMemsetAsync((char*)d_ws + WS_CTL, 0, CTL_BYTES, stream);
  Args a{};
  for (int i = 0; i < 18; ++i) a.in[i] = (const float*)d_in[i];
  a.out = (float*)d_out; a.ws = (unsigned char*)d_ws;
#if MK_PER_PHASE
  for (int p = 0; p < N_PHASES; ++p) { a.ph_lo = p; a.ph_hi = p + 1; hipLaunchKernelGGL(fwd_megakernel, dim3(grid), dim3(NTHR), LDS_BYTES, stream, a); }
#else
  a.ph_lo = 0; a.ph_hi = N_PHASES;
  void* kargs[] = {&a};
  hipError_t e = hipLaunchCooperativeKernel((const void*)fwd_megakernel, dim3(grid), dim3(NTHR), kargs, LDS_BYTES, stream);
  if (e != hipSuccess) fprintf(stderr, "cooperative launch failed: %s (grid %d)\n", hipGetErrorString(e), grid);
#endif
}
```

```cpp
#include <hip/hip_runtime.h>
#include <hip/hip_cooperative_groups.h>
#include <cstdio>
#include <cstdint>
namespace cg = cooperative_groups;

#define LAS __attribute__((address_space(3)))
#define DI __device__ __forceinline__
typedef unsigned short bf16_t;
typedef short bf16x8 __attribute__((ext_vector_type(8)));
typedef short s16x4 __attribute__((ext_vector_type(4)));
typedef float f32x4 __attribute__((ext_vector_type(4)));
typedef float f32x2 __attribute__((ext_vector_type(2)));
typedef unsigned u32x4 __attribute__((ext_vector_type(4)));
typedef unsigned u32x2 __attribute__((ext_vector_type(2)));
typedef __bf16 bf16x2_t __attribute__((ext_vector_type(2)));

#ifndef DUP_MASK
#define DUP_MASK 0
#endif
#ifndef MK_PER_PHASE
#define MK_PER_PHASE 0
#endif

constexpr int M_TOK = 32768, SEQ = 4096, DM = 1024, DFF = 2816, NWAVES = 8, NTHR = 512;
constexpr int EVEN_IN = 3328, ODD_IN = 6144;
constexpr float NORM_EPS = 1e-6f;
constexpr float LOG2E = 1.4426950408889634f;

constexpr size_t MiB = 1u << 20;
constexpr size_t WS_CTL = 0, CTL_BYTES = 65536;
constexpr size_t WS_RINV = 1 * MiB;
constexpr size_t WS_WGU0 = 2 * MiB, WS_WD0 = 13 * MiB, WS_WIN = 19 * MiB, WS_WOUT = 31 * MiB, WS_WGU1 = 35 * MiB, WS_WD1 = 46 * MiB;
constexpr size_t WS_LORA = 51 * MiB + 512 * 1024;
constexpr size_t WS_VFIRST = 52 * MiB;
constexpr size_t WS_TMP = 84 * MiB;
constexpr size_t WS_XB = WS_TMP, WS_F = WS_TMP + 64 * MiB;
constexpr size_t WS_BIG = 212 * MiB;
constexpr size_t WS_H = WS_BIG, WS_ZODD = WS_BIG, WS_MIXE = WS_BIG + 112 * MiB, WS_ZEVEN = WS_BIG + 176 * MiB;
constexpr size_t WS_RW = WS_TMP;
constexpr size_t RW_STRIDE = (size_t)M_TOK * 512;
constexpr size_t WS_YB = WS_TMP;
constexpr size_t WS_END = 596 * MiB;

constexpr int LDS_MAIN = 131072, LDS_BYTES = LDS_MAIN + 256;

DI float bf2f(unsigned short b) { return __uint_as_float((unsigned)b << 16); }
DI unsigned cvtpk(float lo, float hi) { f32x2 v = {lo, hi}; bf16x2_t b = __builtin_convertvector(v, bf16x2_t); return __builtin_bit_cast(unsigned, b); }
DI bf16_t f2bf(float f) { return (bf16_t)(cvtpk(f, 0.f) & 0xffffu); }
DI float wave_sum(float v) {
#pragma unroll
  for (int o = 1; o < 64; o <<= 1) v += __shfl_xor(v, o);
  return v;
}
DI float sigmoidf_(float x) { return __builtin_amdgcn_rcpf(1.f + __builtin_amdgcn_exp2f(-x * LOG2E)); }
DI float siluf_(float x) { return x * sigmoidf_(x); }
DI float tanhf_(float x) { return 2.f * sigmoidf_(2.f * x) - 1.f; }
DI void unpack8(const bf16x8 v, float (&f)[8]) {
#pragma unroll
  for (int e = 0; e < 8; ++e) f[e] = bf2f((unsigned short)v[e]);
}
#define MFMA16(a, b, c) __builtin_amdgcn_mfma_f32_16x16x32_bf16((a), (b), (c), 0, 0, 0)
typedef short v4i16_t __attribute__((ext_vector_type(4)));
DI s16x4 tr_read(const LAS unsigned char* p) { return __builtin_bit_cast(s16x4, __builtin_amdgcn_ds_read_tr16_b64_v4i16((LAS v4i16_t*)p)); }
DI bf16x8 comb8(s16x4 lo, s16x4 hi) { return __builtin_shufflevector(lo, hi, 0, 1, 2, 3, 4, 5, 6, 7); }
template <int CTRL> DI float dppf(float v) { return __builtin_bit_cast(float, __builtin_amdgcn_update_dpp(0, __builtin_bit_cast(int, v), CTRL, 0xF, 0xF, true)); }
DI float row16_sum(float v) {
  v += dppf<0xB1>(v); v += dppf<0x4E>(v); v += dppf<0x141>(v); v += dppf<0x140>(v); return v;
}

namespace pg8 {
constexpr int BM = 256, BK = 64, HALF = 128, HTB = HALF * BK * 2, STAGE_BYTES = 8 * HTB, NXCD = 8, WGM = 8;
__host__ __device__ __forceinline__ int lds_byte(int r, int c) { const int st = (r >> 4) * 2 + (c >> 5), rr = r & 15, cc = c & 31, ob = rr * 64 + cc * 2; return st * 1024 + (ob ^ (((ob >> 9) & 1) << 5)); }
__host__ __device__ __forceinline__ void stage_rc(int b, int& R, int& C) { const int st = b / 1024, sb = b % 1024, swz = sb ^ (((sb >> 9) & 1) << 5); R = (st >> 1) * 16 + swz / 64; C = (st & 1) * 32 + (swz % 64) / 2; }
__host__ __device__ __forceinline__ int perm32(int rho) { const int n = rho >> 4, i = rho & 15; return 8 * (i >> 2) + 4 * n + (i & 3); }
struct Unit { int pm, pn; };
struct Gemm { const bf16_t* A; const bf16_t* Bt; int M, N, K, lda, ldb; };
struct StaticOrder {
  int nM, nN, nwg, G, c;
  __device__ void init(int M, int N, int G_, int c_) { nM = M / BM; nN = N / BM; nwg = nM * nN; G = G_; c = c_; }
  __device__ bool next(int i, Unit& u) const {
    const long L = (long)i * G + c; if (L >= nwg) return false;
    int wgid = (int)L; { const int q = nwg / NXCD, r = nwg % NXCD, xcd = wgid % NXCD, off = wgid / NXCD; wgid = (xcd < r ? xcd * (q + 1) : r * (q + 1) + (xcd - r) * q) + off; }
    const int nig = WGM * nN, gid = wgid / nig, fm = gid * WGM, gsz = (nM - fm) < WGM ? (nM - fm) : WGM;
    u.pm = fm + ((wgid % nig) % gsz); u.pn = (wgid % nig) / gsz; return true;
  }
};
template <int MODE> struct Epi {
  static constexpr bool PERM = true;
  bf16_t* O; int ldc; const float* rs;
  DI void operator()(const f32x4 (&acc)[2][2][4][2], const Unit& u, int wr, int wc, int fr, int fq) const {
    const int row0 = u.pm * BM + wr * 64 + fr;
    if constexpr (MODE == 2) {
      const int col0 = u.pn * HALF + wc * 32 + 8 * fq;
#pragma unroll
      for (int ai = 0; ai < 2; ++ai)
#pragma unroll
        for (int m = 0; m < 4; ++m) {
          const int row = row0 + ai * HALF + m * 16; const float r = rs[row];
          f32x4 g0 = acc[ai][0][m][0] * r, g1 = acc[ai][0][m][1] * r, u0 = acc[ai][1][m][0] * r, u1 = acc[ai][1][m][1] * r;
          float h[8];
#pragma unroll
          for (int e = 0; e < 4; ++e) { h[e] = siluf_(g0[e]) * u0[e]; h[4 + e] = siluf_(g1[e]) * u1[e]; }
          u32x4 w; w.x = cvtpk(h[0], h[1]); w.y = cvtpk(h[2], h[3]); w.z = cvtpk(h[4], h[5]); w.w = cvtpk(h[6], h[7]);
          *(u32x4*)(O + (size_t)row * ldc + col0) = w;
        }
    } else {
      const int col0 = u.pn * BM + wc * 32 + 8 * fq;
#pragma unroll
      for (int ai = 0; ai < 2; ++ai)
#pragma unroll
        for (int m = 0; m < 4; ++m) {
          const int row = row0 + ai * HALF + m * 16; float r = 1.f; if constexpr (MODE == 1) r = rs[row];
          bf16_t* rowp = O + (size_t)row * ldc + col0;
#pragma unroll
          for (int bj = 0; bj < 2; ++bj) { f32x4 v0 = acc[ai][bj][m][0] * r, v1 = acc[ai][bj][m][1] * r;
            u32x4 w; w.x = cvtpk(v0[0], v0[1]); w.y = cvtpk(v0[2], v0[3]); w.z = cvtpk(v1[0], v1[1]); w.w = cvtpk(v1[2], v1[3]);
            *(u32x4*)(rowp + bj * HALF) = w; }
        }
    }
  }
};

struct EpiRT {
  static constexpr bool PERM = true;
  int mode; bf16_t* O; int ldc; const float* rs;
  DI void operator()(const f32x4 (&acc)[2][2][4][2], const Unit& u, int wr, int wc, int fr, int fq) const {
    if (mode == 2) { Epi<2> e{O, ldc, rs}; e(acc, u, wr, wc, fr, fq); }
    else if (mode == 1) { Epi<1> e{O, ldc, rs}; e(acc, u, wr, wc, fr, fq); }
    else { Epi<0> e{O, ldc, rs}; e(acc, u, wr, wc, fr, fq); }
  }
};

template <class EpiT>
DI void gemm_phase(LAS unsigned char* lds, const Gemm g, const StaticOrder& S, const EpiT& E) {
  const int tid = threadIdx.x, wid = __builtin_amdgcn_readfirstlane(tid >> 6), lane = tid & 63, wr = wid >> 2, wc = wid & 3, fr = lane & 15, fq = lane >> 4;
  const int K = g.K, nt = K / BK;
  unsigned voffA[2], voffB[2];
#pragma unroll
  for (int i = 0; i < 2; ++i) { int R, C; stage_rc(tid * 16 + i * 8192, R, C); const int Rb = EpiT::PERM ? ((R & ~31) + perm32(R & 31)) : R;
    voffA[i] = (unsigned)(R * g.lda + C) * 2u; voffB[i] = (unsigned)(Rb * g.ldb + C) * 2u; }
  const size_t kstep = (size_t)(BK * 2);
  const size_t hstepA = (size_t)HALF * g.lda * 2, hstepB = (size_t)HALF * g.ldb * 2;
  const size_t tstepA = 2 * hstepA, tstepB = 2 * hstepB;
  const unsigned ldsw = (unsigned)wid * 1024u;
  const int aoff = lds_byte(wr * 64 + fr, fq * 8), boff = lds_byte(wc * 32 + fr, fq * 8);
#define PG8_SA(b, h) (((b) * 2 + (h)) * HTB)
#define PG8_SB(b, h) ((4 + (b) * 2 + (h)) * HTB)
#define PG8_STAGE(bufoff, gbase, voff) do { _Pragma("unroll") for (int _i = 0; _i < 2; ++_i) \
    __builtin_amdgcn_global_load_lds((const unsigned*)((const char*)(gbase) + (voff)[_i]), (LAS unsigned*)(lds + (bufoff) + ldsw + _i * 8192), 16, 0, 0); } while (0)
#define PG8_LDA(dst, b, h) do { _Pragma("unroll") for (int m = 0; m < 4; ++m) _Pragma("unroll") for (int k = 0; k < 2; ++k) dst[m][k] = *(const LAS bf16x8*)(lds + PG8_SA(b, h) + aoff + m * 2048 + k * 1024); } while (0)
#define PG8_LDB(dst, b, h) do { _Pragma("unroll") for (int n = 0; n < 2; ++n) _Pragma("unroll") for (int k = 0; k < 2; ++k) dst[n][k] = *(const LAS bf16x8*)(lds + PG8_SB(b, h) + boff + n * 2048 + k * 1024); } while (0)
#define PG8_MMA(ai, bj, At, Bt) do { __builtin_amdgcn_s_setprio(1); _Pragma("unroll") for (int m = 0; m < 4; ++m) _Pragma("unroll") for (int n = 0; n < 2; ++n) _Pragma("unroll") for (int k = 0; k < 2; ++k) \
    acc[ai][bj][m][n] = __builtin_amdgcn_mfma_f32_16x16x32_bf16(Bt[n][k], At[m][k], acc[ai][bj][m][n], 0, 0, 0); __builtin_amdgcn_s_setprio(0); } while (0)
#define PG8_WAIT_V(n) asm volatile("s_waitcnt vmcnt(" #n ")" ::: "memory")
#define PG8_WAIT_L(n) asm volatile("s_waitcnt lgkmcnt(" #n ")" ::: "memory")
#define PG8_BAR __builtin_amdgcn_s_barrier()
#define PG8_SCHED __builtin_amdgcn_sched_barrier(0)
  Unit cur, nxt; int ui = 0;
  if (!S.next(0, cur)) return;
  f32x4 acc[2][2][4][2];
#pragma unroll
  for (int a = 0; a < 2; ++a)
#pragma unroll
    for (int b = 0; b < 2; ++b)
#pragma unroll
      for (int m = 0; m < 4; ++m)
#pragma unroll
        for (int n = 0; n < 2; ++n) acc[a][b][m][n] = (f32x4){0.f, 0.f, 0.f, 0.f};
  bf16x8 At[4][2], B0[2][2], B1[2][2];
  const char* cA = (const char*)g.A + (size_t)cur.pm * tstepA; const char* cB = (const char*)g.Bt + (size_t)cur.pn * tstepB;
  PG8_STAGE(PG8_SB(0, 0), cB, voffB); PG8_STAGE(PG8_SB(0, 1), cB + hstepB, voffB); PG8_STAGE(PG8_SA(0, 0), cA, voffA); PG8_STAGE(PG8_SA(0, 1), cA + hstepA, voffA);
  if (wr == 1) PG8_BAR;
  PG8_WAIT_V(2); PG8_BAR;
  PG8_STAGE(PG8_SB(1, 0), cB + kstep, voffB); PG8_STAGE(PG8_SA(1, 0), cA + kstep, voffA); PG8_STAGE(PG8_SB(1, 1), cB + hstepB + kstep, voffB);
  PG8_WAIT_V(6); PG8_BAR;
  for (;;) {
    const bool has_next = S.next(ui + 1, nxt);
    const char* nA = has_next ? (const char*)g.A + (size_t)nxt.pm * tstepA : cA; const char* nB = has_next ? (const char*)g.Bt + (size_t)nxt.pn * tstepB : cB;
    for (int t = 0; t < nt; t += 2) {
      const bool last = (t == nt - 2);
      const char* a1 = cA + (size_t)(t + 1) * kstep;
      const char* a2 = last ? nA : cA + (size_t)(t + 2) * kstep; const char* b2 = last ? nB : cB + (size_t)(t + 2) * kstep;
      const char* a3 = a2 + kstep; const char* b3 = b2 + kstep;
      PG8_LDB(B0, 0, 0); PG8_LDB(B1, 0, 1); PG8_SCHED; PG8_LDA(At, 0, 0); PG8_STAGE(PG8_SA(1, 1), a1 + hstepA, voffA);
      PG8_WAIT_V(8); PG8_WAIT_L(0); PG8_BAR; PG8_MMA(0, 0, At, B0); PG8_MMA(0, 1, At, B1); PG8_BAR; PG8_SCHED;
      PG8_LDA(At, 0, 1); PG8_STAGE(PG8_SB(0, 0), b2, voffB); PG8_STAGE(PG8_SB(0, 1), b2 + hstepB, voffB); PG8_STAGE(PG8_SA(0, 0), a2, voffA);
      PG8_WAIT_V(8); PG8_WAIT_L(0); PG8_BAR; PG8_MMA(1, 0, At, B0); PG8_MMA(1, 1, At, B1); PG8_BAR; PG8_SCHED;
      PG8_LDB(B0, 1, 0); PG8_LDB(B1, 1, 1); PG8_SCHED; PG8_LDA(At, 1, 0); PG8_STAGE(PG8_SA(0, 1), a2 + hstepA, voffA);
      PG8_WAIT_V(8); PG8_WAIT_L(0); PG8_BAR; PG8_MMA(0, 0, At, B0); PG8_MMA(0, 1, At, B1); PG8_BAR; PG8_SCHED;
      PG8_LDA(At, 1, 1); PG8_STAGE(PG8_SB(1, 0), b3, voffB); PG8_STAGE(PG8_SB(1, 1), b3 + hstepB, voffB); PG8_STAGE(PG8_SA(1, 0), a3, voffA);
      PG8_WAIT_V(8); PG8_WAIT_L(0); PG8_BAR; PG8_MMA(1, 0, At, B0); PG8_MMA(1, 1, At, B1); PG8_BAR; PG8_SCHED;
    }
    if (wr == 0) PG8_BAR;
    E(acc, cur, wr, wc, fr, fq);
    if (!has_next) break;
#pragma unroll
    for (int a = 0; a < 2; ++a)
#pragma unroll
      for (int b = 0; b < 2; ++b)
#pragma unroll
        for (int m = 0; m < 4; ++m)
#pragma unroll
          for (int n = 0; n < 2; ++n) acc[a][b][m][n] = (f32x4){0.f, 0.f, 0.f, 0.f};
    cur = nxt; cA = nA; cB = nB; ++ui;
    if (wr == 1) PG8_BAR;
  }
  PG8_WAIT_V(0);
  PG8_BAR;
#undef PG8_SA
#undef PG8_SB
#undef PG8_STAGE
#undef PG8_LDA
#undef PG8_LDB
#undef PG8_MMA
#undef PG8_WAIT_V
#undef PG8_WAIT_L
#undef PG8_BAR
#undef PG8_SCHED
}
}

struct Args { const float* in[18]; float* out; unsigned char* ws; int ph_lo, ph_hi; };
struct Ctx {
  LAS unsigned char* lds;
  int tid, lane, wave, G, bid, z;
  unsigned char* ws; float* out;
};
enum { IN_X = 0, IN_NORMS, IN_WGU, IN_WD, IN_EWIN, IN_EWOUT, IN_LAM, IN_SUBLN, IN_MU, IN_VEC, IN_WUP, IN_AUP, IN_GUP, IN_V0, IN_VDOWN, IN_VUP, IN_OWIN, IN_OWOUT };

DI void transpose_item(const float* W, int K, int N, bf16_t* WT, int mode, const float* gain, int sc_lo, int sc_hi, float sc, LAS float* scr, int item, int lane) {
  const int nblk = N / 32, kb = item / nblk, nb = item % nblk, k0 = 64 * kb, n0 = 32 * nb;
  const float cs = (n0 >= sc_lo && n0 < sc_hi) ? sc : 1.f;
#pragma unroll 8
  for (int i = 0; i < 32; ++i) { const int kk = 2 * i + (lane >> 5); const float gk = gain ? gain[k0 + kk] * cs : cs;
    scr[kk * 33 + (lane & 31)] = W[(size_t)(k0 + kk) * N + n0 + (lane & 31)] * gk; }
  asm volatile("s_waitcnt lgkmcnt(0)" ::: "memory");
  int d0 = n0;
  if (mode == 1) d0 = (n0 < DFF) ? 256 * (n0 / 128) + (n0 % 128) : 256 * ((n0 - DFF) / 128) + 128 + ((n0 - DFF) % 128);
  const int c = lane & 7;
#pragma unroll
  for (int j = 0; j < 4; ++j) { const int n = (lane >> 3) + 8 * j; const LAS float* s = scr + (8 * c) * 33 + n;
    u32x4 o; o.x = cvtpk(s[0 * 33], s[1 * 33]); o.y = cvtpk(s[2 * 33], s[3 * 33]); o.z = cvtpk(s[4 * 33], s[5 * 33]); o.w = cvtpk(s[6 * 33], s[7 * 33]);
    *(u32x4*)(WT + (size_t)(d0 + n) * K + k0 + 8 * c) = o; }
  asm volatile("s_waitcnt lgkmcnt(0)" ::: "memory");
}

DI void convert_layer(const Ctx& c, const Args& a, int L) {
  LAS float* scr = (LAS float*)(c.lds + c.wave * 16384);
  const int gw = c.bid * NWAVES + c.wave, NGW = c.G * NWAVES;
  const bool even = (L & 1) == 0; const int j = L >> 1;
  const float* norms = a.in[c.z + IN_NORMS] + (size_t)L * 6 * DM;
  const float* wgu0 = a.in[c.z + IN_WGU] + (size_t)(L * 2 + 0) * DM * 2 * DFF; const float* wgu1 = a.in[c.z + IN_WGU] + (size_t)(L * 2 + 1) * DM * 2 * DFF;
  const float* wd0 = a.in[c.z + IN_WD] + (size_t)(L * 2 + 0) * DFF * DM; const float* wd1 = a.in[c.z + IN_WD] + (size_t)(L * 2 + 1) * DFF * DM;
  const float* win = even ? a.in[c.z + IN_EWIN] + (size_t)j * DM * EVEN_IN : a.in[c.z + IN_OWIN] + (size_t)j * DM * ODD_IN;
  const float* wout = even ? a.in[c.z + IN_EWOUT] + (size_t)j * DM * DM : a.in[c.z + IN_OWOUT] + (size_t)j * 2048 * DM;
  const int NIN = even ? EVEN_IN : ODD_IN, KOUT = even ? DM : 2048;
  const int I_GU = (DM / 64) * (2 * DFF / 32), I_D = (DFF / 64) * (DM / 32), I_IN = (DM / 64) * (NIN / 32), I_OUT = (KOUT / 64) * (DM / 32);
  const int NIT = 2 * I_GU + 2 * I_D + I_IN + I_OUT;
  bf16_t* WGU0 = (bf16_t*)(c.ws + WS_WGU0); bf16_t* WGU1 = (bf16_t*)(c.ws + WS_WGU1); bf16_t* WD0 = (bf16_t*)(c.ws + WS_WD0); bf16_t* WD1 = (bf16_t*)(c.ws + WS_WD1);
  bf16_t* WIN = (bf16_t*)(c.ws + WS_WIN); bf16_t* WOUT = (bf16_t*)(c.ws + WS_WOUT);
  if (even) {
    bf16_t* WUPT = (bf16_t*)(c.ws + WS_LORA); bf16_t* AUPT = WUPT + 512 * 64; bf16_t* GUPT = AUPT + 512 * 64; bf16_t* VDT = GUPT + 512 * 128; bf16_t* VUPT = VDT + 32 * 512;
    const float* w_up = a.in[c.z + IN_WUP] + (size_t)j * 64 * 512; const float* a_up = a.in[c.z + IN_AUP] + (size_t)j * 64 * 512; const float* g_up = a.in[c.z + IN_GUP] + (size_t)j * 128 * 512;
    const int NS = 16 + 16 + 32 + (j > 0 ? 8 : 0);
    for (int it = gw; it < NS; it += NGW) {
      int r = it;
      if (r < 16) { transpose_item(w_up, 64, 512, WUPT, 0, nullptr, 0, 0, 1.f, scr, r, c.lane); continue; } r -= 16;
      if (r < 16) { transpose_item(a_up, 64, 512, AUPT, 0, nullptr, 0, 0, 1.f, scr, r, c.lane); continue; } r -= 16;
      if (r < 32) { transpose_item(g_up, 128, 512, GUPT, 0, nullptr, 0, 0, 1.f, scr, r, c.lane); continue; } r -= 32;
      transpose_item(a.in[c.z + IN_VDOWN] + (size_t)(j - 1) * 512 * 32, 512, 32, VDT, 0, nullptr, 0, 0, 1.f, scr, r, c.lane);
    }
    if (j > 0) { const float* v_up = a.in[c.z + IN_VUP] + (size_t)(j - 1) * 32 * 512;
      for (int e = c.bid * NTHR + c.tid; e < 32 * 512; e += c.G * NTHR) { const int n = e >> 5, k = e & 31; VUPT[e] = f2bf(v_up[(size_t)k * 512 + n]); } }
  }
  for (int it = gw; it < NIT; it += NGW) {
    int r = it;
    if (r < I_GU) { transpose_item(wgu0, DM, 2 * DFF, WGU0, 1, norms + 0 * DM, 0, 0, 1.f, scr, r, c.lane); continue; } r -= I_GU;
    if (r < I_GU) { transpose_item(wgu1, DM, 2 * DFF, WGU1, 1, norms + 4 * DM, 0, 0, 1.f, scr, r, c.lane); continue; } r -= I_GU;
    if (r < I_D) { transpose_item(wd0, DFF, DM, WD0, 0, nullptr, 0, 0, 1.f, scr, r, c.lane); continue; } r -= I_D;
    if (r < I_D) { transpose_item(wd1, DFF, DM, WD1, 0, nullptr, 0, 0, 1.f, scr, r, c.lane); continue; } r -= I_D;
    if (r < I_IN) { transpose_item(win, DM, NIN, WIN, 0, norms + 2 * DM, even ? 0 : 1024, even ? 0 : 2048, 0.0625f, scr, r, c.lane); continue; } r -= I_IN;
    transpose_item(wout, KOUT, DM, WOUT, 0, nullptr, 0, 0, 1.f, scr, r, c.lane);
  }
}

DI void rowpass(const Ctx& c, const float* xin, const bf16_t* F, const float* gain, float coef) {
  const int gw = c.bid * NWAVES + c.wave, NGW = c.G * NWAVES;
  bf16_t* XB = (bf16_t*)(c.ws + WS_XB); float* RINV = (float*)(c.ws + WS_RINV);
  f32x4 gv[4];
  if (F) {
#pragma unroll
    for (int j = 0; j < 4; ++j) gv[j] = *(const f32x4*)(gain + 256 * j + 4 * c.lane);
  }
  for (int row = gw; row < M_TOK; row += NGW) {
    const f32x4* xr = (const f32x4*)(xin + (size_t)row * DM) + c.lane;
    f32x4 v[4];
#pragma unroll
    for (int j = 0; j < 4; ++j) v[j] = xr[64 * j];
    if (F) {
      const u32x2* fr = (const u32x2*)(F + (size_t)row * DM) + c.lane;
      f32x4 f[4]; float ss = 0.f;
#pragma unroll
      for (int j = 0; j < 4; ++j) { const u32x2 w = fr[64 * j];
        f[j] = (f32x4){__uint_as_float(w.x << 16), __uint_as_float(w.x & 0xffff0000u), __uint_as_float(w.y << 16), __uint_as_float(w.y & 0xffff0000u)};
        ss += (f[j].x * f[j].x + f[j].y * f[j].y) + (f[j].z * f[j].z + f[j].w * f[j].w); }
      const float r = coef * __builtin_amdgcn_rsqf(wave_sum(ss) * (1.f / DM) + NORM_EPS);
#pragma unroll
      for (int j = 0; j < 4; ++j) v[j] = v[j] + f[j] * gv[j] * r;
    }
    float s2 = 0.f;
#pragma unroll
    for (int j = 0; j < 4; ++j) s2 += (v[j].x * v[j].x + v[j].y * v[j].y) + (v[j].z * v[j].z + v[j].w * v[j].w);
    s2 = wave_sum(s2);
    f32x4* xo = (f32x4*)(c.out + (size_t)row * DM) + c.lane;
    u32x2* xb = (u32x2*)(XB + (size_t)row * DM) + c.lane;
#pragma unroll
    for (int j = 0; j < 4; ++j) { xo[64 * j] = v[j]; u32x2 w; w.x = cvtpk(v[j].x, v[j].y); w.y = cvtpk(v[j].z, v[j].w); xb[64 * j] = w; }
    if (c.lane == 0) RINV[row] = __builtin_amdgcn_rsqf(s2 * (1.f / DM) + NORM_EPS);
  }
}

DI f32x4 ld_bf4(const bf16_t* p) { const u32x2 w = *(const u32x2*)p; return (f32x4){__uint_as_float(w.x << 16), __uint_as_float(w.x & 0xffff0000u), __uint_as_float(w.y << 16), __uint_as_float(w.y & 0xffff0000u)}; }
DI void st_bf4(bf16_t* p, f32x4 v) { u32x2 w; w.x = cvtpk(v.x, v.y); w.y = cvtpk(v.z, v.w); *(u32x2*)p = w; }
DI void rwkv_prep(const Ctx& c, const Args& a, int j) {
  const bf16_t* Z = (const bf16_t*)(c.ws + WS_ZEVEN);
  bf16_t* RW = (bf16_t*)(c.ws + WS_RW);
  bf16_t* VF = (bf16_t*)(c.ws + WS_VFIRST);
  const bf16_t* WUPT = (const bf16_t*)(c.ws + WS_LORA); const bf16_t* AUPT = WUPT + 512 * 64; const bf16_t* GUPT = AUPT + 512 * 64;
  const bf16_t* VDT = GUPT + 512 * 128; const bf16_t* VUPT = VDT + 32 * 512;
  const float* mu = a.in[c.z + IN_MU] + (size_t)j * 1792;
  const float* vec = a.in[c.z + IN_VEC] + (size_t)j * 7 * 512;
  const bool vres = j > 0;
  const float* v0p = a.in[c.z + IN_V0] + (size_t)(j > 0 ? j - 1 : 0) * 512;
  constexpr int XS = 528, VS = 1040, US = 80;
  LAS unsigned char* xsb = c.lds; LAS unsigned char* vsb = c.lds + 16896; LAS unsigned char* ub = c.lds + 50176;
  const int tid = c.tid, lane = c.lane, w = c.wave, l15 = lane & 15, quad = lane >> 4;
  for (int u = c.bid; u < M_TOK / 32; u += c.G) {
    const int t0 = u * 32; const bool first = (t0 % SEQ) == 0;
    __syncthreads();
    {
      const int cc = tid & 255, tg = tid >> 8; const float m = mu[1536 + cc];
      const int tb = t0 + tg * 16;
      float prev = (first && tg == 0) ? 0.f : bf2f(Z[(size_t)(tb - 1) * EVEN_IN + 3072 + cc]);
#pragma unroll 4
      for (int i = 0; i < 16; ++i) { const float cur = bf2f(Z[(size_t)(tb + i) * EVEN_IN + 3072 + cc]); const float zs = cur + (prev - cur) * m; prev = cur;
        const float val = cc < 64 ? tanhf_(zs) : (cc < 128 ? zs : sigmoidf_(zs)); *(LAS bf16_t*)(xsb + (tg * 16 + i) * XS + cc * 2) = f2bf(val); }
    }
    __syncthreads();
#pragma unroll 1
    for (int tt = 0; tt < 2; ++tt) {
      const int t = t0 + 16 * tt + l15; const bool tfirst = (t % SEQ) == 0;
      const LAS unsigned char* xr = xsb + (16 * tt + l15) * XS + quad * 16;
      float ss = 0.f;
#pragma unroll 2
      for (int ct = 0; ct < 4; ++ct) {
        const int col = 64 * w + 16 * ct + 4 * quad;
        const size_t wr = (size_t)(64 * w + 16 * ct + l15);
        f32x4 x = {0.f, 0.f, 0.f, 0.f}, z = x;
#pragma unroll
        for (int ks = 0; ks < 2; ++ks) x = MFMA16(*(const bf16x8*)(WUPT + wr * 64 + 32 * ks + 8 * quad), *(const LAS bf16x8*)(xr + ks * 64), x);
#pragma unroll
        for (int ks = 0; ks < 4; ++ks) z = MFMA16(*(const bf16x8*)(GUPT + wr * 128 + 32 * ks + 8 * quad), *(const LAS bf16x8*)(xr + 256 + ks * 64), z);
        const bf16_t* zp = Z + (size_t)t * EVEN_IN + 1536 + col;
        const f32x4 cr = ld_bf4(zp), ck = ld_bf4(zp + 512), cv = ld_bf4(zp + 1024);
        f32x4 pr = {0.f, 0.f, 0.f, 0.f}, pk = pr, pv = pr;
        if (!tfirst) { pr = ld_bf4(zp - EVEN_IN); pk = ld_bf4(zp - EVEN_IN + 512); pv = ld_bf4(zp - EVEN_IN + 1024); }
        const f32x4 mr = *(const f32x4*)(mu + col), mk = *(const f32x4*)(mu + 512 + col), mv = *(const f32x4*)(mu + 1024 + col);
        const f32x4 w0 = *(const f32x4*)(vec + col), k_k = *(const f32x4*)(vec + 1024 + col);
        const f32x4 rr = cr + (pr - cr) * mr, k1 = ck + (pk - ck) * mk, vv = cv + (pv - cv) * mv;
        f32x4 ew;
#pragma unroll
        for (int e = 0; e < 4; ++e) ew[e] = 0.60653065971f * sigmoidf_(w0[e] + x[e]);
        const f32x4 kkr = k1 * k_k; ss += (kkr.x * kkr.x + kkr.y * kkr.y) + (kkr.z * kkr.z + kkr.w * kkr.w);
        const size_t o = (size_t)t * 512 + col;
        st_bf4(RW + 0 * RW_STRIDE + o, ew); st_bf4(RW + 4 * RW_STRIDE + o, rr); st_bf4(RW + 6 * RW_STRIDE + o, z);
        if (!vres) { st_bf4(RW + 5 * RW_STRIDE + o, vv); st_bf4(VF + o, vv); }
        else { u32x2 wv; wv.x = cvtpk(vv.x, vv.y); wv.y = cvtpk(vv.z, vv.w); *(LAS u32x2*)(vsb + (16 * tt + l15) * VS + col * 2) = wv; }
      }
      ss += __shfl_xor(ss, 16); ss += __shfl_xor(ss, 32);
      const float rinv = 1.f / fmaxf(sqrtf(ss), 1e-12f);
#pragma unroll 2
      for (int ct = 0; ct < 4; ++ct) {
        const int col = 64 * w + 16 * ct + 4 * quad;
        const size_t wr = (size_t)(64 * w + 16 * ct + l15);
        f32x4 y = {0.f, 0.f, 0.f, 0.f};
#pragma unroll
        for (int ks = 0; ks < 2; ++ks) y = MFMA16(*(const bf16x8*)(AUPT + wr * 64 + 32 * ks + 8 * quad), *(const LAS bf16x8*)(xr + 128 + ks * 64), y);
        const bf16_t* zp = Z + (size_t)t * EVEN_IN + 1536 + 512 + col;
        const f32x4 ck = ld_bf4(zp); f32x4 pk = {0.f, 0.f, 0.f, 0.f};
        if (!tfirst) pk = ld_bf4(zp - EVEN_IN);
        const f32x4 mk = *(const f32x4*)(mu + 512 + col), a0 = *(const f32x4*)(vec + 512 + col);
        const f32x4 k_k = *(const f32x4*)(vec + 1024 + col), k_a = *(const f32x4*)(vec + 1536 + col);
        const f32x4 k1 = ck + (pk - ck) * mk;
        f32x4 a1;
#pragma unroll
        for (int e = 0; e < 4; ++e) a1[e] = sigmoidf_(a0[e] + y[e]);
        const f32x4 kk = k1 * k_k * rinv;
        const f32x4 kmod = k1 * (1.f + (a1 - 1.f) * k_a);
        const size_t o = (size_t)t * 512 + col;
        st_bf4(RW + 1 * RW_STRIDE + o, kk); st_bf4(RW + 2 * RW_STRIDE + o, kk * a1); st_bf4(RW + 3 * RW_STRIDE + o, kmod);
      }
    }
    if (vres) {
      __syncthreads();
      if (w < 4) { const int mt = w >> 1, tt = w & 1; f32x4 acc = {0.f, 0.f, 0.f, 0.f};
#pragma unroll 4
        for (int ks = 0; ks < 16; ++ks) acc = MFMA16(*(const bf16x8*)(VDT + (size_t)(16 * mt + l15) * 512 + 32 * ks + 8 * quad), *(const LAS bf16x8*)(vsb + (16 * tt + l15) * VS + (32 * ks + 8 * quad) * 2), acc);
        u32x2 wv; wv.x = cvtpk(acc.x, acc.y); wv.y = cvtpk(acc.z, acc.w); *(LAS u32x2*)(ub + (16 * tt + l15) * US + (16 * mt + 4 * quad) * 2) = wv; }
      __syncthreads();
#pragma unroll 2
      for (int ct = 0; ct < 4; ++ct) {
        const int col = 64 * w + 16 * ct + 4 * quad;
        const bf16x8 fu = *(const bf16x8*)(VUPT + (size_t)(64 * w + 16 * ct + l15) * 32 + 8 * quad);
        const f32x4 v0 = *(const f32x4*)(v0p + col);
#pragma unroll
        for (int tt = 0; tt < 2; ++tt) {
          f32x4 sacc = {0.f, 0.f, 0.f, 0.f};
          sacc = MFMA16(fu, *(const LAS bf16x8*)(ub + (16 * tt + l15) * US + quad * 16), sacc);
          const size_t o = (size_t)(t0 + 16 * tt + l15) * 512 + col;
          const u32x2 wv = *(const LAS u32x2*)(vsb + (16 * tt + l15) * VS + col * 2);
          const f32x4 vv = {__uint_as_float(wv.x << 16), __uint_as_float(wv.x & 0xffff0000u), __uint_as_float(wv.y << 16), __uint_as_float(wv.y & 0xffff0000u)};
          const f32x4 vf = ld_bf4(VF + o); f32x4 r;
#pragma unroll
          for (int e = 0; e < 4; ++e) r[e] = vv[e] + (vf[e] - vv[e]) * sigmoidf_(v0[e] + sacc[e]);
          st_bf4(RW + 5 * RW_STRIDE + o, r);
        }
      }
    }
  }
}

DI void rwkv_scan_item(const Ctx& c, int item) {
  const int bh = item >> 2, qtr = item & 3, b = bh >> 3, h = bh & 7;
  const bf16_t* RW = (const bf16_t*)(c.ws + WS_RW);
  bf16_t* MIX = (bf16_t*)(c.ws + WS_MIXE);
  const int tid = c.tid, lane = c.lane, rg = lane >> 4, c4 = lane & 15, row = (c.wave & 3) * 4 + rg;
  constexpr int BUF_F = 32 * 320 + 32 * 16;
  LAS float* buf0 = (LAS float*)c.lds;
  LAS float* ybuf = (LAS float*)c.lds + 2 * BUF_F;
  const size_t tokbase = (size_t)b * SEQ;
  const int i2 = tid & 255;
  const int l_step = i2 >> 3, l_c8 = i2 & 7, l_arr = tid >> 8;
  const bf16_t* src01 = RW + (size_t)l_arr * RW_STRIDE + (tokbase + l_step) * 512 + h * 64 + l_c8 * 8;
  const int vid = tid - 256;
  const bf16_t* srcv = RW + 5 * RW_STRIDE + (tokbase + ((vid >> 1) & 31)) * 512 + h * 64 + qtr * 16 + (vid & 1) * 8;
  bf16x8 p0, p1, p2;
  auto issue = [&](int ch) {
    const size_t off = (size_t)ch * 32 * 512;
    p0 = *(const bf16x8*)(src01 + off); p1 = *(const bf16x8*)(src01 + 2 * RW_STRIDE + off);
    if (tid < 256) p2 = *(const bf16x8*)(src01 + 4 * RW_STRIDE + off);
    else if (tid < 320) p2 = *(const bf16x8*)(srcv + off);
  };
  auto stash = [&](int bsel) {
    LAS float* B = buf0 + bsel * BUF_F;
    float f[8];
    { unpack8(p0, f); LAS float* d = B + l_step * 320 + l_arr * 64 + l_c8 * 8;
      if (l_arr == 0) {
#pragma unroll
        for (int e = 0; e < 8; ++e) f[e] = __builtin_amdgcn_exp2f(-f[e] * LOG2E);
      } else {
#pragma unroll
        for (int e = 0; e < 8; ++e) f[e] = -f[e];
      }
      *(LAS f32x4*)d = (f32x4){f[0], f[1], f[2], f[3]}; *(LAS f32x4*)(d + 4) = (f32x4){f[4], f[5], f[6], f[7]}; }
    { unpack8(p1, f); LAS float* d = B + l_step * 320 + (l_arr + 2) * 64 + l_c8 * 8;
      *(LAS f32x4*)d = (f32x4){f[0], f[1], f[2], f[3]}; *(LAS f32x4*)(d + 4) = (f32x4){f[4], f[5], f[6], f[7]}; }
    if (tid < 256) { unpack8(p2, f); LAS float* d = B + l_step * 320 + 4 * 64 + l_c8 * 8;
      *(LAS f32x4*)d = (f32x4){f[0], f[1], f[2], f[3]}; *(LAS f32x4*)(d + 4) = (f32x4){f[4], f[5], f[6], f[7]}; }
    else if (tid < 320) { unpack8(p2, f); LAS float* d = B + 32 * 320 + (vid >> 1) * 16 + (vid & 1) * 8;
      *(LAS f32x4*)d = (f32x4){f[0], f[1], f[2], f[3]}; *(LAS f32x4*)(d + 4) = (f32x4){f[4], f[5], f[6], f[7]}; }
  };
  __syncthreads();
  issue(0); stash(0);
  if (1 < SEQ / 32) issue(1);
  __syncthreads();
  f32x2 S0 = {0.f, 0.f}, S1 = {0.f, 0.f};
#pragma unroll 1
  for (int ch = 0; ch < SEQ / 32; ++ch) {
    if (ch + 1 < SEQ / 32) stash((ch + 1) & 1);
    if (ch + 2 < SEQ / 32) issue(ch + 2);
    LAS float* yb = ybuf + (ch & 1) * 512;
    if (c.wave < 4) {
      const LAS float* B = buf0 + (ch & 1) * BUF_F;
      const LAS float* Lb = B + c4 * 4; const LAS float* Vb = B + 32 * 320 + row;
      float yk0 = 0.f, yk1 = 0.f;
      f32x4 dw = *(const LAS f32x4*)(Lb), nk = *(const LAS f32x4*)(Lb + 64), ka = *(const LAS f32x4*)(Lb + 128), kv = *(const LAS f32x4*)(Lb + 192), rv = *(const LAS f32x4*)(Lb + 256);
      float vv = Vb[0];
#pragma unroll
      for (int s = 0; s < 32; ++s) {
        f32x4 dwn = dw, nkn = nk, kan = ka, kvn = kv, rvn = rv; float vvn = vv;
        if (s + 1 < 32) { const LAS float* L = Lb + (s + 1) * 320;
          dwn = *(const LAS f32x4*)(L); nkn = *(const LAS f32x4*)(L + 64); kan = *(const LAS f32x4*)(L + 128); kvn = *(const LAS f32x4*)(L + 192); rvn = *(const LAS f32x4*)(L + 256);
          vvn = Vb[(s + 1) * 16]; }
        __builtin_amdgcn_sched_barrier(0);
        f32x2 t = S0 * (f32x2){nk.x, nk.y}; t = S1 * (f32x2){nk.z, nk.w} + t;
        const float sa = row16_sum(t.x + t.y);
        const f32x2 tk0 = (f32x2){kv.x, kv.y} * vv, tk1 = (f32x2){kv.z, kv.w} * vv;
        S0 = S0 * (f32x2){dw.x, dw.y} + tk0; S1 = S1 * (f32x2){dw.z, dw.w} + tk1;
        S0 = (f32x2){ka.x, ka.y} * sa + S0; S1 = (f32x2){ka.z, ka.w} * sa + S1;
        f32x2 u = S0 * (f32x2){rv.x, rv.y}; u = S1 * (f32x2){rv.z, rv.w} + u;
        const float y = row16_sum(u.x + u.y);
        if (s < 16) yk0 = (c4 == s) ? y : yk0; else yk1 = (c4 == s - 16) ? y : yk1;
        __builtin_amdgcn_sched_barrier(0);
        dw = dwn; nk = nkn; ka = kan; kv = kvn; rv = rvn; vv = vvn;
      }
      yb[c4 * 16 + row] = yk0; yb[(16 + c4) * 16 + row] = yk1;
    }
    __syncthreads();
    if (tid < 256) { const int s = tid >> 3, r2 = (tid & 7) * 2; const float y0 = yb[s * 16 + r2], y1 = yb[s * 16 + r2 + 1];
      *(unsigned*)(MIX + (tokbase + ch * 32 + s) * 1024 + 512 + h * 64 + qtr * 16 + r2) = cvtpk(y0, y1); }
  }
}

DI void attn_unit(const Ctx& c, const Args& a, int j, int b, int h, int c2, float lam, float lam_init) {
  const bf16_t* Z = (const bf16_t*)(c.ws + WS_ZEVEN) + (size_t)b * SEQ * EVEN_IN;
  bf16_t* MIX = (bf16_t*)(c.ws + WS_MIXE) + (size_t)b * SEQ * 1024;
  const float* subln = a.in[c.z + IN_SUBLN] + (size_t)j * 128;
  const int tid = c.tid, lane = c.lane, wave = c.wave, l15 = lane & 15, quad = lane >> 4, q_ = l15 >> 2, p_ = l15 & 3;
  const int q0 = 128 * c2 + 16 * wave, my_chunk = 2 * c2 + (wave >> 2), nkt = 2 * c2 + 2;
  constexpr int RS = 272, IMG = 64 * RS, BUFB = 2 * IMG;
  bf16x8 qf[2][2];
#pragma unroll
  for (int m = 0; m < 2; ++m)
#pragma unroll
    for (int ks = 0; ks < 2; ++ks) qf[m][ks] = *(const bf16x8*)(Z + (size_t)(q0 + l15) * EVEN_IN + h * 128 + m * 64 + ks * 32 + quad * 8);
  f32x4 o[2][8];
#pragma unroll
  for (int m = 0; m < 2; ++m)
#pragma unroll
    for (int d = 0; d < 8; ++d) o[m][d] = (f32x4){0.f, 0.f, 0.f, 0.f};
  float mrun[2] = {-1e30f, -1e30f}, lrun[2] = {0.f, 0.f};
  const float slope2 = __builtin_amdgcn_exp2f(-2.f * (float)(h + 1)) * LOG2E, sc2 = 0.125f * LOG2E;
  u32x4 pf[4];
  const int prow = tid >> 4, pc16 = tid & 15;
  const bf16_t* ksrc = Z + (size_t)prow * EVEN_IN + 512 + h * 128 + pc16 * 8;
  auto issue = [&](int kt) {
    const bf16_t* s = ksrc + (size_t)kt * 64 * EVEN_IN;
    pf[0] = *(const u32x4*)(s); pf[1] = *(const u32x4*)(s + (size_t)32 * EVEN_IN);
    pf[2] = *(const u32x4*)(s + 512); pf[3] = *(const u32x4*)(s + (size_t)32 * EVEN_IN + 512);
  };
  auto stash = [&](int bsel) {
    LAS unsigned char* B = c.lds + bsel * BUFB + prow * RS + pc16 * 16;
    *(LAS u32x4*)(B) = pf[0]; *(LAS u32x4*)(B + 32 * RS) = pf[1]; *(LAS u32x4*)(B + IMG) = pf[2]; *(LAS u32x4*)(B + IMG + 32 * RS) = pf[3];
  };
  issue(0); stash(0);
  __syncthreads();
#pragma unroll 1
  for (int kt = 0; kt < nkt; ++kt) {
    const bool has_next = kt + 1 < nkt;
    if (has_next) issue(kt + 1);
    if (kt <= my_chunk) {
      const LAS unsigned char* Kb = c.lds + (kt & 1) * BUFB; const LAS unsigned char* Vb = Kb + IMG;
      f32x4 s[2][4];
#pragma unroll
      for (int m = 0; m < 2; ++m)
#pragma unroll
        for (int t16 = 0; t16 < 4; ++t16) { f32x4 acc = {0.f, 0.f, 0.f, 0.f};
#pragma unroll
          for (int ks = 0; ks < 2; ++ks) { const bf16x8 kf = *(const LAS bf16x8*)(Kb + (16 * t16 + l15) * RS + (m * 64 + ks * 32 + quad * 8) * 2); acc = MFMA16(kf, qf[m][ks], acc); }
          s[m][t16] = acc; }
      const float dbase = (float)(q0 + l15 - 64 * kt - 4 * quad);
      bf16x8 pfr[2][2];
#pragma unroll
      for (int m = 0; m < 2; ++m) {
        float mx = -1e30f;
#pragma unroll
        for (int t16 = 0; t16 < 4; ++t16)
#pragma unroll
          for (int e = 0; e < 4; ++e) { const float d = __builtin_fabsf(dbase - (float)(16 * t16 + e)); const float v = s[m][t16][e] * sc2 - slope2 * d; s[m][t16][e] = v; mx = fmaxf(mx, v); }
        mx = fmaxf(mx, __shfl_xor(mx, 16)); mx = fmaxf(mx, __shfl_xor(mx, 32));
        const float mnew = fmaxf(mrun[m], mx), alpha = __builtin_amdgcn_exp2f(mrun[m] - mnew); mrun[m] = mnew;
        float ps = 0.f;
#pragma unroll
        for (int t16 = 0; t16 < 4; ++t16)
#pragma unroll
          for (int e = 0; e < 4; ++e) { const float p = __builtin_amdgcn_exp2f(s[m][t16][e] - mnew); s[m][t16][e] = p; ps += p; }
        lrun[m] = lrun[m] * alpha + ps;
#pragma unroll
        for (int d = 0; d < 8; ++d) o[m][d] = o[m][d] * alpha;
#pragma unroll
        for (int s2 = 0; s2 < 2; ++s2) { u32x4 w; w.x = cvtpk(s[m][2 * s2][0], s[m][2 * s2][1]); w.y = cvtpk(s[m][2 * s2][2], s[m][2 * s2][3]);
          w.z = cvtpk(s[m][2 * s2 + 1][0], s[m][2 * s2 + 1][1]); w.w = cvtpk(s[m][2 * s2 + 1][2], s[m][2 * s2 + 1][3]); pfr[m][s2] = __builtin_bit_cast(bf16x8, w); }
      }
#pragma unroll
      for (int s2 = 0; s2 < 2; ++s2)
#pragma unroll
        for (int d = 0; d < 8; ++d) {
          const LAS unsigned char* vp = Vb + (32 * s2 + 4 * quad + q_) * RS + (16 * d + 4 * p_) * 2;
          const bf16x8 vf = comb8(tr_read(vp), tr_read(vp + 16 * RS));
          o[0][d] = MFMA16(vf, pfr[0][s2], o[0][d]); o[1][d] = MFMA16(vf, pfr[1][s2], o[1][d]);
        }
    }
    if (has_next) stash((kt + 1) & 1);
    __syncthreads();
  }
  float inv[2];
#pragma unroll
  for (int m = 0; m < 2; ++m) { float l = lrun[m]; l += __shfl_xor(l, 16); l += __shfl_xor(l, 32); inv[m] = 1.f / l; }
  const float i1 = lam * inv[1];
  float ss = 0.f;
#pragma unroll
  for (int d = 0; d < 8; ++d)
#pragma unroll
    for (int e = 0; e < 4; ++e) { const float v = o[0][d][e] * inv[0] - o[1][d][e] * i1; o[0][d][e] = v; ss += v * v; }
  ss += __shfl_xor(ss, 16); ss += __shfl_xor(ss, 32);
  const float rn = __builtin_amdgcn_rsqf(ss * (1.f / 128.f) + NORM_EPS) * (1.f - lam_init);
  bf16_t* orow = MIX + (size_t)(q0 + l15) * 1024 + h * 128 + 4 * quad;
#pragma unroll
  for (int d = 0; d < 8; ++d) { const f32x4 g = *(const f32x4*)(subln + 16 * d + 4 * quad);
    u32x2 w; w.x = cvtpk(o[0][d][0] * rn * g.x, o[0][d][1] * rn * g.y); w.y = cvtpk(o[0][d][2] * rn * g.z, o[0][d][3] * rn * g.w);
    *(u32x2*)(orow + 16 * d) = w; }
}

DI void attn_phase(const Ctx& c, const Args& a, int j, int layer, unsigned* counter) {
  const float* lv = a.in[c.z + IN_LAM] + (size_t)j * 4 * 64;
  const float lam_init = 0.8f - 0.6f * __expf(-0.3f * (float)layer);
  const float d1 = wave_sum(lv[c.lane] * lv[64 + c.lane]), d2 = wave_sum(lv[128 + c.lane] * lv[192 + c.lane]);
  const float lam = __expf(d1) - __expf(d2) + lam_init;
  LAS int* qw = (LAS int*)(c.lds + LDS_MAIN + 64);
  const int x = c.bid & 7;
  unsigned* cnt = counter + x;
  for (;;) {
    __syncthreads();
    if (c.tid == 0) *qw = (int)atomicAdd(cnt, 1u);
    __syncthreads();
    const int item = *qw;
    if (item >= 128) break;
    const int c2 = 31 - (item & 31), bh = x * 4 + (item >> 5);
    attn_unit(c, a, j, bh >> 2, bh & 3, c2, lam, lam_init);
  }
}

DI void rwkv_post(const Ctx& c, const Args& a, int j) {
  const bf16_t* RW = (const bf16_t*)(c.ws + WS_RW);
  bf16_t* MIX = (bf16_t*)(c.ws + WS_MIXE);
  const float* vec = a.in[c.z + IN_VEC] + (size_t)j * 7 * 512;
  const int gw = c.bid * NWAVES + c.wave, NGW = c.G * NWAVES;
  for (int p = gw; p < M_TOK * 8; p += NGW) {
    const int t = p >> 3, h = p & 7, cc = h * 64 + c.lane; const size_t o = (size_t)t * 512 + cc;
    const float y = bf2f(MIX[(size_t)t * 1024 + 512 + cc]);
    const float r = bf2f(RW[4 * RW_STRIDE + o]), k = bf2f(RW[3 * RW_STRIDE + o]), v = bf2f(RW[5 * RW_STRIDE + o]), g = bf2f(RW[6 * RW_STRIDE + o]);
    const float mean = wave_sum(y) * (1.f / 64.f), d = y - mean, var = wave_sum(d * d) * (1.f / 64.f);
    const float yn = d * __builtin_amdgcn_rsqf(var + 64e-5f) * vec[5 * 512 + cc] + vec[6 * 512 + cc];
    const float bonus = wave_sum(r * k * vec[4 * 512 + cc]) * v;
    MIX[(size_t)t * 1024 + 512 + cc] = f2bf((yn + bonus) * g);
  }
}

DI void retention_unit(const Ctx& c, int bh, int slice) {
  const int b = bh >> 2, h = bh & 3;
  const bf16_t* Z = (const bf16_t*)(c.ws + WS_ZODD) + (size_t)b * SEQ * ODD_IN;
  bf16_t* YB = (bf16_t*)(c.ws + WS_YB) + (size_t)b * SEQ * 2048 + h * 512 + slice * 64;
  const int tid = c.tid, lane = c.lane, wave = c.wave, l15 = lane & 15, quad = lane >> 4, q_ = l15 >> 2, p_ = l15 & 3;
  constexpr int RQ = 528, RV = 144;
  LAS unsigned char* Qi = c.lds; LAS unsigned char* Ki = c.lds + 33792; LAS unsigned char* Vi = c.lds + 67584; LAS unsigned char* Vdi = c.lds + 76800;
  LAS unsigned char* Sci = c.lds + 86016; LAS unsigned char* Si = c.lds + 95232;
  const float log2g = __log2f(1.f - __builtin_amdgcn_exp2f(-5.f - (float)h));
  const float cd = __builtin_amdgcn_exp2f(log2g * 64.f);
  f32x4 st[2][4];
#pragma unroll
  for (int mt = 0; mt < 2; ++mt)
#pragma unroll
    for (int nt = 0; nt < 4; ++nt) st[mt][nt] = (f32x4){0.f, 0.f, 0.f, 0.f};
  u32x4 pq[4], pk[4], pv;
  const int prow = tid >> 5, pc = tid & 31;
  const bf16_t* qsrc = Z + (size_t)prow * ODD_IN + h * 256 + pc * 8;
  const int vrow = tid >> 3, vc = tid & 7;
  const bf16_t* vsrc = Z + (size_t)vrow * ODD_IN + 2048 + h * 512 + slice * 64 + vc * 8;
  auto issue = [&](int ch) {
    const size_t off = (size_t)ch * 64 * ODD_IN;
#pragma unroll
    for (int i = 0; i < 4; ++i) { pq[i] = *(const u32x4*)(qsrc + off + (size_t)(16 * i) * ODD_IN); pk[i] = *(const u32x4*)(qsrc + off + (size_t)(16 * i) * ODD_IN + 1024); }
    pv = *(const u32x4*)(vsrc + off);
  };
  auto stash = [&]() {
#pragma unroll
    for (int i = 0; i < 4; ++i) { *(LAS u32x4*)(Qi + (prow + 16 * i) * RQ + pc * 16) = pq[i]; *(LAS u32x4*)(Ki + (prow + 16 * i) * RQ + pc * 16) = pk[i]; }
    *(LAS u32x4*)(Vi + vrow * RV + vc * 16) = pv;
  };
  __syncthreads();
  issue(0);
  for (int i = tid; i < 33792 / 16; i += NTHR) *(LAS u32x4*)(Si + i * 16) = (u32x4){0u, 0u, 0u, 0u};
  stash();
  __syncthreads();
#pragma unroll 1
  for (int ch = 0; ch < 64; ++ch) {
    if (ch + 1 < 64) issue(ch + 1);
    {
      const int it = wave >> 1;
#pragma unroll
      for (int jj2 = 0; jj2 < 2; ++jj2) { const int jt = 2 * (wave & 1) + jj2; f32x4 acc = {0.f, 0.f, 0.f, 0.f};
#pragma unroll
        for (int ks = 0; ks < 8; ++ks) { const bf16x8 kf = *(const LAS bf16x8*)(Ki + (16 * jt + l15) * RQ + (32 * ks + 8 * quad) * 2);
          const bf16x8 qf = *(const LAS bf16x8*)(Qi + (16 * it + l15) * RQ + (32 * ks + 8 * quad) * 2); acc = MFMA16(kf, qf, acc); }
        const int i = 16 * it + l15, j0 = 16 * jt + 4 * quad; float v[4];
#pragma unroll
        for (int e = 0; e < 4; ++e) v[e] = acc[e] * __builtin_amdgcn_exp2f(log2g * __builtin_fabsf((float)(i - j0 - e)));
        u32x2 w; w.x = cvtpk(v[0], v[1]); w.y = cvtpk(v[2], v[3]); *(LAS u32x2*)(Sci + i * RV + j0 * 2) = w; }
      { const bf16x8 v8 = *(const LAS bf16x8*)(Vi + vrow * RV + vc * 16); float f[8]; unpack8(v8, f); const float kd = __builtin_amdgcn_exp2f(log2g * (float)(63 - vrow));
        u32x4 w; w.x = cvtpk(f[0] * kd, f[1] * kd); w.y = cvtpk(f[2] * kd, f[3] * kd); w.z = cvtpk(f[4] * kd, f[5] * kd); w.w = cvtpk(f[6] * kd, f[7] * kd);
        *(LAS u32x4*)(Vdi + vrow * RV + vc * 16) = w; }
    }
    __syncthreads();
    {
      const int et = wave >> 1;
#pragma unroll
      for (int ii = 0; ii < 2; ++ii) { const int it2 = 2 * (wave & 1) + ii; f32x4 acc = {0.f, 0.f, 0.f, 0.f};
#pragma unroll
        for (int ks = 0; ks < 8; ++ks) { const bf16x8 sf = *(const LAS bf16x8*)(Si + (16 * et + l15) * RQ + (32 * ks + 8 * quad) * 2);
          const bf16x8 qf = *(const LAS bf16x8*)(Qi + (16 * it2 + l15) * RQ + (32 * ks + 8 * quad) * 2); acc = MFMA16(sf, qf, acc); }
        const float qd = __builtin_amdgcn_exp2f(log2g * (float)(16 * it2 + l15 + 1)); acc = acc * qd;
#pragma unroll
        for (int s = 0; s < 2; ++s) { const LAS unsigned char* vp = Vi + (32 * s + 8 * quad + q_) * RV + (16 * et + 4 * p_) * 2;
          const bf16x8 vf = comb8(tr_read(vp), tr_read(vp + 4 * RV));
          const bf16x8 sc = *(const LAS bf16x8*)(Sci + (16 * it2 + l15) * RV + (32 * s + 8 * quad) * 2); acc = MFMA16(vf, sc, acc); }
        u32x2 w; w.x = cvtpk(acc[0], acc[1]); w.y = cvtpk(acc[2], acc[3]);
        *(u32x2*)(YB + (size_t)(ch * 64 + 16 * it2 + l15) * 2048 + 16 * et + 4 * quad) = w; }
#pragma unroll
      for (int mt = 0; mt < 2; ++mt)
#pragma unroll
        for (int nt = 0; nt < 4; ++nt) st[mt][nt] = st[mt][nt] * cd;
#pragma unroll
      for (int s = 0; s < 2; ++s) { bf16x8 vd[4];
#pragma unroll
        for (int nt = 0; nt < 4; ++nt) { const LAS unsigned char* vp = Vdi + (32 * s + 8 * quad + q_) * RV + (16 * nt + 4 * p_) * 2; vd[nt] = comb8(tr_read(vp), tr_read(vp + 4 * RV)); }
#pragma unroll
        for (int mt = 0; mt < 2; ++mt) { const LAS unsigned char* kp = Ki + (32 * s + 8 * quad + q_) * RQ + (32 * wave + 16 * mt + 4 * p_) * 2;
          const bf16x8 kf = comb8(tr_read(kp), tr_read(kp + 4 * RQ));
#pragma unroll
          for (int nt = 0; nt < 4; ++nt) st[mt][nt] = MFMA16(kf, vd[nt], st[mt][nt]); } }
    }
    __syncthreads();
#pragma unroll
    for (int mt = 0; mt < 2; ++mt)
#pragma unroll
      for (int nt = 0; nt < 4; ++nt) { u32x2 w; w.x = cvtpk(st[mt][nt][0], st[mt][nt][1]); w.y = cvtpk(st[mt][nt][2], st[mt][nt][3]);
        *(LAS u32x2*)(Si + (16 * nt + l15) * RQ + (32 * wave + 16 * mt + 4 * quad) * 2) = w; }
    if (ch + 1 < 64) stash();
    __syncthreads();
  }
}

DI void retention_post(const Ctx& c) {
  const bf16_t* YB = (const bf16_t*)(c.ws + WS_YB);
  bf16_t* Z = (bf16_t*)(c.ws + WS_ZODD);
  const int gw = c.bid * NWAVES + c.wave, NGW = c.G * NWAVES;
  for (int p = gw; p < M_TOK * 4; p += NGW) {
    const int t = p >> 2, h = p & 3;
    const bf16x8 y8 = *(const bf16x8*)(YB + (size_t)t * 2048 + h * 512 + c.lane * 8);
    bf16_t* gp = Z + (size_t)t * ODD_IN + 4096 + h * 512 + c.lane * 8;
    const bf16x8 g8 = *(const bf16x8*)gp;
    float y[8], g[8]; unpack8(y8, y); unpack8(g8, g);
    float ss = 0.f;
#pragma unroll
    for (int e = 0; e < 8; ++e) ss += y[e] * y[e];
    const float rn = __builtin_amdgcn_rsqf(wave_sum(ss) * (1.f / 512.f) + NORM_EPS);
#pragma unroll
    for (int e = 0; e < 8; ++e) y[e] = siluf_(g[e]) * y[e] * rn;
    u32x4 w; w.x = cvtpk(y[0], y[1]); w.y = cvtpk(y[2], y[3]); w.z = cvtpk(y[4], y[5]); w.w = cvtpk(y[6], y[7]);
    *(u32x4*)gp = w;
  }
}

#define XB_TMO      128
#define XB_XCNT(j)  (256  + 64 * (j))
#define XB_XSUB(j)  (1280 + 64 * (j))
#define XB_XGEN(j)  (2304 + 64 * (j))
#define XB_TOP      3328
#define XB_TOPGEN   3392
#define XCD_BAR_WORDS 3456
#define XB_SPIN_CAP (1u << 18)
__device__ __forceinline__ unsigned xb_ld(unsigned* p)              { return __hip_atomic_load(p, __ATOMIC_RELAXED, __HIP_MEMORY_SCOPE_AGENT); }
__device__ __forceinline__ unsigned xb_add(unsigned* p, unsigned v) { return __hip_atomic_fetch_add(p, v, __ATOMIC_RELAXED, __HIP_MEMORY_SCOPE_AGENT); }
__device__ __forceinline__ unsigned xb_xcc_id() { return (unsigned)__builtin_amdgcn_s_getreg((3 << 11) | 20) & 0xFu; }
#define XB_SPIN(cond, bar) do { unsigned _sp = 0; while (cond) { __builtin_amdgcn_s_sleep(1); \
    if ((++_sp & 255u) == 0u) { if (xb_ld(&(bar)[XB_TMO])) break; if (_sp > XB_SPIN_CAP) { atomicAdd(&(bar)[XB_TMO], 1u); break; } } } } while (0)
struct XcdBarrier { unsigned* bar; unsigned x; volatile LAS unsigned* st; };
__device__ __forceinline__ XcdBarrier xcd_barrier_post(unsigned* bar, volatile LAS unsigned* st) {
    XcdBarrier b; b.bar = bar; b.x = xb_xcc_id(); b.st = st;
    if (threadIdx.x == 0) (void)xb_add(&bar[XB_XCNT(b.x)], 1u);
    return b;
}
__device__ __forceinline__ void xcd_barrier_complete(unsigned* bar, unsigned x, unsigned& nloc, unsigned& nx) {
    const unsigned G = gridDim.x * gridDim.y * gridDim.z;
    unsigned sum, cnt, mine, sp = 0u;
    for (;;) {
        sum = 0u; cnt = 0u; mine = 0u;
#pragma unroll
        for (unsigned j = 0; j < 16; ++j) { const unsigned c = xb_ld(&bar[XB_XCNT(j)]); sum += c; cnt += (c > 0u) ? 1u : 0u; mine = (j == x) ? c : mine; }
        if (sum == G) break;
        __builtin_amdgcn_s_sleep(1);
        if ((++sp & 255u) == 0u) { if (xb_ld(&bar[XB_TMO])) break; if (sp > XB_SPIN_CAP) { atomicAdd(&bar[XB_TMO], 1u); break; } }
    }
    nloc = mine > 0u ? mine : 1u; nx = cnt > 0u ? cnt : 1u;
}
__device__ __forceinline__ void xcd_barrier(const XcdBarrier& b) {
    asm volatile("s_waitcnt vmcnt(0)" ::: "memory");
    __syncthreads();
    if (threadIdx.x == 0) {
        unsigned* bar = b.bar;
        __builtin_amdgcn_s_waitcnt(0);
        unsigned nloc = b.st[0], nx = b.st[1];
        if (nloc == 0u) { xcd_barrier_complete(bar, b.x, nloc, nx); b.st[0] = nloc; b.st[1] = nx; }
        const unsigned old = xb_add(&bar[XB_XSUB(b.x)], 1u);
        const unsigned gen = old / nloc;
        if (old + 1u == (gen + 1u) * nloc) {
            __builtin_amdgcn_fence(__ATOMIC_RELEASE, "agent");
            asm volatile("s_waitcnt vmcnt(0)" ::: "memory");
            const unsigned og = xb_add(&bar[XB_TOP], 1u);
            const unsigned tg = og / nx;
            if (og + 1u == (tg + 1u) * nx) xb_add(&bar[XB_TOPGEN], 1u);
            else XB_SPIN(xb_ld(&bar[XB_TOPGEN]) == tg, bar);
            __builtin_amdgcn_fence(__ATOMIC_ACQUIRE, "agent");
            xb_add(&bar[XB_XGEN(b.x)], 1u);
            asm volatile("s_waitcnt vmcnt(0)" ::: "memory");
        } else {
            XB_SPIN(xb_ld(&bar[XB_XGEN(b.x)]) == gen, bar);
            __builtin_amdgcn_fence(__ATOMIC_ACQUIRE, "agent");
            asm volatile("s_waitcnt vmcnt(0)" ::: "memory");
        }
    }
    __syncthreads();
}

enum { T_CONV = 0, T_GU_A, T_DOWN_A, T_ROW1, T_WIN, T_PREP, T_SCAN, T_MIX, T_POST, T_WOUT, T_ROW3, T_GU_B, T_DOWN_B, T_RET, T_RETPOST, T_FINAL };
__global__ void __launch_bounds__(NTHR, 2) fwd_megakernel(Args args) {
  extern __shared__ __attribute__((aligned(16))) unsigned char lds_raw[];
  cg::grid_group grid = cg::this_grid();
  const int lo = args.ph_lo, hi = args.ph_hi;
  volatile LAS unsigned* bst = (volatile LAS unsigned*)((LAS unsigned char*)lds_raw + LDS_MAIN + 128);
  if (threadIdx.x < 2) bst[threadIdx.x] = 0u;
  __syncthreads();
  XcdBarrier xbar; xbar.bar = (unsigned*)(args.ws + WS_CTL) + 4096; xbar.x = 0; xbar.st = bst;
  if (!MK_PER_PHASE) xbar = xcd_barrier_post((unsigned*)(args.ws + WS_CTL) + 4096, bst);
#pragma unroll 1
  for (int ph = lo; ph < hi; ++ph) {
    Ctx c;
    { int tid = threadIdx.x, bid = blockIdx.x, G = gridDim.x, z = 0;
      asm volatile("" : "+v"(tid)); asm volatile("" : "+s"(bid), "+s"(G), "+s"(z));
      unsigned char* ws = args.ws + z; float* out = args.out + z;
      c.lds = (LAS unsigned char*)lds_raw; c.tid = tid; c.lane = tid & 63; c.wave = __builtin_amdgcn_readfirstlane(tid >> 6);
      c.G = G; c.bid = bid; c.z = z; c.ws = ws; c.out = out; }
    int L, k;
    if (ph < 13) { L = 0; k = ph; } else if (ph < 24) { L = 1; k = ph - 13; } else if (ph < 37) { L = 2; k = ph - 24; } else if (ph < 48) { L = 3; k = ph - 37; } else { L = 4; k = 0; }
    int type;
    if (L == 4) type = T_FINAL;
    else if ((L & 1) == 0) type = k;
    else type = (k <= 4) ? k : (k == 5 ? T_RET : (k == 6 ? T_RETPOST : k + 2));
    const bool even = (L & 1) == 0; const int j = L >> 1;
    const bool is_gemm = (type == T_GU_A || type == T_DOWN_A || type == T_WIN || type == T_WOUT || type == T_GU_B || type == T_DOWN_B);
    if (is_gemm) {
      pg8::Gemm g; pg8::EpiRT E;
      bf16_t* XB = (bf16_t*)(c.ws + WS_XB); bf16_t* F = (bf16_t*)(c.ws + WS_F); bf16_t* H = (bf16_t*)(c.ws + WS_H);
      const float* RINV = (const float*)(c.ws + WS_RINV);
      g.M = M_TOK;
      if (type == T_GU_A || type == T_GU_B) { g.A = XB; g.Bt = (const bf16_t*)(c.ws + (type == T_GU_A ? WS_WGU0 : WS_WGU1)); g.N = 2 * DFF; g.K = DM; g.lda = DM; g.ldb = DM; E.mode = 2; E.O = H; E.ldc = DFF; E.rs = RINV; }
      else if (type == T_DOWN_A || type == T_DOWN_B) { g.A = H; g.Bt = (const bf16_t*)(c.ws + (type == T_DOWN_A ? WS_WD0 : WS_WD1)); g.N = DM; g.K = DFF; g.lda = DFF; g.ldb = DFF; E.mode = 0; E.O = F; E.ldc = DM; E.rs = RINV; }
      else if (type == T_WIN) { const int NIN = even ? EVEN_IN : ODD_IN; g.A = XB; g.Bt = (const bf16_t*)(c.ws + WS_WIN); g.N = NIN; g.K = DM; g.lda = DM; g.ldb = DM; E.mode = 1; E.O = (bf16_t*)(c.ws + (even ? WS_ZEVEN : WS_ZODD)); E.ldc = NIN; E.rs = RINV; }
      else { if (even) { g.A = (const bf16_t*)(c.ws + WS_MIXE); g.K = DM; g.lda = DM; g.ldb = DM; } else { g.A = (const bf16_t*)(c.ws + WS_ZODD) + 4096; g.K = 2048; g.lda = ODD_IN; g.ldb = 2048; }
        g.Bt = (const bf16_t*)(c.ws + WS_WOUT); g.N = DM; E.mode = 0; E.O = F; E.ldc = DM; E.rs = RINV; }
      pg8::StaticOrder S; S.init(M_TOK, g.N, c.G, c.bid);
      pg8::gemm_phase(c.lds, g, S, E);
      if ((DUP_MASK >> type) & 1) pg8::gemm_phase(c.lds, g, S, E);
    } else if (type == T_CONV || type == T_ROW1 || type == T_ROW3 || type == T_FINAL) {
      const float* xin = c.out; const bf16_t* F = (const bf16_t*)(c.ws + WS_F); const float* gain = nullptr; float coef = 0.5f;
      if (type == T_CONV) {
        convert_layer(c, args, L);
        if ((DUP_MASK >> T_CONV) & 1) convert_layer(c, args, L);
        if (L == 0) { xin = args.in[c.z + IN_X]; F = nullptr; } else gain = args.in[c.z + IN_NORMS] + (size_t)(L - 1) * 6 * DM + 5 * DM;
      } else if (type == T_ROW1) gain = args.in[c.z + IN_NORMS] + (size_t)L * 6 * DM + 1 * DM;
      else if (type == T_ROW3) { gain = args.in[c.z + IN_NORMS] + (size_t)L * 6 * DM + 3 * DM; coef = 1.0f; }
      else gain = args.in[c.z + IN_NORMS] + (size_t)3 * 6 * DM + 5 * DM;
      rowpass(c, xin, F, gain, coef);
    } else if (type == T_PREP) {
      rwkv_prep(c, args, j);
      if ((DUP_MASK >> T_PREP) & 1) rwkv_prep(c, args, j);
    } else if (type == T_SCAN) {
      for (int u = c.bid; u < 256; u += c.G) { const int x = u & 7, slot = u >> 3; rwkv_scan_item(c, (x * 8 + (slot >> 2)) * 4 + (slot & 3)); }
    } else if (type == T_MIX) {
      attn_phase(c, args, j, L, (unsigned*)(c.ws + WS_CTL) + 64 * j);
    } else if (type == T_POST) {
      rwkv_post(c, args, j);
    } else if (type == T_RET) {
      for (int u = c.bid; u < 256; u += c.G) { const int x = u & 7, slot = u >> 3; retention_unit(c, x * 4 + (slot >> 3), slot & 7); }
    } else if (type == T_RETPOST) {
      retention_post(c);
    }
    if (ph + 1 < hi) { if (ph == lo) grid.sync(); else xcd_barrier(xbar); }
  }
}
constexpr int N_PHASES = 13 + 11 + 13 + 11 + 1;

extern "C" void kernel_launch(void* const* d_in, const int* in_sizes, int n_in, void* d_out, int out_size, void* d_ws, size_t ws_size, hipStream_t stream) {
  static int grid = 0;
  if (grid == 0) {
    if (n_in != 18 || out_size != M_TOK * DM || ws_size < WS_END) { fprintf(stderr, "kernel_launch: unexpected shapes (n_in %d, out %d, ws %zu, need %zu)\n", n_in, out_size, ws_size, (size_t)WS_END); grid = -1; return; }
    int dev = 0, cus = 0, per_cu = 0;
    hipGetDevice(&dev); hipDeviceGetAttribute(&cus, hipDeviceAttributeMultiprocessorCount, dev);
    if (hipFuncSetAttribute((const void*)fwd_megakernel, hipFuncAttributeMaxDynamicSharedMemorySize, LDS_BYTES) != hipSuccess) { fprintf(stderr, "kernel_launch: hipFuncSetAttribute failed\n"); grid = -1; return; }
    if (hipOccupancyMaxActiveBlocksPerMultiprocessor(&per_cu, (const void*)fwd_megakernel, NTHR, LDS_BYTES) != hipSuccess || per_cu < 1) { fprintf(stderr, "kernel_launch: occupancy query gives %d\n", per_cu); per_cu = 1; }
    (void)hipGetLastError();
    grid = cus * per_cu;
    if (grid > 256) grid = 256;
  }
  if (grid < 0) return;
  hipMemsetAsync((char*)d_ws + WS_CTL, 0, CTL_BYTES, stream);
  Args a{};
  for (int i = 0; i < 18; ++i) a.in[i] = (const float*)d_in[i];
  a.out = (float*)d_out; a.ws = (unsigned char*)d_ws;
#if MK_PER_PHASE
  for (int p = 0; p < N_PHASES; ++p) { a.ph_lo = p; a.ph_hi = p + 1; hipLaunchKernelGGL(fwd_megakernel, dim3(grid), dim3(NTHR), LDS_BYTES, stream, a); }
#else
  a.ph_lo = 0; a.ph_hi = N_PHASES;
  void* kargs[] = {&a};
  hipError_t e = hipLaunchCooperativeKernel((const void*)fwd_megakernel, dim3(grid), dim3(NTHR), kargs, LDS_BYTES, stream);
  if (e != hipSuccess) fprintf(stderr, "cooperative launch failed: %s (grid %d)\n", hipGetErrorString(e), grid);
#endif
}
```

```cpp
#include <hip/hip_runtime.h>
#include <hip/hip_cooperative_groups.h>
#include <cstdio>
#include <cstdint>
namespace cg = cooperative_groups;

#define LAS __attribute__((address_space(3)))
#define DI __device__ __forceinline__
typedef unsigned short bf16_t;
typedef short bf16x8 __attribute__((ext_vector_type(8)));
typedef short s16x4 __attribute__((ext_vector_type(4)));
typedef float f32x4 __attribute__((ext_vector_type(4)));
typedef float f32x2 __attribute__((ext_vector_type(2)));
typedef unsigned u32x4 __attribute__((ext_vector_type(4)));
typedef unsigned u32x2 __attribute__((ext_vector_type(2)));
typedef __bf16 bf16x2_t __attribute__((ext_vector_type(2)));

#ifndef DUP_MASK
#define DUP_MASK 0
#endif
#ifndef MK_PER_PHASE
#define MK_PER_PHASE 0
#endif

constexpr int M_TOK = 32768, SEQ = 4096, DM = 1024, DFF = 2816, NWAVES = 8, NTHR = 512;
constexpr int EVEN_IN = 3328, ODD_IN = 6144;
constexpr float NORM_EPS = 1e-6f;
constexpr float LOG2E = 1.4426950408889634f;

constexpr size_t MiB = 1u << 20;
constexpr size_t WS_CTL = 0, CTL_BYTES = 65536;
constexpr size_t WS_RINV = 1 * MiB;
constexpr size_t WS_WGU0 = 2 * MiB, WS_WD0 = 13 * MiB, WS_WIN = 19 * MiB, WS_WOUT = 31 * MiB, WS_WGU1 = 35 * MiB, WS_WD1 = 46 * MiB;
constexpr size_t WS_LORA = 51 * MiB + 512 * 1024;
constexpr size_t WS_VFIRST = 52 * MiB;
constexpr size_t WS_TMP = 84 * MiB;
constexpr size_t WS_XB = 596 * MiB, WS_F = WS_TMP + 64 * MiB;
constexpr size_t WS_BIG = 212 * MiB;
constexpr size_t WS_H = WS_BIG, WS_ZODD = WS_BIG, WS_MIXE = WS_BIG + 112 * MiB, WS_ZEVEN = WS_BIG + 176 * MiB;
constexpr size_t WS_RW = WS_TMP;
constexpr size_t RW_STRIDE = (size_t)M_TOK * 512;
constexpr size_t WS_YB = WS_TMP;
constexpr size_t WS_END = 660 * MiB;

constexpr int LDS_MAIN = 131072, LDS_BYTES = LDS_MAIN + 256;

DI float bf2f(unsigned short b) { return __uint_as_float((unsigned)b << 16); }
DI unsigned cvtpk(float lo, float hi) { f32x2 v = {lo, hi}; bf16x2_t b = __builtin_convertvector(v, bf16x2_t); return __builtin_bit_cast(unsigned, b); }
DI bf16_t f2bf(float f) { return (bf16_t)(cvtpk(f, 0.f) & 0xffffu); }
DI float wave_sum(float v) {
#pragma unroll
  for (int o = 1; o < 64; o <<= 1) v += __shfl_xor(v, o);
  return v;
}
DI float sigmoidf_(float x) { return __builtin_amdgcn_rcpf(1.f + __builtin_amdgcn_exp2f(-x * LOG2E)); }
DI float siluf_(float x) { return x * sigmoidf_(x); }
DI float tanhf_(float x) { return 2.f * sigmoidf_(2.f * x) - 1.f; }
DI void unpack8(const bf16x8 v, float (&f)[8]) {
#pragma unroll
  for (int e = 0; e < 8; ++e) f[e] = bf2f((unsigned short)v[e]);
}
#define MFMA16(a, b, c) __builtin_amdgcn_mfma_f32_16x16x32_bf16((a), (b), (c), 0, 0, 0)
typedef short v4i16_t __attribute__((ext_vector_type(4)));
DI s16x4 tr_read(const LAS unsigned char* p) { return __builtin_bit_cast(s16x4, __builtin_amdgcn_ds_read_tr16_b64_v4i16((LAS v4i16_t*)p)); }
DI bf16x8 comb8(s16x4 lo, s16x4 hi) { return __builtin_shufflevector(lo, hi, 0, 1, 2, 3, 4, 5, 6, 7); }
template <int CTRL> DI float dppf(float v) { return __builtin_bit_cast(float, __builtin_amdgcn_update_dpp(0, __builtin_bit_cast(int, v), CTRL, 0xF, 0xF, true)); }
DI void lds_barrier() { asm volatile("s_waitcnt lgkmcnt(0)" ::: "memory"); __builtin_amdgcn_s_barrier(); asm volatile("" ::: "memory"); }
DI float row16_sum(float v) {
  v += dppf<0xB1>(v); v += dppf<0x4E>(v); v += dppf<0x141>(v); v += dppf<0x140>(v); return v;
}

__device__ __forceinline__ unsigned xb_xcc_id() { return (unsigned)__builtin_amdgcn_s_getreg((3 << 11) | 20) & 0xFu; }

namespace pg8 {
constexpr int BM = 256, BK = 64, HALF = 128, HTB = HALF * BK * 2, STAGE_BYTES = 8 * HTB, NXCD = 8, WGM = 8;
__host__ __device__ __forceinline__ int lds_byte(int r, int c) { const int st = (r >> 4) * 2 + (c >> 5), rr = r & 15, cc = c & 31, ob = rr * 64 + cc * 2; return st * 1024 + (ob ^ (((ob >> 9) & 1) << 5)); }
__host__ __device__ __forceinline__ void stage_rc(int b, int& R, int& C) { const int st = b / 1024, sb = b % 1024, swz = sb ^ (((sb >> 9) & 1) << 5); R = (st >> 1) * 16 + swz / 64; C = (st & 1) * 32 + (swz % 64) / 2; }
__host__ __device__ __forceinline__ int perm32(int rho) { const int n = rho >> 4, i = rho & 15; return 8 * (i >> 2) + 4 * n + (i & 3); }
struct Unit { int pm, pn; };
struct Gemm { const bf16_t* A; const bf16_t* Bt; int M, N, K, lda, ldb; };
struct StaticOrder {
  int nM, nN, nwg, G, c;
  __device__ void init(int M, int N, int G_, int c_) { nM = M / BM; nN = N / BM; nwg = nM * nN; G = G_; c = c_; }
  __device__ bool next(int i, Unit& u) const {
    const long L = (long)i * G + c; if (L >= nwg) return false;
    int wgid = (int)L; { const int q = nwg / NXCD, r = nwg % NXCD, xcd = wgid % NXCD, off = wgid / NXCD; wgid = (xcd < r ? xcd * (q + 1) : r * (q + 1) + (xcd - r) * q) + off; }
    const int nig = WGM * nN, gid = wgid / nig, fm = gid * WGM, gsz = (nM - fm) < WGM ? (nM - fm) : WGM;
    u.pm = fm + ((wgid % nig) % gsz); u.pn = (wgid % nig) / gsz; return true;
  }
};
template <int MODE> struct Epi {
  static constexpr bool PERM = true;
  bf16_t* O; int ldc; const float* rs;
  DI void operator()(const f32x4 (&acc)[2][2][4][2], const Unit& u, int wr, int wc, int fr, int fq) const {
    const int row0 = u.pm * BM + wr * 64 + fr;
    if constexpr (MODE == 2) {
      const int col0 = u.pn * HALF + wc * 32 + 8 * fq;
#pragma unroll
      for (int ai = 0; ai < 2; ++ai)
#pragma unroll
        for (int m = 0; m < 4; ++m) {
          const int row = row0 + ai * HALF + m * 16; const float r = rs[row];
          f32x4 g0 = acc[ai][0][m][0] * r, g1 = acc[ai][0][m][1] * r, u0 = acc[ai][1][m][0] * r, u1 = acc[ai][1][m][1] * r;
          float h[8];
#pragma unroll
          for (int e = 0; e < 4; ++e) { h[e] = siluf_(g0[e]) * u0[e]; h[4 + e] = siluf_(g1[e]) * u1[e]; }
          u32x4 w; w.x = cvtpk(h[0], h[1]); w.y = cvtpk(h[2], h[3]); w.z = cvtpk(h[4], h[5]); w.w = cvtpk(h[6], h[7]);
          *(u32x4*)(O + (size_t)row * ldc + col0) = w;
        }
    } else {
      const int col0 = u.pn * BM + wc * 32 + 8 * fq;
#pragma unroll
      for (int ai = 0; ai < 2; ++ai)
#pragma unroll
        for (int m = 0; m < 4; ++m) {
          const int row = row0 + ai * HALF + m * 16; float r = 1.f; if constexpr (MODE == 1) r = rs[row];
          bf16_t* rowp = O + (size_t)row * ldc + col0;
#pragma unroll
          for (int bj = 0; bj < 2; ++bj) { f32x4 v0 = acc[ai][bj][m][0] * r, v1 = acc[ai][bj][m][1] * r;
            u32x4 w; w.x = cvtpk(v0[0], v0[1]); w.y = cvtpk(v0[2], v0[3]); w.z = cvtpk(v1[0], v1[1]); w.w = cvtpk(v1[2], v1[3]);
            *(u32x4*)(rowp + bj * HALF) = w; }
        }
    }
  }
};

struct EpiRT {
  static constexpr bool PERM = true;
  int mode; bf16_t* O; int ldc; const float* rs;
  DI void operator()(const f32x4 (&acc)[2][2][4][2], const Unit& u, int wr, int wc, int fr, int fq) const {
    if (mode == 3) {
      const int row0 = u.pm * BM + wr * 64 + fr;
#pragma unroll
      for (int ai = 0; ai < 2; ++ai)
#pragma unroll
        for (int m = 0; m < 4; ++m) {
          const int row = row0 + ai * HALF + m * 16; const float r = rs[row]; const int b = row >> 12, t = row & 4095;
#pragma unroll
          for (int bj = 0; bj < 2; ++bj) { const int cw = wc * 32 + 8 * fq + bj * HALF; size_t off;
            if (u.pn < 8) off = (size_t)(u.pn >> 2) * 33554432u + ((size_t)((b * 4 + (u.pn & 3)) * 4096 + t)) * 256 + cw;
            else if (u.pn < 16) { const int e = ((u.pn - 8) & 1) * 256 + cw; off = (size_t)67108864u + ((size_t)(((b * 4 + ((u.pn - 8) >> 1)) * 8 + (e >> 6)) * 4096 + t)) * 64 + (e & 63); }
            else off = (size_t)134217728u + (size_t)row * 2048 + (u.pn - 16) * 256 + cw;
            f32x4 v0 = acc[ai][bj][m][0] * r, v1 = acc[ai][bj][m][1] * r;
            u32x4 w; w.x = cvtpk(v0[0], v0[1]); w.y = cvtpk(v0[2], v0[3]); w.z = cvtpk(v1[0], v1[1]); w.w = cvtpk(v1[2], v1[3]);
            *(u32x4*)(O + off) = w; }
        }
    }
    else if (mode == 2) { Epi<2> e{O, ldc, rs}; e(acc, u, wr, wc, fr, fq); }
    else if (mode == 1) { Epi<1> e{O, ldc, rs}; e(acc, u, wr, wc, fr, fq); }
    else { Epi<0> e{O, ldc, rs}; e(acc, u, wr, wc, fr, fq); }
  }
};

template <class EpiT>
DI void gemm_phase(LAS unsigned char* lds, const Gemm g, const StaticOrder& S, const EpiT& E) {
  const int tid = threadIdx.x, wid = __builtin_amdgcn_readfirstlane(tid >> 6), lane = tid & 63, wr = wid >> 2, wc = wid & 3, fr = lane & 15, fq = lane >> 4;
  const int K = g.K, nt = K / BK;
  unsigned voffA[2], voffB[2];
#pragma unroll
  for (int i = 0; i < 2; ++i) { int R, C; stage_rc(tid * 16 + i * 8192, R, C); const int Rb = EpiT::PERM ? ((R & ~31) + perm32(R & 31)) : R;
    voffA[i] = (unsigned)(R * g.lda + C) * 2u; voffB[i] = (unsigned)(Rb * g.ldb + C) * 2u; }
  const size_t kstep = (size_t)(BK * 2);
  const size_t hstepA = (size_t)HALF * g.lda * 2, hstepB = (size_t)HALF * g.ldb * 2;
  const size_t tstepA = 2 * hstepA, tstepB = 2 * hstepB;
  const unsigned ldsw = (unsigned)wid * 1024u;
  const int aoff = lds_byte(wr * 64 + fr, fq * 8), boff = lds_byte(wc * 32 + fr, fq * 8);
#define PG8_SA(b, h) (((b) * 2 + (h)) * HTB)
#define PG8_SB(b, h) ((4 + (b) * 2 + (h)) * HTB)
#define PG8_STAGE(bufoff, gbase, voff) do { _Pragma("unroll") for (int _i = 0; _i < 2; ++_i) \
    __builtin_amdgcn_global_load_lds((const unsigned*)((const char*)(gbase) + (voff)[_i]), (LAS unsigned*)(lds + (bufoff) + ldsw + _i * 8192), 16, 0, 0); } while (0)
#define PG8_LDA(dst, b, h) do { _Pragma("unroll") for (int m = 0; m < 4; ++m) _Pragma("unroll") for (int k = 0; k < 2; ++k) dst[m][k] = *(const LAS bf16x8*)(lds + PG8_SA(b, h) + aoff + m * 2048 + k * 1024); } while (0)
#define PG8_LDB(dst, b, h) do { _Pragma("unroll") for (int n = 0; n < 2; ++n) _Pragma("unroll") for (int k = 0; k < 2; ++k) dst[n][k] = *(const LAS bf16x8*)(lds + PG8_SB(b, h) + boff + n * 2048 + k * 1024); } while (0)
#define PG8_MMA(ai, bj, At, Bt) do { __builtin_amdgcn_s_setprio(1); _Pragma("unroll") for (int m = 0; m < 4; ++m) _Pragma("unroll") for (int n = 0; n < 2; ++n) _Pragma("unroll") for (int k = 0; k < 2; ++k) \
    acc[ai][bj][m][n] = __builtin_amdgcn_mfma_f32_16x16x32_bf16(Bt[n][k], At[m][k], acc[ai][bj][m][n], 0, 0, 0); __builtin_amdgcn_s_setprio(0); } while (0)
#define PG8_WAIT_V(n) asm volatile("s_waitcnt vmcnt(" #n ")" ::: "memory")
#define PG8_WAIT_L(n) asm volatile("s_waitcnt lgkmcnt(" #n ")" ::: "memory")
#define PG8_BAR __builtin_amdgcn_s_barrier()
#define PG8_SCHED __builtin_amdgcn_sched_barrier(0)
  Unit cur, nxt; int ui = 0;
  if (!S.next(0, cur)) return;
  f32x4 acc[2][2][4][2];
#pragma unroll
  for (int a = 0; a < 2; ++a)
#pragma unroll
    for (int b = 0; b < 2; ++b)
#pragma unroll
      for (int m = 0; m < 4; ++m)
#pragma unroll
        for (int n = 0; n < 2; ++n) acc[a][b][m][n] = (f32x4){0.f, 0.f, 0.f, 0.f};
  bf16x8 At[4][2], B0[2][2], B1[2][2];
  const char* cA = (const char*)g.A + (size_t)cur.pm * tstepA; const char* cB = (const char*)g.Bt + (size_t)cur.pn * tstepB;
  PG8_STAGE(PG8_SB(0, 0), cB, voffB); PG8_STAGE(PG8_SB(0, 1), cB + hstepB, voffB); PG8_STAGE(PG8_SA(0, 0), cA, voffA); PG8_STAGE(PG8_SA(0, 1), cA + hstepA, voffA);
  if (wr == 1) PG8_BAR;
  PG8_WAIT_V(2); PG8_BAR;
  PG8_STAGE(PG8_SB(1, 0), cB + kstep, voffB); PG8_STAGE(PG8_SA(1, 0), cA + kstep, voffA); PG8_STAGE(PG8_SB(1, 1), cB + hstepB + kstep, voffB);
  PG8_WAIT_V(6); PG8_BAR;
  for (;;) {
    const bool has_next = S.next(ui + 1, nxt);
    const char* nA = has_next ? (const char*)g.A + (size_t)nxt.pm * tstepA : cA; const char* nB = has_next ? (const char*)g.Bt + (size_t)nxt.pn * tstepB : cB;
    for (int t = 0; t < nt; t += 2) {
      const bool last = (t == nt - 2);
      const char* a1 = cA + (size_t)(t + 1) * kstep;
      const char* a2 = last ? nA : cA + (size_t)(t + 2) * kstep; const char* b2 = last ? nB : cB + (size_t)(t + 2) * kstep;
      const char* a3 = a2 + kstep; const char* b3 = b2 + kstep;
      PG8_LDB(B0, 0, 0); PG8_LDB(B1, 0, 1); PG8_SCHED; PG8_LDA(At, 0, 0); PG8_STAGE(PG8_SA(1, 1), a1 + hstepA, voffA);
      PG8_WAIT_V(8); PG8_WAIT_L(0); PG8_BAR; PG8_MMA(0, 0, At, B0); PG8_MMA(0, 1, At, B1); PG8_BAR; PG8_SCHED;
      PG8_LDA(At, 0, 1); PG8_STAGE(PG8_SB(0, 0), b2, voffB); PG8_STAGE(PG8_SB(0, 1), b2 + hstepB, voffB); PG8_STAGE(PG8_SA(0, 0), a2, voffA);
      PG8_WAIT_V(8); PG8_WAIT_L(0); PG8_BAR; PG8_MMA(1, 0, At, B0); PG8_MMA(1, 1, At, B1); PG8_BAR; PG8_SCHED;
      PG8_LDB(B0, 1, 0); PG8_LDB(B1, 1, 1); PG8_SCHED; PG8_LDA(At, 1, 0); PG8_STAGE(PG8_SA(0, 1), a2 + hstepA, voffA);
      PG8_WAIT_V(8); PG8_WAIT_L(0); PG8_BAR; PG8_MMA(0, 0, At, B0); PG8_MMA(0, 1, At, B1); PG8_BAR; PG8_SCHED;
      PG8_LDA(At, 1, 1); PG8_STAGE(PG8_SB(1, 0), b3, voffB); PG8_STAGE(PG8_SB(1, 1), b3 + hstepB, voffB); PG8_STAGE(PG8_SA(1, 0), a3, voffA);
      PG8_WAIT_V(8); PG8_WAIT_L(0); PG8_BAR; PG8_MMA(1, 0, At, B0); PG8_MMA(1, 1, At, B1); PG8_BAR; PG8_SCHED;
    }
    if (wr == 0) PG8_BAR;
    E(acc, cur, wr, wc, fr, fq);
    if (!has_next) break;
#pragma unroll
    for (int a = 0; a < 2; ++a)
#pragma unroll
      for (int b = 0; b < 2; ++b)
#pragma unroll
        for (int m = 0; m < 4; ++m)
#pragma unroll
          for (int n = 0; n < 2; ++n) acc[a][b][m][n] = (f32x4){0.f, 0.f, 0.f, 0.f};
    cur = nxt; cA = nA; cB = nB; ++ui;
    if (wr == 1) PG8_BAR;
  }
  PG8_WAIT_V(0);
  PG8_BAR;
#undef PG8_SA
#undef PG8_SB
#undef PG8_STAGE
#undef PG8_LDA
#undef PG8_LDB
#undef PG8_MMA
#undef PG8_WAIT_V
#undef PG8_WAIT_L
#undef PG8_BAR
#undef PG8_SCHED
}
}

struct Args { const float* in[18]; float* out; unsigned char* ws; int ph_lo, ph_hi; };
struct Ctx {
  LAS unsigned char* lds;
  int tid, lane, wave, G, bid, z;
  unsigned char* ws; float* out;
};
enum { IN_X = 0, IN_NORMS, IN_WGU, IN_WD, IN_EWIN, IN_EWOUT, IN_LAM, IN_SUBLN, IN_MU, IN_VEC, IN_WUP, IN_AUP, IN_GUP, IN_V0, IN_VDOWN, IN_VUP, IN_OWIN, IN_OWOUT };

DI void transpose_item(const float* W, int K, int N, bf16_t* WT, int mode, const float* gain, int sc_lo, int sc_hi, float sc, LAS float* scr, int item, int lane) {
  const int nblk = N / 32, kb = item / nblk, nb = item % nblk, k0 = 64 * kb, n0 = 32 * nb;
  const float cs = (n0 >= sc_lo && n0 < sc_hi) ? sc : 1.f;
#pragma unroll 8
  for (int i = 0; i < 32; ++i) { const int kk = 2 * i + (lane >> 5); const float gk = gain ? gain[k0 + kk] * cs : cs;
    scr[kk * 33 + (lane & 31)] = W[(size_t)(k0 + kk) * N + n0 + (lane & 31)] * gk; }
  asm volatile("s_waitcnt lgkmcnt(0)" ::: "memory");
  int d0 = n0;
  if (mode == 1) d0 = (n0 < DFF) ? 256 * (n0 / 128) + (n0 % 128) : 256 * ((n0 - DFF) / 128) + 128 + ((n0 - DFF) % 128);
  const int c = lane & 7;
#pragma unroll
  for (int j = 0; j < 4; ++j) { const int n = (lane >> 3) + 8 * j; const LAS float* s = scr + (8 * c) * 33 + n;
    u32x4 o; o.x = cvtpk(s[0 * 33], s[1 * 33]); o.y = cvtpk(s[2 * 33], s[3 * 33]); o.z = cvtpk(s[4 * 33], s[5 * 33]); o.w = cvtpk(s[6 * 33], s[7 * 33]);
    *(u32x4*)(WT + (size_t)(d0 + n) * K + k0 + 8 * c) = o; }
  asm volatile("s_waitcnt lgkmcnt(0)" ::: "memory");
}

DI void convert_layer(const Ctx& c, const Args& a, int L) {
  LAS float* scr = (LAS float*)(c.lds + c.wave * 16384);
  const int gw = c.bid * NWAVES + c.wave, NGW = c.G * NWAVES;
  const bool even = (L & 1) == 0; const int j = L >> 1;
  const float* norms = a.in[c.z + IN_NORMS] + (size_t)L * 6 * DM;
  const float* wgu0 = a.in[c.z + IN_WGU] + (size_t)(L * 2 + 0) * DM * 2 * DFF; const float* wgu1 = a.in[c.z + IN_WGU] + (size_t)(L * 2 + 1) * DM * 2 * DFF;
  const float* wd0 = a.in[c.z + IN_WD] + (size_t)(L * 2 + 0) * DFF * DM; const float* wd1 = a.in[c.z + IN_WD] + (size_t)(L * 2 + 1) * DFF * DM;
  const float* win = even ? a.in[c.z + IN_EWIN] + (size_t)j * DM * EVEN_IN : a.in[c.z + IN_OWIN] + (size_t)j * DM * ODD_IN;
  const float* wout = even ? a.in[c.z + IN_EWOUT] + (size_t)j * DM * DM : a.in[c.z + IN_OWOUT] + (size_t)j * 2048 * DM;
  const int NIN = even ? EVEN_IN : ODD_IN, KOUT = even ? DM : 2048;
  const int I_GU = (DM / 64) * (2 * DFF / 32), I_D = (DFF / 64) * (DM / 32), I_IN = (DM / 64) * (NIN / 32), I_OUT = (KOUT / 64) * (DM / 32);
  const int NIT = 2 * I_GU + 2 * I_D + I_IN + I_OUT;
  bf16_t* WGU0 = (bf16_t*)(c.ws + WS_WGU0); bf16_t* WGU1 = (bf16_t*)(c.ws + WS_WGU1); bf16_t* WD0 = (bf16_t*)(c.ws + WS_WD0); bf16_t* WD1 = (bf16_t*)(c.ws + WS_WD1);
  bf16_t* WIN = (bf16_t*)(c.ws + WS_WIN); bf16_t* WOUT = (bf16_t*)(c.ws + WS_WOUT);
  if (even) {
    bf16_t* WUPT = (bf16_t*)(c.ws + WS_LORA); bf16_t* AUPT = WUPT + 512 * 64; bf16_t* GUPT = AUPT + 512 * 64; bf16_t* VDT = GUPT + 512 * 128; bf16_t* VUPT = VDT + 32 * 512;
    const float* w_up = a.in[c.z + IN_WUP] + (size_t)j * 64 * 512; const float* a_up = a.in[c.z + IN_AUP] + (size_t)j * 64 * 512; const float* g_up = a.in[c.z + IN_GUP] + (size_t)j * 128 * 512;
    const int NS = 16 + 16 + 32 + (j > 0 ? 8 : 0);
    for (int it = gw; it < NS; it += NGW) {
      int r = it;
      if (r < 16) { transpose_item(w_up, 64, 512, WUPT, 0, nullptr, 0, 0, 1.f, scr, r, c.lane); continue; } r -= 16;
      if (r < 16) { transpose_item(a_up, 64, 512, AUPT, 0, nullptr, 0, 0, 1.f, scr, r, c.lane); continue; } r -= 16;
      if (r < 32) { transpose_item(g_up, 128, 512, GUPT, 0, nullptr, 0, 0, 1.f, scr, r, c.lane); continue; } r -= 32;
      transpose_item(a.in[c.z + IN_VDOWN] + (size_t)(j - 1) * 512 * 32, 512, 32, VDT, 0, nullptr, 0, 0, 1.f, scr, r, c.lane);
    }
    if (j > 0) { const float* v_up = a.in[c.z + IN_VUP] + (size_t)(j - 1) * 32 * 512;
      for (int e = c.bid * NTHR + c.tid; e < 32 * 512; e += c.G * NTHR) { const int n = e >> 5, k = e & 31; VUPT[e] = f2bf(v_up[(size_t)k * 512 + n]); } }
  }
  for (int it = gw; it < NIT; it += NGW) {
    int r = it;
    if (r < I_GU) { transpose_item(wgu0, DM, 2 * DFF, WGU0, 1, norms + 0 * DM, 0, 0, 1.f, scr, r, c.lane); continue; } r -= I_GU;
    if (r < I_GU) { transpose_item(wgu1, DM, 2 * DFF, WGU1, 1, norms + 4 * DM, 0, 0, 1.f, scr, r, c.lane); continue; } r -= I_GU;
    if (r < I_D) { transpose_item(wd0, DFF, DM, WD0, 0, nullptr, 0, 0, 1.f, scr, r, c.lane); continue; } r -= I_D;
    if (r < I_D) { transpose_item(wd1, DFF, DM, WD1, 0, nullptr, 0, 0, 1.f, scr, r, c.lane); continue; } r -= I_D;
    if (r < I_IN) { transpose_item(win, DM, NIN, WIN, 0, norms + 2 * DM, even ? 0 : 1024, even ? 0 : 2048, 0.0625f, scr, r, c.lane); continue; } r -= I_IN;
    transpose_item(wout, KOUT, DM, WOUT, 0, nullptr, 0, 0, 1.f, scr, r, c.lane);
  }
}

DI f32x4 bf4_to_f(const u32x2 w) { return (f32x4){__uint_as_float(w.x << 16), __uint_as_float(w.x & 0xffff0000u), __uint_as_float(w.y << 16), __uint_as_float(w.y & 0xffff0000u)}; }
DI void rowpass(const Ctx& c, const float* xin, float* xout, const bf16_t* F, const float* gain, float coef) {
  const int gw = c.bid * NWAVES + c.wave, NGW = c.G * NWAVES;
  bf16_t* XB = (bf16_t*)(c.ws + WS_XB); float* RINV = (float*)(c.ws + WS_RINV);
  f32x4 gv[4];
  if (F) {
#pragma unroll
    for (int j = 0; j < 4; ++j) gv[j] = *(const f32x4*)(gain + 256 * j + 4 * c.lane) * coef;
  }
#pragma unroll 2
  for (int row = gw; row < M_TOK; row += NGW) {
    f32x4 v[4];
    u32x2* xb = (u32x2*)(XB + (size_t)row * DM) + c.lane;
    if (xin) { const f32x4* xr = (const f32x4*)(xin + (size_t)row * DM) + c.lane;
#pragma unroll
      for (int j = 0; j < 4; ++j) v[j] = xr[64 * j]; }
    else {
#pragma unroll
      for (int j = 0; j < 4; ++j) v[j] = bf4_to_f(xb[64 * j]); }
    if (F) {
      const u32x2* fr = (const u32x2*)(F + (size_t)row * DM) + c.lane;
      f32x4 f[4]; float ss = 0.f;
#pragma unroll
      for (int j = 0; j < 4; ++j) { f[j] = bf4_to_f(fr[64 * j]); ss += (f[j].x * f[j].x + f[j].y * f[j].y) + (f[j].z * f[j].z + f[j].w * f[j].w); }
      const float r = __builtin_amdgcn_rsqf(wave_sum(ss) * (1.f / DM) + NORM_EPS);
#pragma unroll
      for (int j = 0; j < 4; ++j) v[j] = v[j] + f[j] * gv[j] * r;
    }
    if (xout) { f32x4* xo = (f32x4*)(xout + (size_t)row * DM) + c.lane;
#pragma unroll
      for (int j = 0; j < 4; ++j) xo[64 * j] = v[j]; }
    else {
      float s2 = 0.f;
#pragma unroll
      for (int j = 0; j < 4; ++j) { u32x2 w; w.x = cvtpk(v[j].x, v[j].y); w.y = cvtpk(v[j].z, v[j].w); xb[64 * j] = w;
        const f32x4 q = bf4_to_f(w); s2 += (q.x * q.x + q.y * q.y) + (q.z * q.z + q.w * q.w); }
      s2 = wave_sum(s2);
      if (c.lane == 0) RINV[row] = __builtin_amdgcn_rsqf(s2 * (1.f / DM) + NORM_EPS);
    }
  }
}

DI f32x4 ld_bf4(const bf16_t* p) { const u32x2 w = *(const u32x2*)p; return (f32x4){__uint_as_float(w.x << 16), __uint_as_float(w.x & 0xffff0000u), __uint_as_float(w.y << 16), __uint_as_float(w.y & 0xffff0000u)}; }
DI void st_bf4(bf16_t* p, f32x4 v) { u32x2 w; w.x = cvtpk(v.x, v.y); w.y = cvtpk(v.z, v.w); *(u32x2*)p = w; }
DI void rwkv_prep(const Ctx& c, const Args& a, int j) {
  const bf16_t* Z = (const bf16_t*)(c.ws + WS_ZEVEN);
  bf16_t* RW = (bf16_t*)(c.ws + WS_RW);
  bf16_t* VF = (bf16_t*)(c.ws + WS_VFIRST);
  const bf16_t* WUPT = (const bf16_t*)(c.ws + WS_LORA); const bf16_t* AUPT = WUPT + 512 * 64; const bf16_t* GUPT = AUPT + 512 * 64;
  const bf16_t* VDT = GUPT + 512 * 128; const bf16_t* VUPT = VDT + 32 * 512;
  const float* mu = a.in[c.z + IN_MU] + (size_t)j * 1792;
  const float* vec = a.in[c.z + IN_VEC] + (size_t)j * 7 * 512;
  const bool vres = j > 0;
  const float* v0p = a.in[c.z + IN_V0] + (size_t)(j > 0 ? j - 1 : 0) * 512;
  constexpr int XS = 528, VS = 1040, US = 80;
  LAS unsigned char* xsb = c.lds; LAS unsigned char* vsb = c.lds + 16896; LAS unsigned char* ub = c.lds + 50176;
  const int tid = c.tid, lane = c.lane, w = c.wave, l15 = lane & 15, quad = lane >> 4;
  for (int u = c.bid; u < M_TOK / 32; u += c.G) {
    const int t0 = u * 32; const bool first = (t0 % SEQ) == 0;
    __syncthreads();
    {
      const int cc = tid & 255, tg = tid >> 8; const float m = mu[1536 + cc];
      const int tb = t0 + tg * 16;
      float prev = (first && tg == 0) ? 0.f : bf2f(Z[(size_t)(tb - 1) * EVEN_IN + 3072 + cc]);
#pragma unroll 4
      for (int i = 0; i < 16; ++i) { const float cur = bf2f(Z[(size_t)(tb + i) * EVEN_IN + 3072 + cc]); const float zs = cur + (prev - cur) * m; prev = cur;
        const float val = cc < 64 ? tanhf_(zs) : (cc < 128 ? zs : sigmoidf_(zs)); *(LAS bf16_t*)(xsb + (tg * 16 + i) * XS + cc * 2) = f2bf(val); }
    }
    __syncthreads();
#pragma unroll 1
    for (int tt = 0; tt < 2; ++tt) {
      const int t = t0 + 16 * tt + l15; const bool tfirst = (t % SEQ) == 0;
      const LAS unsigned char* xr = xsb + (16 * tt + l15) * XS + quad * 16;
      float ss = 0.f;
#pragma unroll 2
      for (int ct = 0; ct < 4; ++ct) {
        const int col = 64 * w + 16 * ct + 4 * quad;
        const size_t wr = (size_t)(64 * w + 16 * ct + l15);
        f32x4 x = {0.f, 0.f, 0.f, 0.f}, z = x;
#pragma unroll
        for (int ks = 0; ks < 2; ++ks) x = MFMA16(*(const bf16x8*)(WUPT + wr * 64 + 32 * ks + 8 * quad), *(const LAS bf16x8*)(xr + ks * 64), x);
#pragma unroll
        for (int ks = 0; ks < 4; ++ks) z = MFMA16(*(const bf16x8*)(GUPT + wr * 128 + 32 * ks + 8 * quad), *(const LAS bf16x8*)(xr + 256 + ks * 64), z);
        const bf16_t* zp = Z + (size_t)t * EVEN_IN + 1536 + col;
        const f32x4 cr = ld_bf4(zp), ck = ld_bf4(zp + 512), cv = ld_bf4(zp + 1024);
        f32x4 pr = {0.f, 0.f, 0.f, 0.f}, pk = pr, pv = pr;
        if (!tfirst) { pr = ld_bf4(zp - EVEN_IN); pk = ld_bf4(zp - EVEN_IN + 512); pv = ld_bf4(zp - EVEN_IN + 1024); }
        const f32x4 mr = *(const f32x4*)(mu + col), mk = *(const f32x4*)(mu + 512 + col), mv = *(const f32x4*)(mu + 1024 + col);
        const f32x4 w0 = *(const f32x4*)(vec + col), k_k = *(const f32x4*)(vec + 1024 + col);
        const f32x4 rr = cr + (pr - cr) * mr, k1 = ck + (pk - ck) * mk, vv = cv + (pv - cv) * mv;
        f32x4 ew;
#pragma unroll
        for (int e = 0; e < 4; ++e) ew[e] = 0.60653065971f * sigmoidf_(w0[e] + x[e]);
        const f32x4 kkr = k1 * k_k; ss += (kkr.x * kkr.x + kkr.y * kkr.y) + (kkr.z * kkr.z + kkr.w * kkr.w);
        const size_t o = (size_t)t * 512 + col;
        st_bf4(RW + 0 * RW_STRIDE + o, ew); st_bf4(RW + 4 * RW_STRIDE + o, rr); st_bf4(RW + 6 * RW_STRIDE + o, z);
        if (!vres) { st_bf4(RW + 5 * RW_STRIDE + o, vv); st_bf4(VF + o, vv); }
        else { u32x2 wv; wv.x = cvtpk(vv.x, vv.y); wv.y = cvtpk(vv.z, vv.w); *(LAS u32x2*)(vsb + (16 * tt + l15) * VS + col * 2) = wv; }
      }
      ss += __shfl_xor(ss, 16); ss += __shfl_xor(ss, 32);
      const float rinv = 1.f / fmaxf(sqrtf(ss), 1e-12f);
#pragma unroll 2
      for (int ct = 0; ct < 4; ++ct) {
        const int col = 64 * w + 16 * ct + 4 * quad;
        const size_t wr = (size_t)(64 * w + 16 * ct + l15);
        f32x4 y = {0.f, 0.f, 0.f, 0.f};
#pragma unroll
        for (int ks = 0; ks < 2; ++ks) y = MFMA16(*(const bf16x8*)(AUPT + wr * 64 + 32 * ks + 8 * quad), *(const LAS bf16x8*)(xr + 128 + ks * 64), y);
        const bf16_t* zp = Z + (size_t)t * EVEN_IN + 1536 + 512 + col;
        const f32x4 ck = ld_bf4(zp); f32x4 pk = {0.f, 0.f, 0.f, 0.f};
        if (!tfirst) pk = ld_bf4(zp - EVEN_IN);
        const f32x4 mk = *(const f32x4*)(mu + 512 + col), a0 = *(const f32x4*)(vec + 512 + col);
        const f32x4 k_k = *(const f32x4*)(vec + 1024 + col), k_a = *(const f32x4*)(vec + 1536 + col);
        const f32x4 k1 = ck + (pk - ck) * mk;
        f32x4 a1;
#pragma unroll
        for (int e = 0; e < 4; ++e) a1[e] = sigmoidf_(a0[e] + y[e]);
        const f32x4 kk = k1 * k_k * rinv;
        const f32x4 kmod = k1 * (1.f + (a1 - 1.f) * k_a);
        const size_t o = (size_t)t * 512 + col;
        st_bf4(RW + 1 * RW_STRIDE + o, kk); st_bf4(RW + 2 * RW_STRIDE + o, kk * a1); st_bf4(RW + 3 * RW_STRIDE + o, kmod);
      }
    }
    if (vres) {
      __syncthreads();
      if (w < 4) { const int mt = w >> 1, tt = w & 1; f32x4 acc = {0.f, 0.f, 0.f, 0.f};
#pragma unroll 4
        for (int ks = 0; ks < 16; ++ks) acc = MFMA16(*(const bf16x8*)(VDT + (size_t)(16 * mt + l15) * 512 + 32 * ks + 8 * quad), *(const LAS bf16x8*)(vsb + (16 * tt + l15) * VS + (32 * ks + 8 * quad) * 2), acc);
        u32x2 wv; wv.x = cvtpk(acc.x, acc.y); wv.y = cvtpk(acc.z, acc.w); *(LAS u32x2*)(ub + (16 * tt + l15) * US + (16 * mt + 4 * quad) * 2) = wv; }
      __syncthreads();
#pragma unroll 2
      for (int ct = 0; ct < 4; ++ct) {
        const int col = 64 * w + 16 * ct + 4 * quad;
        const bf16x8 fu = *(const bf16x8*)(VUPT + (size_t)(64 * w + 16 * ct + l15) * 32 + 8 * quad);
        const f32x4 v0 = *(const f32x4*)(v0p + col);
#pragma unroll
        for (int tt = 0; tt < 2; ++tt) {
          f32x4 sacc = {0.f, 0.f, 0.f, 0.f};
          sacc = MFMA16(fu, *(const LAS bf16x8*)(ub + (16 * tt + l15) * US + quad * 16), sacc);
          const size_t o = (size_t)(t0 + 16 * tt + l15) * 512 + col;
          const u32x2 wv = *(const LAS u32x2*)(vsb + (16 * tt + l15) * VS + col * 2);
          const f32x4 vv = {__uint_as_float(wv.x << 16), __uint_as_float(wv.x & 0xffff0000u), __uint_as_float(wv.y << 16), __uint_as_float(wv.y & 0xffff0000u)};
          const f32x4 vf = ld_bf4(VF + o); f32x4 r;
#pragma unroll
          for (int e = 0; e < 4; ++e) r[e] = vv[e] + (vf[e] - vv[e]) * sigmoidf_(v0[e] + sacc[e]);
          st_bf4(RW + 5 * RW_STRIDE + o, r);
        }
      }
    }
  }
}

DI void rwkv_scan_item(const Ctx& c, int item) {
  const int bh = item >> 2, qtr = item & 3, b = bh >> 3, h = bh & 7;
  const bf16_t* RW = (const bf16_t*)(c.ws + WS_RW);
  bf16_t* MIX = (bf16_t*)(c.ws + WS_MIXE);
  const int tid = c.tid, lane = c.lane, rg = lane >> 4, c4 = lane & 15, row = (c.wave & 3) * 4 + rg;
  constexpr int BUF_F = 32 * 320 + 32 * 16;
  LAS float* buf0 = (LAS float*)c.lds;
  LAS float* ybuf = (LAS float*)c.lds + 2 * BUF_F;
  const size_t tokbase = (size_t)b * SEQ;
  const int i2 = tid & 255;
  const int l_step = i2 >> 3, l_c8 = i2 & 7, l_arr = tid >> 8;
  const bf16_t* src01 = RW + (size_t)l_arr * RW_STRIDE + (tokbase + l_step) * 512 + h * 64 + l_c8 * 8;
  const int vid = tid - 256;
  const bf16_t* srcv = RW + 5 * RW_STRIDE + (tokbase + ((vid >> 1) & 31)) * 512 + h * 64 + qtr * 16 + (vid & 1) * 8;
  bf16x8 p0, p1, p2;
  auto issue = [&](int ch) {
    const size_t off = (size_t)ch * 32 * 512;
    p0 = *(const bf16x8*)(src01 + off); p1 = *(const bf16x8*)(src01 + 2 * RW_STRIDE + off);
    if (tid < 256) p2 = *(const bf16x8*)(src01 + 4 * RW_STRIDE + off);
    else if (tid < 320) p2 = *(const bf16x8*)(srcv + off);
  };
  auto stash = [&](int bsel) {
    LAS float* B = buf0 + bsel * BUF_F;
    float f[8];
    { unpack8(p0, f); LAS float* d = B + l_step * 320 + l_arr * 64 + l_c8 * 8;
      if (l_arr == 0) {
#pragma unroll
        for (int e = 0; e < 8; ++e) f[e] = __builtin_amdgcn_exp2f(-f[e] * LOG2E);
      } else {
#pragma unroll
        for (int e = 0; e < 8; ++e) f[e] = -f[e];
      }
      *(LAS f32x4*)d = (f32x4){f[0], f[1], f[2], f[3]}; *(LAS f32x4*)(d + 4) = (f32x4){f[4], f[5], f[6], f[7]}; }
    { unpack8(p1, f); LAS float* d = B + l_step * 320 + (l_arr + 2) * 64 + l_c8 * 8;
      *(LAS f32x4*)d = (f32x4){f[0], f[1], f[2], f[3]}; *(LAS f32x4*)(d + 4) = (f32x4){f[4], f[5], f[6], f[7]}; }
    if (tid < 256) { unpack8(p2, f); LAS float* d = B + l_step * 320 + 4 * 64 + l_c8 * 8;
      *(LAS f32x4*)d = (f32x4){f[0], f[1], f[2], f[3]}; *(LAS f32x4*)(d + 4) = (f32x4){f[4], f[5], f[6], f[7]}; }
    else if (tid < 320) { unpack8(p2, f); LAS float* d = B + 32 * 320 + (vid >> 1) * 16 + (vid & 1) * 8;
      *(LAS f32x4*)d = (f32x4){f[0], f[1], f[2], f[3]}; *(LAS f32x4*)(d + 4) = (f32x4){f[4], f[5], f[6], f[7]}; }
  };
  __syncthreads();
  issue(0); stash(0);
  if (1 < SEQ / 32) issue(1);
  __syncthreads();
  f32x2 S0 = {0.f, 0.f}, S1 = {0.f, 0.f};
#pragma unroll 1
  for (int ch = 0; ch < SEQ / 32; ++ch) {
    if (ch + 1 < SEQ / 32) stash((ch + 1) & 1);
    if (ch + 2 < SEQ / 32) issue(ch + 2);
    LAS float* yb = ybuf + (ch & 1) * 512;
    if (c.wave < 4) {
      const LAS float* B = buf0 + (ch & 1) * BUF_F;
      const LAS float* Lb = B + c4 * 4; const LAS float* Vb = B + 32 * 320 + row;
      float yk0 = 0.f, yk1 = 0.f;
      f32x4 dw = *(const LAS f32x4*)(Lb), nk = *(const LAS f32x4*)(Lb + 64), ka = *(const LAS f32x4*)(Lb + 128), kv = *(const LAS f32x4*)(Lb + 192), rv = *(const LAS f32x4*)(Lb + 256);
      float vv = Vb[0];
#pragma unroll
      for (int s = 0; s < 32; ++s) {
        f32x4 dwn = dw, nkn = nk, kan = ka, kvn = kv, rvn = rv; float vvn = vv;
        if (s + 1 < 32) { const LAS float* L = Lb + (s + 1) * 320;
          dwn = *(const LAS f32x4*)(L); nkn = *(const LAS f32x4*)(L + 64); kan = *(const LAS f32x4*)(L + 128); kvn = *(const LAS f32x4*)(L + 192); rvn = *(const LAS f32x4*)(L + 256);
          vvn = Vb[(s + 1) * 16]; }
        __builtin_amdgcn_sched_barrier(0);
        f32x2 t = S0 * (f32x2){nk.x, nk.y}; t = S1 * (f32x2){nk.z, nk.w} + t;
        const float sa = row16_sum(t.x + t.y);
        const f32x2 tk0 = (f32x2){kv.x, kv.y} * vv, tk1 = (f32x2){kv.z, kv.w} * vv;
        S0 = S0 * (f32x2){dw.x, dw.y} + tk0; S1 = S1 * (f32x2){dw.z, dw.w} + tk1;
        S0 = (f32x2){ka.x, ka.y} * sa + S0; S1 = (f32x2){ka.z, ka.w} * sa + S1;
        f32x2 u = S0 * (f32x2){rv.x, rv.y}; u = S1 * (f32x2){rv.z, rv.w} + u;
        const float y = row16_sum(u.x + u.y);
        if (s < 16) yk0 = (c4 == s) ? y : yk0; else yk1 = (c4 == s - 16) ? y : yk1;
        __builtin_amdgcn_sched_barrier(0);
        dw = dwn; nk = nkn; ka = kan; kv = kvn; rv = rvn; vv = vvn;
      }
      yb[c4 * 16 + row] = yk0; yb[(16 + c4) * 16 + row] = yk1;
    }
    lds_barrier();
    if (tid < 256) { const int s = tid >> 3, r2 = (tid & 7) * 2; const float y0 = yb[s * 16 + r2], y1 = yb[s * 16 + r2 + 1];
      *(unsigned*)(MIX + (tokbase + ch * 32 + s) * 1024 + 512 + h * 64 + qtr * 16 + r2) = cvtpk(y0, y1); }
  }
}

DI void attn_unit(const Ctx& c, const Args& a, int j, int b, int h, int c2, float lam, float lam_init) {
  const bf16_t* Z = (const bf16_t*)(c.ws + WS_ZEVEN) + (size_t)b * SEQ * EVEN_IN;
  bf16_t* MIX = (bf16_t*)(c.ws + WS_MIXE) + (size_t)b * SEQ * 1024;
  const float* subln = a.in[c.z + IN_SUBLN] + (size_t)j * 128;
  const int tid = c.tid, lane = c.lane, wave = c.wave, l15 = lane & 15, quad = lane >> 4, q_ = l15 >> 2, p_ = l15 & 3;
  const int q0 = 128 * c2 + 16 * wave, my_chunk = 2 * c2 + (wave >> 2), nkt = 2 * c2 + 2;
  constexpr int RS = 272, IMG = 64 * RS, BUFB = 2 * IMG;
  bf16x8 qf[2][2];
#pragma unroll
  for (int m = 0; m < 2; ++m)
#pragma unroll
    for (int ks = 0; ks < 2; ++ks) qf[m][ks] = *(const bf16x8*)(Z + (size_t)(q0 + l15) * EVEN_IN + h * 128 + m * 64 + ks * 32 + quad * 8);
  f32x4 o[2][8];
#pragma unroll
  for (int m = 0; m < 2; ++m)
#pragma unroll
    for (int d = 0; d < 8; ++d) o[m][d] = (f32x4){0.f, 0.f, 0.f, 0.f};
  float mrun[2] = {-1e30f, -1e30f}, lrun[2] = {0.f, 0.f};
  const float slope2 = __builtin_amdgcn_exp2f(-2.f * (float)(h + 1)) * LOG2E, sc2 = 0.125f * LOG2E;
  u32x4 pf[4];
  const int prow = tid >> 4, pc16 = tid & 15;
  const bf16_t* ksrc = Z + (size_t)prow * EVEN_IN + 512 + h * 128 + pc16 * 8;
  auto issue = [&](int kt) {
    const bf16_t* s = ksrc + (size_t)kt * 64 * EVEN_IN;
    pf[0] = *(const u32x4*)(s); pf[1] = *(const u32x4*)(s + (size_t)32 * EVEN_IN);
    pf[2] = *(const u32x4*)(s + 512); pf[3] = *(const u32x4*)(s + (size_t)32 * EVEN_IN + 512);
  };
  auto stash = [&](int bsel) {
    LAS unsigned char* B = c.lds + bsel * BUFB + prow * RS + pc16 * 16;
    *(LAS u32x4*)(B) = pf[0]; *(LAS u32x4*)(B + 32 * RS) = pf[1]; *(LAS u32x4*)(B + IMG) = pf[2]; *(LAS u32x4*)(B + IMG + 32 * RS) = pf[3];
  };
  issue(0); stash(0);
  __syncthreads();
#pragma unroll 1
  for (int kt = 0; kt < nkt; ++kt) {
    const bool has_next = kt + 1 < nkt;
    if (has_next) issue(kt + 1);
    if (kt <= my_chunk) {
      const LAS unsigned char* Kb = c.lds + (kt & 1) * BUFB; const LAS unsigned char* Vb = Kb + IMG;
      f32x4 s[2][4];
#pragma unroll
      for (int m = 0; m < 2; ++m)
#pragma unroll
        for (int t16 = 0; t16 < 4; ++t16) { f32x4 acc = {0.f, 0.f, 0.f, 0.f};
#pragma unroll
          for (int ks = 0; ks < 2; ++ks) { const bf16x8 kf = *(const LAS bf16x8*)(Kb + (16 * t16 + l15) * RS + (m * 64 + ks * 32 + quad * 8) * 2); acc = MFMA16(kf, qf[m][ks], acc); }
          s[m][t16] = acc; }
      const float dbase = (float)(q0 + l15 - 64 * kt - 4 * quad);
      bf16x8 pfr[2][2];
#pragma unroll
      for (int m = 0; m < 2; ++m) {
        float mx = -1e30f;
#pragma unroll
        for (int t16 = 0; t16 < 4; ++t16)
#pragma unroll
          for (int e = 0; e < 4; ++e) { const float d = __builtin_fabsf(dbase - (float)(16 * t16 + e)); const float v = s[m][t16][e] * sc2 - slope2 * d; s[m][t16][e] = v; mx = fmaxf(mx, v); }
        mx = fmaxf(mx, __shfl_xor(mx, 16)); mx = fmaxf(mx, __shfl_xor(mx, 32));
        const float mnew = fmaxf(mrun[m], mx), alpha = __builtin_amdgcn_exp2f(mrun[m] - mnew); mrun[m] = mnew;
        float ps = 0.f;
#pragma unroll
        for (int t16 = 0; t16 < 4; ++t16)
#pragma unroll
          for (int e = 0; e < 4; ++e) { const float p = __builtin_amdgcn_exp2f(s[m][t16][e] - mnew); s[m][t16][e] = p; ps += p; }
        lrun[m] = lrun[m] * alpha + ps;
#pragma unroll
        for (int d = 0; d < 8; ++d) o[m][d] = o[m][d] * alpha;
#pragma unroll
        for (int s2 = 0; s2 < 2; ++s2) { u32x4 w; w.x = cvtpk(s[m][2 * s2][0], s[m][2 * s2][1]); w.y = cvtpk(s[m][2 * s2][2], s[m][2 * s2][3]);
          w.z = cvtpk(s[m][2 * s2 + 1][0], s[m][2 * s2 + 1][1]); w.w = cvtpk(s[m][2 * s2 + 1][2], s[m][2 * s2 + 1][3]); pfr[m][s2] = __builtin_bit_cast(bf16x8, w); }
      }
#pragma unroll
      for (int s2 = 0; s2 < 2; ++s2)
#pragma unroll
        for (int d = 0; d < 8; ++d) {
          const LAS unsigned char* vp = Vb + (32 * s2 + 4 * quad + q_) * RS + (16 * d + 4 * p_) * 2;
          const bf16x8 vf = comb8(tr_read(vp), tr_read(vp + 16 * RS));
          o[0][d] = MFMA16(vf, pfr[0][s2], o[0][d]); o[1][d] = MFMA16(vf, pfr[1][s2], o[1][d]);
        }
    }
    if (has_next) stash((kt + 1) & 1);
    lds_barrier();
  }
  float inv[2];
#pragma unroll
  for (int m = 0; m < 2; ++m) { float l = lrun[m]; l += __shfl_xor(l, 16); l += __shfl_xor(l, 32); inv[m] = 1.f / l; }
  const float i1 = lam * inv[1];
  float ss = 0.f;
#pragma unroll
  for (int d = 0; d < 8; ++d)
#pragma unroll
    for (int e = 0; e < 4; ++e) { const float v = o[0][d][e] * inv[0] - o[1][d][e] * i1; o[0][d][e] = v; ss += v * v; }
  ss += __shfl_xor(ss, 16); ss += __shfl_xor(ss, 32);
  const float rn = __builtin_amdgcn_rsqf(ss * (1.f / 128.f) + NORM_EPS) * (1.f - lam_init);
  bf16_t* orow = MIX + (size_t)(q0 + l15) * 1024 + h * 128 + 4 * quad;
#pragma unroll
  for (int d = 0; d < 8; ++d) { const f32x4 g = *(const f32x4*)(subln + 16 * d + 4 * quad);
    u32x2 w; w.x = cvtpk(o[0][d][0] * rn * g.x, o[0][d][1] * rn * g.y); w.y = cvtpk(o[0][d][2] * rn * g.z, o[0][d][3] * rn * g.w);
    *(u32x2*)(orow + 16 * d) = w; }
}

DI void attn_phase(const Ctx& c, const Args& a, int j, int layer, unsigned* counter) {
  const float* lv = a.in[c.z + IN_LAM] + (size_t)j * 4 * 64;
  const float lam_init = 0.8f - 0.6f * __expf(-0.3f * (float)layer);
  const float d1 = wave_sum(lv[c.lane] * lv[64 + c.lane]), d2 = wave_sum(lv[128 + c.lane] * lv[192 + c.lane]);
  const float lam = __expf(d1) - __expf(d2) + lam_init;
  LAS int* qw = (LAS int*)(c.lds + LDS_MAIN + 64);
  const int x = (int)(xb_xcc_id() & 7u);
  for (int qi = 0; qi < 8; ++qi) { const int q = (x + qi) & 7;
    for (;;) {
      __syncthreads();
      if (c.tid == 0) *qw = (int)atomicAdd(counter + q, 1u);
      __syncthreads();
      const int item = *qw;
      if (item >= 128) break;
      const int c2 = 31 - (item & 31), bh = q * 4 + (item >> 5);
      attn_unit(c, a, j, bh >> 2, bh & 3, c2, lam, lam_init);
    }
  }
}

DI void rwkv_post(const Ctx& c, const Args& a, int j) {
  const bf16_t* RW = (const bf16_t*)(c.ws + WS_RW);
  bf16_t* MIX = (bf16_t*)(c.ws + WS_MIXE);
  const float* vec = a.in[c.z + IN_VEC] + (size_t)j * 7 * 512;
  const int gw = c.bid * NWAVES + c.wave, NGW = c.G * NWAVES;
  for (int p = gw; p < M_TOK * 8; p += NGW) {
    const int t = p >> 3, h = p & 7, cc = h * 64 + c.lane; const size_t o = (size_t)t * 512 + cc;
    const float y = bf2f(MIX[(size_t)t * 1024 + 512 + cc]);
    const float r = bf2f(RW[4 * RW_STRIDE + o]), k = bf2f(RW[3 * RW_STRIDE + o]), v = bf2f(RW[5 * RW_STRIDE + o]), g = bf2f(RW[6 * RW_STRIDE + o]);
    const float mean = wave_sum(y) * (1.f / 64.f), d = y - mean, var = wave_sum(d * d) * (1.f / 64.f);
    const float yn = d * __builtin_amdgcn_rsqf(var + 64e-5f) * vec[5 * 512 + cc] + vec[6 * 512 + cc];
    const float bonus = wave_sum(r * k * vec[4 * 512 + cc]) * v;
    MIX[(size_t)t * 1024 + 512 + cc] = f2bf((yn + bonus) * g);
  }
}

DI void retention_unit(const Ctx& c, int bh, int slice) {
  const int b = bh >> 2, h = bh & 3;
  const bf16_t* Zq = (const bf16_t*)(c.ws + WS_ZODD) + (size_t)bh * SEQ * 256;
  const bf16_t* Zv = (const bf16_t*)(c.ws + WS_ZODD) + 67108864u + (size_t)(bh * 8 + slice) * SEQ * 64;
  bf16_t* YB = (bf16_t*)(c.ws + WS_YB) + (size_t)b * SEQ * 2048 + h * 512 + slice * 64;
  const int tid = c.tid, lane = c.lane, wave = c.wave, l15 = lane & 15, quad = lane >> 4, q_ = l15 >> 2, p_ = l15 & 3;
  constexpr int RQ = 528, RV = 144;
  LAS unsigned char* Qi = c.lds; LAS unsigned char* Ki = c.lds + 33792; LAS unsigned char* Vi = c.lds + 67584; LAS unsigned char* Vdi = c.lds + 76800;
  LAS unsigned char* Sci = c.lds + 86016; LAS unsigned char* Si = c.lds + 95232;
  const float log2g = __log2f(1.f - __builtin_amdgcn_exp2f(-5.f - (float)h));
  const float cd = __builtin_amdgcn_exp2f(log2g * 64.f);
  f32x4 st[2][4];
#pragma unroll
  for (int mt = 0; mt < 2; ++mt)
#pragma unroll
    for (int nt = 0; nt < 4; ++nt) st[mt][nt] = (f32x4){0.f, 0.f, 0.f, 0.f};
  u32x4 pq[4], pk[4], pv;
  const int prow = tid >> 5, pc = tid & 31;
  const bf16_t* qsrc = Zq + (size_t)tid * 8;
  const int vrow = tid >> 3, vc = tid & 7;
  const bf16_t* vsrc = Zv + (size_t)tid * 8;
  auto issue = [&](int ch) {
#pragma unroll
    for (int i = 0; i < 4; ++i) { pq[i] = *(const u32x4*)(qsrc + (size_t)ch * 16384 + i * 4096); pk[i] = *(const u32x4*)(qsrc + 33554432u + (size_t)ch * 16384 + i * 4096); }
    pv = *(const u32x4*)(vsrc + (size_t)ch * 4096);
  };
  auto stash = [&]() {
#pragma unroll
    for (int i = 0; i < 4; ++i) { *(LAS u32x4*)(Qi + (prow + 16 * i) * RQ + pc * 16) = pq[i]; *(LAS u32x4*)(Ki + (prow + 16 * i) * RQ + pc * 16) = pk[i]; }
    *(LAS u32x4*)(Vi + vrow * RV + vc * 16) = pv;
  };
  __syncthreads();
  issue(0);
  for (int i = tid; i < 33792 / 16; i += NTHR) *(LAS u32x4*)(Si + i * 16) = (u32x4){0u, 0u, 0u, 0u};
  stash();
  __syncthreads();
#pragma unroll 1
  for (int ch = 0; ch < 64; ++ch) {
    if (ch + 1 < 64) issue(ch + 1);
    {
      const int it = wave >> 1;
#pragma unroll
      for (int jj2 = 0; jj2 < 2; ++jj2) { const int jt = 2 * (wave & 1) + jj2; f32x4 acc = {0.f, 0.f, 0.f, 0.f};
#pragma unroll
        for (int ks = 0; ks < 8; ++ks) { const bf16x8 kf = *(const LAS bf16x8*)(Ki + (16 * jt + l15) * RQ + (32 * ks + 8 * quad) * 2);
          const bf16x8 qf = *(const LAS bf16x8*)(Qi + (16 * it + l15) * RQ + (32 * ks + 8 * quad) * 2); acc = MFMA16(kf, qf, acc); }
        const int i = 16 * it + l15, j0 = 16 * jt + 4 * quad; float v[4];
#pragma unroll
        for (int e = 0; e < 4; ++e) v[e] = acc[e] * __builtin_amdgcn_exp2f(log2g * __builtin_fabsf((float)(i - j0 - e)));
        u32x2 w; w.x = cvtpk(v[0], v[1]); w.y = cvtpk(v[2], v[3]); *(LAS u32x2*)(Sci + i * RV + j0 * 2) = w; }
      { const bf16x8 v8 = *(const LAS bf16x8*)(Vi + vrow * RV + vc * 16); float f[8]; unpack8(v8, f); const float kd = __builtin_amdgcn_exp2f(log2g * (float)(63 - vrow));
        u32x4 w; w.x = cvtpk(f[0] * kd, f[1] * kd); w.y = cvtpk(f[2] * kd, f[3] * kd); w.z = cvtpk(f[4] * kd, f[5] * kd); w.w = cvtpk(f[6] * kd, f[7] * kd);
        *(LAS u32x4*)(Vdi + vrow * RV + vc * 16) = w; }
    }
    lds_barrier();
    {
      const int et = wave >> 1;
#pragma unroll
      for (int ii = 0; ii < 2; ++ii) { const int it2 = 2 * (wave & 1) + ii; f32x4 acc = {0.f, 0.f, 0.f, 0.f};
#pragma unroll
        for (int ks = 0; ks < 8; ++ks) { const bf16x8 sf = *(const LAS bf16x8*)(Si + (16 * et + l15) * RQ + (32 * ks + 8 * quad) * 2);
          const bf16x8 qf = *(const LAS bf16x8*)(Qi + (16 * it2 + l15) * RQ + (32 * ks + 8 * quad) * 2); acc = MFMA16(sf, qf, acc); }
        const float qd = __builtin_amdgcn_exp2f(log2g * (float)(16 * it2 + l15 + 1)); acc = acc * qd;
#pragma unroll
        for (int s = 0; s < 2; ++s) { const LAS unsigned char* vp = Vi + (32 * s + 8 * quad + q_) * RV + (16 * et + 4 * p_) * 2;
          const bf16x8 vf = comb8(tr_read(vp), tr_read(vp + 4 * RV));
          const bf16x8 sc = *(const LAS bf16x8*)(Sci + (16 * it2 + l15) * RV + (32 * s + 8 * quad) * 2); acc = MFMA16(vf, sc, acc); }
        u32x2 w; w.x = cvtpk(acc[0], acc[1]); w.y = cvtpk(acc[2], acc[3]);
        *(u32x2*)(YB + (size_t)(ch * 64 + 16 * it2 + l15) * 2048 + 16 * et + 4 * quad) = w; }
#pragma unroll
      for (int mt = 0; mt < 2; ++mt)
#pragma unroll
        for (int nt = 0; nt < 4; ++nt) st[mt][nt] = st[mt][nt] * cd;
#pragma unroll
      for (int s = 0; s < 2; ++s) { bf16x8 vd[4];
#pragma unroll
        for (int nt = 0; nt < 4; ++nt) { const LAS unsigned char* vp = Vdi + (32 * s + 8 * quad + q_) * RV + (16 * nt + 4 * p_) * 2; vd[nt] = comb8(tr_read(vp), tr_read(vp + 4 * RV)); }
#pragma unroll
        for (int mt = 0; mt < 2; ++mt) { const LAS unsigned char* kp = Ki + (32 * s + 8 * quad + q_) * RQ + (32 * wave + 16 * mt + 4 * p_) * 2;
          const bf16x8 kf = comb8(tr_read(kp), tr_read(kp + 4 * RQ));
#pragma unroll
          for (int nt = 0; nt < 4; ++nt) st[mt][nt] = MFMA16(kf, vd[nt], st[mt][nt]); } }
    }
    lds_barrier();
#pragma unroll
    for (int mt = 0; mt < 2; ++mt)
#pragma unroll
      for (int nt = 0; nt < 4; ++nt) { u32x2 w; w.x = cvtpk(st[mt][nt][0], st[mt][nt][1]); w.y = cvtpk(st[mt][nt][2], st[mt][nt][3]);
        *(LAS u32x2*)(Si + (16 * nt + l15) * RQ + (32 * wave + 16 * mt + 4 * quad) * 2) = w; }
    if (ch + 1 < 64) stash();
    lds_barrier();
  }
}

DI void retention_post(const Ctx& c) {
  const bf16_t* YB = (const bf16_t*)(c.ws + WS_YB);
  bf16_t* Z = (bf16_t*)(c.ws + WS_ZODD);
  const int gw = c.bid * NWAVES + c.wave, NGW = c.G * NWAVES;
  for (int p = gw; p < M_TOK * 4; p += NGW) {
    const int t = p >> 2, h = p & 3;
    const bf16x8 y8 = *(const bf16x8*)(YB + (size_t)t * 2048 + h * 512 + c.lane * 8);
    bf16_t* gp = Z + 134217728u + (size_t)t * 2048 + h * 512 + c.lane * 8;
    const bf16x8 g8 = *(const bf16x8*)gp;
    float y[8], g[8]; unpack8(y8, y); unpack8(g8, g);
    float ss = 0.f;
#pragma unroll
    for (int e = 0; e < 8; ++e) ss += y[e] * y[e];
    const float rn = __builtin_amdgcn_rsqf(wave_sum(ss) * (1.f / 512.f) + NORM_EPS);
#pragma unroll
    for (int e = 0; e < 8; ++e) y[e] = siluf_(g[e]) * y[e] * rn;
    u32x4 w; w.x = cvtpk(y[0], y[1]); w.y = cvtpk(y[2], y[3]); w.z = cvtpk(y[4], y[5]); w.w = cvtpk(y[6], y[7]);
    *(u32x4*)gp = w;
  }
}

#define XB_TMO      128
#define XB_XCNT(j)  (256  + 64 * (j))
#define XB_XSUB(j)  (1280 + 64 * (j))
#define XB_XGEN(j)  (2304 + 64 * (j))
#define XB_TOP      3328
#define XB_TOPGEN   3392
#define XCD_BAR_WORDS 3456
#define XB_SPIN_CAP (1u << 18)
__device__ __forceinline__ unsigned xb_ld(unsigned* p)              { return __hip_atomic_load(p, __ATOMIC_RELAXED, __HIP_MEMORY_SCOPE_AGENT); }
__device__ __forceinline__ unsigned xb_add(unsigned* p, unsigned v) { return __hip_atomic_fetch_add(p, v, __ATOMIC_RELAXED, __HIP_MEMORY_SCOPE_AGENT); }
#define XB_SPIN(cond, bar) do { unsigned _sp = 0; while (cond) { __builtin_amdgcn_s_sleep(1); \
    if ((++_sp & 255u) == 0u) { if (xb_ld(&(bar)[XB_TMO])) break; if (_sp > XB_SPIN_CAP) { atomicAdd(&(bar)[XB_TMO], 1u); break; } } } } while (0)
struct XcdBarrier { unsigned* bar; unsigned x; volatile LAS unsigned* st; };
__device__ __forceinline__ XcdBarrier xcd_barrier_post(unsigned* bar, volatile LAS unsigned* st) {
    XcdBarrier b; b.bar = bar; b.x = xb_xcc_id(); b.st = st;
    if (threadIdx.x == 0) (void)xb_add(&bar[XB_XCNT(b.x)], 1u);
    return b;
}
__device__ __forceinline__ void xcd_barrier_complete(unsigned* bar, unsigned x, unsigned& nloc, unsigned& nx) {
    const unsigned G = gridDim.x * gridDim.y * gridDim.z;
    unsigned sum, cnt, mine, sp = 0u;
    for (;;) {
        sum = 0u; cnt = 0u; mine = 0u;
#pragma unroll
        for (unsigned j = 0; j < 16; ++j) { const unsigned c = xb_ld(&bar[XB_XCNT(j)]); sum += c; cnt += (c > 0u) ? 1u : 0u; mine = (j == x) ? c : mine; }
        if (sum == G) break;
        __builtin_amdgcn_s_sleep(1);
        if ((++sp & 255u) == 0u) { if (xb_ld(&bar[XB_TMO])) break; if (sp > XB_SPIN_CAP) { atomicAdd(&bar[XB_TMO], 1u); break; } }
    }
    nloc = mine > 0u ? mine : 1u; nx = cnt > 0u ? cnt : 1u;
}
__device__ __forceinline__ void xcd_barrier(const XcdBarrier& b) {
    asm volatile("s_waitcnt vmcnt(0)" ::: "memory");
    __syncthreads();
    if (threadIdx.x == 0) {
        unsigned* bar = b.bar;
        __builtin_amdgcn_s_waitcnt(0);
        unsigned nloc = b.st[0], nx = b.st[1];
        if (nloc == 0u) { xcd_barrier_complete(bar, b.x, nloc, nx); b.st[0] = nloc; b.st[1] = nx; }
        const unsigned old = xb_add(&bar[XB_XSUB(b.x)], 1u);
        const unsigned gen = old / nloc;
        if (old + 1u == (gen + 1u) * nloc) {
            __builtin_amdgcn_fence(__ATOMIC_RELEASE, "agent");
            asm volatile("s_waitcnt vmcnt(0)" ::: "memory");
            const unsigned og = xb_add(&bar[XB_TOP], 1u);
            const unsigned tg = og / nx;
            if (og + 1u == (tg + 1u) * nx) xb_add(&bar[XB_TOPGEN], 1u);
            else XB_SPIN(xb_ld(&bar[XB_TOPGEN]) == tg, bar);
            __builtin_amdgcn_fence(__ATOMIC_ACQUIRE, "agent");
            xb_add(&bar[XB_XGEN(b.x)], 1u);
            asm volatile("s_waitcnt vmcnt(0)" ::: "memory");
        } else {
            XB_SPIN(xb_ld(&bar[XB_XGEN(b.x)]) == gen, bar);
            __builtin_amdgcn_fence(__ATOMIC_ACQUIRE, "agent");
            asm volatile("s_waitcnt vmcnt(0)" ::: "memory");
        }
    }
    __syncthreads();
}

enum { T_CONV = 0, T_GU_A, T_DOWN_A, T_ROW1, T_WIN, T_PREP, T_SCAN, T_MIX, T_POST, T_WOUT, T_ROW3, T_GU_B, T_DOWN_B, T_RET, T_RETPOST, T_FINAL };
__global__ void __launch_bounds__(NTHR, 2) fwd_megakernel(Args args) {
  extern __shared__ __attribute__((aligned(16))) unsigned char lds_raw[];
  cg::grid_group grid = cg::this_grid();
  const int lo = args.ph_lo, hi = args.ph_hi;
  volatile LAS unsigned* bst = (volatile LAS unsigned*)((LAS unsigned char*)lds_raw + LDS_MAIN + 128);
  if (threadIdx.x < 2) bst[threadIdx.x] = 0u;
  __syncthreads();
  XcdBarrier xbar; xbar.bar = (unsigned*)(args.ws + WS_CTL) + 4096; xbar.x = 0; xbar.st = bst;
  if (!MK_PER_PHASE) xbar = xcd_barrier_post((unsigned*)(args.ws + WS_CTL) + 4096, bst);
#pragma unroll 1
  for (int ph = lo; ph < hi; ++ph) {
    Ctx c;
    { int tid = threadIdx.x, bid = blockIdx.x, G = gridDim.x, z = 0;
      asm volatile("" : "+v"(tid)); asm volatile("" : "+s"(bid), "+s"(G), "+s"(z));
      unsigned char* ws = args.ws + z; float* out = args.out + z;
      c.lds = (LAS unsigned char*)lds_raw; c.tid = tid; c.lane = tid & 63; c.wave = __builtin_amdgcn_readfirstlane(tid >> 6);
      c.G = G; c.bid = bid; c.z = z; c.ws = ws; c.out = out; }
    int L, k;
    if (ph < 12) { L = 0; k = ph; } else if (ph < 23) { L = 1; k = ph - 12; } else if (ph < 35) { L = 2; k = ph - 23; } else if (ph < 46) { L = 3; k = ph - 35; } else { L = 4; k = 0; }
    int type;
    if (L == 4) type = T_FINAL;
    else if ((L & 1) == 0) type = (k <= T_MIX) ? k : k + 1;
    else type = (k <= 4) ? k : (k == 5 ? T_RET : (k == 6 ? T_RETPOST : k + 2));
    const bool even = (L & 1) == 0; const int j = L >> 1;
    const bool is_gemm = (type == T_GU_A || type == T_DOWN_A || type == T_WIN || type == T_WOUT || type == T_GU_B || type == T_DOWN_B);
    if (is_gemm) {
      pg8::Gemm g; pg8::EpiRT E;
      bf16_t* XB = (bf16_t*)(c.ws + WS_XB); bf16_t* F = (bf16_t*)(c.ws + WS_F); bf16_t* H = (bf16_t*)(c.ws + WS_H);
      const float* RINV = (const float*)(c.ws + WS_RINV);
      g.M = M_TOK;
      if (type == T_GU_A || type == T_GU_B) { g.A = XB; g.Bt = (const bf16_t*)(c.ws + (type == T_GU_A ? WS_WGU0 : WS_WGU1)); g.N = 2 * DFF; g.K = DM; g.lda = DM; g.ldb = DM; E.mode = 2; E.O = H; E.ldc = DFF; E.rs = RINV; }
      else if (type == T_DOWN_A || type == T_DOWN_B) { g.A = H; g.Bt = (const bf16_t*)(c.ws + (type == T_DOWN_A ? WS_WD0 : WS_WD1)); g.N = DM; g.K = DFF; g.lda = DFF; g.ldb = DFF; E.mode = 0; E.O = F; E.ldc = DM; E.rs = RINV; }
      else if (type == T_WIN) { const int NIN = even ? EVEN_IN : ODD_IN; g.A = XB; g.Bt = (const bf16_t*)(c.ws + WS_WIN); g.N = NIN; g.K = DM; g.lda = DM; g.ldb = DM; E.mode = even ? 1 : 3; E.O = (bf16_t*)(c.ws + (even ? WS_ZEVEN : WS_ZODD)); E.ldc = NIN; E.rs = RINV; }
      else { if (even) { g.A = (const bf16_t*)(c.ws + WS_MIXE); g.K = DM; g.lda = DM; g.ldb = DM; } else { g.A = (const bf16_t*)(c.ws + WS_ZODD) + 134217728u; g.K = 2048; g.lda = 2048; g.ldb = 2048; }
        g.Bt = (const bf16_t*)(c.ws + WS_WOUT); g.N = DM; E.mode = 0; E.O = F; E.ldc = DM; E.rs = RINV; }
      pg8::StaticOrder S; S.init(M_TOK, g.N, c.G, c.bid);
      pg8::gemm_phase(c.lds, g, S, E);
      if ((DUP_MASK >> type) & 1) pg8::gemm_phase(c.lds, g, S, E);
    } else if (type == T_CONV || type == T_ROW1 || type == T_ROW3 || type == T_FINAL) {
      const float* xin = nullptr; float* xout = nullptr; const bf16_t* F = (const bf16_t*)(c.ws + WS_F); const float* gain = nullptr; float coef = 0.5f;
      if (type == T_CONV) {
        convert_layer(c, args, L);
        if (L == 0) { xin = args.in[c.z + IN_X]; F = nullptr; } else gain = args.in[c.z + IN_NORMS] + (size_t)(L - 1) * 6 * DM + 5 * DM;
      } else if (type == T_ROW1) gain = args.in[c.z + IN_NORMS] + (size_t)L * 6 * DM + 1 * DM;
      else if (type == T_ROW3) { gain = args.in[c.z + IN_NORMS] + (size_t)L * 6 * DM + 3 * DM; coef = 1.0f; }
      else { gain = args.in[c.z + IN_NORMS] + (size_t)3 * 6 * DM + 5 * DM; xout = c.out; }
      rowpass(c, xin, xout, F, gain, coef);
    } else if (type == T_PREP) {
      rwkv_prep(c, args, j);
      if ((DUP_MASK >> T_PREP) & 1) rwkv_prep(c, args, j);
    } else if (type == T_SCAN) {
      for (int u = c.bid; u < 256; u += c.G) { const int x = u & 7, slot = u >> 3; rwkv_scan_item(c, (x * 8 + (slot >> 2)) * 4 + (slot & 3)); }
    } else if (type == T_MIX) {
      attn_phase(c, args, j, L, (unsigned*)(c.ws + WS_CTL) + 64 * j);
      rwkv_post(c, args, j);
    } else if (type == T_POST) {
    } else if (type == T_RET) {
      { unsigned* cnt0 = (unsigned*)(c.ws + WS_CTL) + 128 + 64 * j; const int x = (int)(xb_xcc_id() & 7u);
        LAS int* qw = (LAS int*)(c.lds + LDS_MAIN + 64);
        for (int qi = 0; qi < 8; ++qi) { const int q = (x + qi) & 7;
          for (;;) { __syncthreads(); if (c.tid == 0) *qw = (int)atomicAdd(cnt0 + q, 1u); __syncthreads();
            const int slot = *qw; if (slot >= 32) break; retention_unit(c, q * 4 + (slot >> 3), slot & 7); } } }
    } else if (type == T_RETPOST) {
      retention_post(c);
    }
    if (ph + 1 < hi) { if (ph == lo) grid.sync(); else xcd_barrier(xbar); }
  }
}
constexpr int N_PHASES = 12 + 11 + 12 + 11 + 1;

extern "C" void kernel_launch(void* const* d_in, const int* in_sizes, int n_in, void* d_out, int out_size, void* d_ws, size_t ws_size, hipStream_t stream) {
  static int grid = 0;
  if (grid == 0) {
    if (n_in != 18 || out_size != M_TOK * DM || ws_size < WS_END) { fprintf(stderr, "kernel_launch: unexpected shapes (n_in %d, out %d, ws %zu, need %zu)\n", n_in, out_size, ws_size, (size_t)WS_END); grid = -1; return; }
    int dev = 0, cus = 0, per_cu = 0;
    hipGetDevice(&dev); hipDeviceGetAttribute(&cus, hipDeviceAttributeMultiprocessorCount, dev);
    if (hipFuncSetAttribute((const void*)fwd_megakernel, hipFuncAttributeMaxDynamicSharedMemorySize, LDS_BYTES) != hipSuccess) { fprintf(stderr, "kernel_launch: hipFuncSetAttribute failed\n"); grid = -1; return; }
    if (hipOccupancyMaxActiveBlocksPerMultiprocessor(&per_cu, (const void*)fwd_megakernel, NTHR, LDS_BYTES) != hipSuccess || per_cu < 1) { fprintf(stderr, "kernel_launch: occupancy query gives %d\n", per_cu); per_cu = 1; }
    (void)hipGetLastError();
    grid = cus * per_cu;
    if (grid > 256) grid = 256;
  }
  if (grid < 0) return;
  hipMemsetAsync((char*)d_ws + WS_CTL, 0, CTL_BYTES, stream);
  Args a{};
  for (int i = 0; i < 18; ++i) a.in[i] = (const float*)d_in[i];
  a.out = (float*)d_out; a.ws = (unsigned char*)d_ws;
#if MK_PER_PHASE
  for (int p = 0; p < N_PHASES; ++p) { a.ph_lo = p; a.ph_hi = p + 1; hipLaunchKernelGGL(fwd_megakernel, dim3(grid), dim3(NTHR), LDS_BYTES, stream, a); }
#else
  a.ph_lo = 0; a.ph_hi = N_PHASES;
  void* kargs[] = {&a};
  hipError_t e = hipLaunchCooperativeKernel((const void*)fwd_megakernel, dim3(grid), dim3(NTHR), kargs, LDS_BYTES, stream);
  if (e != hipSuccess) fprintf(stderr, "cooperative launch failed: %s (grid %d)\n", hipGetErrorString(e), grid);
#endif
}
```

```cpp
#include <hip/hip_runtime.h>
#include <hip/hip_cooperative_groups.h>
#include <cstdio>
#include <cstdint>
namespace cg = cooperative_groups;

#define LAS __attribute__((address_space(3)))
#define DI __device__ __forceinline__
typedef unsigned short bf16_t;
typedef short bf16x8 __attribute__((ext_vector_type(8)));
typedef short s16x4 __attribute__((ext_vector_type(4)));
typedef float f32x4 __attribute__((ext_vector_type(4)));
typedef float f32x2 __attribute__((ext_vector_type(2)));
typedef unsigned u32x4 __attribute__((ext_vector_type(4)));
typedef unsigned u32x2 __attribute__((ext_vector_type(2)));
typedef __bf16 bf16x2_t __attribute__((ext_vector_type(2)));

#ifndef DUP_MASK
#define DUP_MASK 0
#endif
#ifndef PROBE_MASK
#define PROBE_MASK 0
#endif
#ifndef MK_PER_PHASE
#define MK_PER_PHASE 0
#endif

constexpr int M_TOK = 32768, SEQ = 4096, DM = 1024, DFF = 2816, NWAVES = 8, NTHR = 512;
constexpr int EVEN_IN = 3328, ODD_IN = 6144;
constexpr float NORM_EPS = 1e-6f;
constexpr float LOG2E = 1.4426950408889634f;

constexpr size_t MiB = 1u << 20;
constexpr size_t WS_CTL = 0, CTL_BYTES = 65536;
constexpr size_t WS_RINV = 1 * MiB;
constexpr size_t WS_KN = 1 * MiB + 512 * 1024;
constexpr size_t WS_WGU0 = 2 * MiB, WS_WD0 = 13 * MiB, WS_WIN = 19 * MiB, WS_WOUT = 31 * MiB, WS_WGU1 = 35 * MiB, WS_WD1 = 46 * MiB;
constexpr size_t WS_LORA = 51 * MiB + 512 * 1024;
constexpr size_t WS_VFIRST = 52 * MiB;
constexpr size_t WS_TMP = 84 * MiB;
constexpr size_t WS_XB = 596 * MiB, WS_F = WS_TMP + 64 * MiB;
constexpr size_t WS_BIG = 212 * MiB;
constexpr size_t WS_H = WS_BIG, WS_ZODD = WS_BIG, WS_MIXE = WS_BIG + 112 * MiB, WS_ZEVEN = WS_BIG + 176 * MiB;
constexpr size_t WS_RW = WS_TMP;
constexpr size_t RW_STRIDE = (size_t)M_TOK * 512;
constexpr size_t WS_YB = WS_TMP;
constexpr size_t WS_END = 660 * MiB;

constexpr int LDS_MAIN = 131072, LDS_CTLO = 159744, LDS_BYTES = 160 * 1024;

DI float bf2f(unsigned short b) { return __uint_as_float((unsigned)b << 16); }
DI unsigned cvtpk(float lo, float hi) { f32x2 v = {lo, hi}; bf16x2_t b = __builtin_convertvector(v, bf16x2_t); return __builtin_bit_cast(unsigned, b); }
DI bf16_t f2bf(float f) { return (bf16_t)(cvtpk(f, 0.f) & 0xffffu); }
DI float wave_sum(float v) {
#pragma unroll
  for (int o = 1; o < 64; o <<= 1) v += __shfl_xor(v, o);
  return v;
}
DI float sigmoidf_(float x) { return __builtin_amdgcn_rcpf(1.f + __builtin_amdgcn_exp2f(-x * LOG2E)); }
DI float siluf_(float x) { return x * sigmoidf_(x); }
DI float tanhf_(float x) { return 2.f * sigmoidf_(2.f * x) - 1.f; }
DI void unpack8(const bf16x8 v, float (&f)[8]) {
#pragma unroll
  for (int e = 0; e < 8; ++e) f[e] = bf2f((unsigned short)v[e]);
}
#define MFMA16(a, b, c) __builtin_amdgcn_mfma_f32_16x16x32_bf16((a), (b), (c), 0, 0, 0)
typedef short v4i16_t __attribute__((ext_vector_type(4)));
DI s16x4 tr_read(const LAS unsigned char* p) { return __builtin_bit_cast(s16x4, __builtin_amdgcn_ds_read_tr16_b64_v4i16((LAS v4i16_t*)p)); }
DI bf16x8 comb8(s16x4 lo, s16x4 hi) { return __builtin_shufflevector(lo, hi, 0, 1, 2, 3, 4, 5, 6, 7); }
template <int CTRL> DI float dppf(float v) { return __builtin_bit_cast(float, __builtin_amdgcn_update_dpp(0, __builtin_bit_cast(int, v), CTRL, 0xF, 0xF, true)); }
DI void lds_barrier() { asm volatile("s_waitcnt lgkmcnt(0)" ::: "memory"); __builtin_amdgcn_s_barrier(); asm volatile("" ::: "memory"); }
DI float row16_sum(float v) {
  v += dppf<0xB1>(v); v += dppf<0x4E>(v); v += dppf<0x141>(v); v += dppf<0x140>(v); return v;
}

__device__ __forceinline__ unsigned xb_xcc_id() { return (unsigned)__builtin_amdgcn_s_getreg((3 << 11) | 20) & 0xFu; }

namespace pg8 {
constexpr int BM = 256, BK = 64, HALF = 128, HTB = HALF * BK * 2, STAGE_BYTES = 8 * HTB, NXCD = 8, WGM = 4;
__host__ __device__ __forceinline__ int lds_byte(int r, int c) { const int st = (r >> 4) * 2 + (c >> 5), rr = r & 15, cc = c & 31, ob = rr * 64 + cc * 2; return st * 1024 + (ob ^ (((ob >> 9) & 1) << 5)); }
__host__ __device__ __forceinline__ void stage_rc(int b, int& R, int& C) { const int st = b / 1024, sb = b % 1024, swz = sb ^ (((sb >> 9) & 1) << 5); R = (st >> 1) * 16 + swz / 64; C = (st & 1) * 32 + (swz % 64) / 2; }
__host__ __device__ __forceinline__ int perm32(int rho) { const int n = rho >> 4, i = rho & 15; return 8 * (i >> 2) + 4 * n + (i & 3); }
struct Unit { int pm, pn; };
struct Gemm { const bf16_t* A; const bf16_t* Bt; int M, N, K, lda, ldb; };
struct StaticOrder {
  int nM, nN, nwg, G, c;
  __device__ void init(int M, int N, int G_, int c_) { nM = M / BM; nN = N / BM; nwg = nM * nN; G = G_; c = c_; }
  __device__ bool next(int i, Unit& u) const {
    const long L = (long)i * G + c; if (L >= nwg) return false;
    int wgid = (int)L; { const int q = nwg / NXCD, r = nwg % NXCD, xcd = wgid % NXCD, off = wgid / NXCD; wgid = (xcd < r ? xcd * (q + 1) : r * (q + 1) + (xcd - r) * q) + off; }
    const int nig = WGM * nN, gid = wgid / nig, fm = gid * WGM, gsz = (nM - fm) < WGM ? (nM - fm) : WGM;
    u.pm = fm + ((wgid % nig) % gsz); u.pn = (wgid % nig) / gsz; return true;
  }
};
template <int MODE> struct Epi {
  static constexpr bool PERM = true;
  bf16_t* O; int ldc; const float* rs;
  DI void operator()(const f32x4 (&acc)[2][2][4][2], const Unit& u, int wr, int wc, int fr, int fq) const {
    const int row0 = u.pm * BM + wr * 64 + fr;
    if constexpr (MODE == 2) {
      const int col0 = u.pn * HALF + wc * 32 + 8 * fq;
#pragma unroll
      for (int ai = 0; ai < 2; ++ai)
#pragma unroll
        for (int m = 0; m < 4; ++m) {
          const int row = row0 + ai * HALF + m * 16; const float r = rs[row];
          f32x4 g0 = acc[ai][0][m][0] * r, g1 = acc[ai][0][m][1] * r, u0 = acc[ai][1][m][0] * r, u1 = acc[ai][1][m][1] * r;
          float h[8];
#pragma unroll
          for (int e = 0; e < 4; ++e) { h[e] = siluf_(g0[e]) * u0[e]; h[4 + e] = siluf_(g1[e]) * u1[e]; }
          u32x4 w; w.x = cvtpk(h[0], h[1]); w.y = cvtpk(h[2], h[3]); w.z = cvtpk(h[4], h[5]); w.w = cvtpk(h[6], h[7]);
          *(u32x4*)(O + (size_t)row * ldc + col0) = w;
        }
    } else {
      const int col0 = u.pn * BM + wc * 32 + 8 * fq;
#pragma unroll
      for (int ai = 0; ai < 2; ++ai)
#pragma unroll
        for (int m = 0; m < 4; ++m) {
          const int row = row0 + ai * HALF + m * 16; float r = 1.f; if constexpr (MODE == 1) r = rs[row];
          bf16_t* rowp = O + (size_t)row * ldc + col0;
#pragma unroll
          for (int bj = 0; bj < 2; ++bj) { f32x4 v0 = acc[ai][bj][m][0] * r, v1 = acc[ai][bj][m][1] * r;
            u32x4 w; w.x = cvtpk(v0[0], v0[1]); w.y = cvtpk(v0[2], v0[3]); w.z = cvtpk(v1[0], v1[1]); w.w = cvtpk(v1[2], v1[3]);
            *(u32x4*)(rowp + bj * HALF) = w; }
        }
    }
  }
};

struct EpiRT {
  static constexpr bool PERM = true;
  int mode; bf16_t* O; int ldc; const float* rs;
  DI void operator()(const f32x4 (&acc)[2][2][4][2], const Unit& u, int wr, int wc, int fr, int fq) const {
    if (mode == 3) {
      const int row0 = u.pm * BM + wr * 64 + fr;
#pragma unroll
      for (int ai = 0; ai < 2; ++ai)
#pragma unroll
        for (int m = 0; m < 4; ++m) {
          const int row = row0 + ai * HALF + m * 16; const float r = rs[row]; const int b = row >> 12, t = row & 4095;
#pragma unroll
          for (int bj = 0; bj < 2; ++bj) { const int cw = wc * 32 + 8 * fq + bj * HALF; size_t off;
            if (u.pn < 8) off = (size_t)(u.pn >> 2) * 33554432u + ((size_t)((b * 4 + (u.pn & 3)) * 4096 + t)) * 256 + cw;
            else if (u.pn < 16) { const int e = ((u.pn - 8) & 1) * 256 + cw; off = (size_t)67108864u + ((size_t)(((b * 4 + ((u.pn - 8) >> 1)) * 8 + (e >> 6)) * 4096 + t)) * 64 + (e & 63); }
            else off = (size_t)134217728u + (size_t)row * 2048 + (u.pn - 16) * 256 + cw;
            f32x4 v0 = acc[ai][bj][m][0] * r, v1 = acc[ai][bj][m][1] * r;
            u32x4 w; w.x = cvtpk(v0[0], v0[1]); w.y = cvtpk(v0[2], v0[3]); w.z = cvtpk(v1[0], v1[1]); w.w = cvtpk(v1[2], v1[3]);
            *(u32x4*)(O + off) = w; }
        }
    }
    else if (mode == 2) { Epi<2> e{O, ldc, rs}; e(acc, u, wr, wc, fr, fq); }
    else if (mode == 1) { Epi<1> e{O, ldc, rs}; e(acc, u, wr, wc, fr, fq); }
    else { Epi<0> e{O, ldc, rs}; e(acc, u, wr, wc, fr, fq); }
  }
};

template <class EpiT>
DI void gemm_phase(LAS unsigned char* lds, const Gemm g, const StaticOrder& S, const EpiT& E) {
  const int tid = threadIdx.x, wid = __builtin_amdgcn_readfirstlane(tid >> 6), lane = tid & 63, wr = wid >> 2, wc = wid & 3, fr = lane & 15, fq = lane >> 4;
  const int K = g.K, nt = K / BK;
  unsigned voffA[2], voffB[2];
#pragma unroll
  for (int i = 0; i < 2; ++i) { int R, C; stage_rc(tid * 16 + i * 8192, R, C); const int Rb = EpiT::PERM ? ((R & ~31) + perm32(R & 31)) : R;
    voffA[i] = (unsigned)(R * g.lda + C) * 2u; voffB[i] = (unsigned)(Rb * g.ldb + C) * 2u; }
  const size_t kstep = (size_t)(BK * 2);
  const size_t hstepA = (size_t)HALF * g.lda * 2, hstepB = (size_t)HALF * g.ldb * 2;
  const size_t tstepA = 2 * hstepA, tstepB = 2 * hstepB;
  const unsigned ldsw = (unsigned)wid * 1024u;
  const int aoff = lds_byte(wr * 64 + fr, fq * 8), boff = lds_byte(wc * 32 + fr, fq * 8);
#define PG8_SA(b, h) (((b) * 2 + (h)) * HTB)
#define PG8_SB(b, h) ((4 + (b) * 2 + (h)) * HTB)
#define PG8_STAGE(bufoff, gbase, voff) do { _Pragma("unroll") for (int _i = 0; _i < 2; ++_i) \
    __builtin_amdgcn_global_load_lds((const unsigned*)((const char*)(gbase) + (voff)[_i]), (LAS unsigned*)(lds + (bufoff) + ldsw + _i * 8192), 16, 0, 0); } while (0)
#define PG8_LDA(dst, b, h) do { _Pragma("unroll") for (int m = 0; m < 4; ++m) _Pragma("unroll") for (int k = 0; k < 2; ++k) dst[m][k] = *(const LAS bf16x8*)(lds + PG8_SA(b, h) + aoff + m * 2048 + k * 1024); } while (0)
#define PG8_LDB(dst, b, h) do { _Pragma("unroll") for (int n = 0; n < 2; ++n) _Pragma("unroll") for (int k = 0; k < 2; ++k) dst[n][k] = *(const LAS bf16x8*)(lds + PG8_SB(b, h) + boff + n * 2048 + k * 1024); } while (0)
#define PG8_MMA(ai, bj, At, Bt) do { __builtin_amdgcn_s_setprio(1); _Pragma("unroll") for (int m = 0; m < 4; ++m) _Pragma("unroll") for (int n = 0; n < 2; ++n) _Pragma("unroll") for (int k = 0; k < 2; ++k) \
    acc[ai][bj][m][n] = __builtin_amdgcn_mfma_f32_16x16x32_bf16(Bt[n][k], At[m][k], acc[ai][bj][m][n], 0, 0, 0); __builtin_amdgcn_s_setprio(0); } while (0)
#define PG8_WAIT_V(n) asm volatile("s_waitcnt vmcnt(" #n ")" ::: "memory")
#define PG8_WAIT_L(n) asm volatile("s_waitcnt lgkmcnt(" #n ")" ::: "memory")
#define PG8_BAR __builtin_amdgcn_s_barrier()
#define PG8_SCHED __builtin_amdgcn_sched_barrier(0)
  Unit cur, nxt; int ui = 0;
  if (!S.next(0, cur)) return;
  f32x4 acc[2][2][4][2];
#pragma unroll
  for (int a = 0; a < 2; ++a)
#pragma unroll
    for (int b = 0; b < 2; ++b)
#pragma unroll
      for (int m = 0; m < 4; ++m)
#pragma unroll
        for (int n = 0; n < 2; ++n) acc[a][b][m][n] = (f32x4){0.f, 0.f, 0.f, 0.f};
  bf16x8 At[4][2], B0[2][2], B1[2][2];
  const char* cA = (const char*)g.A + (size_t)cur.pm * tstepA; const char* cB = (const char*)g.Bt + (size_t)cur.pn * tstepB;
  PG8_STAGE(PG8_SB(0, 0), cB, voffB); PG8_STAGE(PG8_SB(0, 1), cB + hstepB, voffB); PG8_STAGE(PG8_SA(0, 0), cA, voffA); PG8_STAGE(PG8_SA(0, 1), cA + hstepA, voffA);
  if (wr == 1) PG8_BAR;
  PG8_WAIT_V(2); PG8_BAR;
  PG8_STAGE(PG8_SB(1, 0), cB + kstep, voffB); PG8_STAGE(PG8_SA(1, 0), cA + kstep, voffA); PG8_STAGE(PG8_SB(1, 1), cB + hstepB + kstep, voffB);
  PG8_WAIT_V(6); PG8_BAR;
  for (;;) {
    const bool has_next = S.next(ui + 1, nxt);
    const char* nA = has_next ? (const char*)g.A + (size_t)nxt.pm * tstepA : cA; const char* nB = has_next ? (const char*)g.Bt + (size_t)nxt.pn * tstepB : cB;
    for (int t = 0; t < nt; t += 2) {
      const bool last = (t == nt - 2);
      const char* a1 = cA + (size_t)(t + 1) * kstep;
      const char* a2 = last ? nA : cA + (size_t)(t + 2) * kstep; const char* b2 = last ? nB : cB + (size_t)(t + 2) * kstep;
      const char* a3 = a2 + kstep; const char* b3 = b2 + kstep;
      PG8_LDB(B0, 0, 0); PG8_LDB(B1, 0, 1); PG8_SCHED; PG8_LDA(At, 0, 0); PG8_STAGE(PG8_SA(1, 1), a1 + hstepA, voffA);
      PG8_WAIT_V(8); PG8_WAIT_L(0); PG8_BAR; PG8_MMA(0, 0, At, B0); PG8_MMA(0, 1, At, B1); PG8_BAR; PG8_SCHED;
      PG8_LDA(At, 0, 1); PG8_STAGE(PG8_SB(0, 0), b2, voffB); PG8_STAGE(PG8_SB(0, 1), b2 + hstepB, voffB); PG8_STAGE(PG8_SA(0, 0), a2, voffA);
      PG8_WAIT_V(8); PG8_WAIT_L(0); PG8_BAR; PG8_MMA(1, 0, At, B0); PG8_MMA(1, 1, At, B1); PG8_BAR; PG8_SCHED;
      PG8_LDB(B0, 1, 0); PG8_LDB(B1, 1, 1); PG8_SCHED; PG8_LDA(At, 1, 0); PG8_STAGE(PG8_SA(0, 1), a2 + hstepA, voffA);
      PG8_WAIT_V(8); PG8_WAIT_L(0); PG8_BAR; PG8_MMA(0, 0, At, B0); PG8_MMA(0, 1, At, B1); PG8_BAR; PG8_SCHED;
      PG8_LDA(At, 1, 1); PG8_STAGE(PG8_SB(1, 0), b3, voffB); PG8_STAGE(PG8_SB(1, 1), b3 + hstepB, voffB); PG8_STAGE(PG8_SA(1, 0), a3, voffA);
      PG8_WAIT_V(8); PG8_WAIT_L(0); PG8_BAR; PG8_MMA(1, 0, At, B0); PG8_MMA(1, 1, At, B1); PG8_BAR; PG8_SCHED;
    }
    if (wr == 0) PG8_BAR;
    E(acc, cur, wr, wc, fr, fq);
    if (!has_next) break;
#pragma unroll
    for (int a = 0; a < 2; ++a)
#pragma unroll
      for (int b = 0; b < 2; ++b)
#pragma unroll
        for (int m = 0; m < 4; ++m)
#pragma unroll
          for (int n = 0; n < 2; ++n) acc[a][b][m][n] = (f32x4){0.f, 0.f, 0.f, 0.f};
    cur = nxt; cA = nA; cB = nB; ++ui;
    if (wr == 1) PG8_BAR;
  }
  PG8_WAIT_V(0);
  PG8_BAR;
#undef PG8_SA
#undef PG8_SB
#undef PG8_STAGE
#undef PG8_LDA
#undef PG8_LDB
#undef PG8_MMA
#undef PG8_WAIT_V
#undef PG8_WAIT_L
#undef PG8_BAR
#undef PG8_SCHED
}
}

struct Args { const float* in[18]; float* out; unsigned char* ws; int ph_lo, ph_hi; };
struct Ctx {
  LAS unsigned char* lds;
  int tid, lane, wave, G, bid, z;
  unsigned char* ws; float* out;
};
enum { IN_X = 0, IN_NORMS, IN_WGU, IN_WD, IN_EWIN, IN_EWOUT, IN_LAM, IN_SUBLN, IN_MU, IN_VEC, IN_WUP, IN_AUP, IN_GUP, IN_V0, IN_VDOWN, IN_VUP, IN_OWIN, IN_OWOUT };

DI void transpose_item(const float* W, int K, int N, bf16_t* WT, int mode, const float* gain, int sc_lo, int sc_hi, float sc, LAS float* scr, int item, int lane) {
  const int nblk = N / 32, kb = item / nblk, nb = item % nblk, k0 = 64 * kb, n0 = 32 * nb;
  const float cs = (n0 >= sc_lo && n0 < sc_hi) ? sc : 1.f;
#pragma unroll
  for (int i = 0; i < 8; ++i) { const int kk = 8 * i + (lane >> 3), n4 = (lane & 7) * 4; const float gk = gain ? gain[k0 + kk] * cs : cs;
    const f32x4 v = __builtin_nontemporal_load((const f32x4*)(W + (size_t)(k0 + kk) * N + n0 + n4)) * gk;
    LAS float* d = scr + kk * 33 + n4; d[0] = v.x; d[1] = v.y; d[2] = v.z; d[3] = v.w; }
  asm volatile("s_waitcnt lgkmcnt(0)" ::: "memory");
  int d0 = n0;
  if (mode & 1) d0 = (n0 < DFF) ? 256 * (n0 / 128) + (n0 % 128) : 256 * ((n0 - DFF) / 128) + 128 + ((n0 - DFF) % 128);
  const int c = lane & 7;
#pragma unroll
  for (int j = 0; j < 4; ++j) { const int n = (lane >> 3) + 8 * j; const LAS float* s = scr + (8 * c) * 33 + n;
    u32x4 o; o.x = cvtpk(s[0 * 33], s[1 * 33]); o.y = cvtpk(s[2 * 33], s[3 * 33]); o.z = cvtpk(s[4 * 33], s[5 * 33]); o.w = cvtpk(s[6 * 33], s[7 * 33]);
    if (mode & 2) __builtin_nontemporal_store(o, (u32x4*)(WT + (size_t)(d0 + n) * K + k0 + 8 * c));
    else *(u32x4*)(WT + (size_t)(d0 + n) * K + k0 + 8 * c) = o; }
  asm volatile("s_waitcnt lgkmcnt(0)" ::: "memory");
}

DI void convert_layer(const Ctx& c, const Args& a, int L) {
  LAS float* scr = (LAS float*)(c.lds + c.wave * 16384);
  const int gw = c.bid * NWAVES + c.wave, NGW = c.G * NWAVES;
  const bool even = (L & 1) == 0; const int j = L >> 1;
  const float* norms = a.in[c.z + IN_NORMS] + (size_t)L * 6 * DM;
  const float* wgu0 = a.in[c.z + IN_WGU] + (size_t)(L * 2 + 0) * DM * 2 * DFF; const float* wgu1 = a.in[c.z + IN_WGU] + (size_t)(L * 2 + 1) * DM * 2 * DFF;
  const float* wd0 = a.in[c.z + IN_WD] + (size_t)(L * 2 + 0) * DFF * DM; const float* wd1 = a.in[c.z + IN_WD] + (size_t)(L * 2 + 1) * DFF * DM;
  const float* win = even ? a.in[c.z + IN_EWIN] + (size_t)j * DM * EVEN_IN : a.in[c.z + IN_OWIN] + (size_t)j * DM * ODD_IN;
  const float* wout = even ? a.in[c.z + IN_EWOUT] + (size_t)j * DM * DM : a.in[c.z + IN_OWOUT] + (size_t)j * 2048 * DM;
  const int NIN = even ? EVEN_IN : ODD_IN, KOUT = even ? DM : 2048;
  const int I_GU = (DM / 64) * (2 * DFF / 32), I_D = (DFF / 64) * (DM / 32), I_IN = (DM / 64) * (NIN / 32), I_OUT = (KOUT / 64) * (DM / 32);
  const int NIT = 2 * I_GU + 2 * I_D + I_IN + I_OUT;
  bf16_t* WGU0 = (bf16_t*)(c.ws + WS_WGU0); bf16_t* WGU1 = (bf16_t*)(c.ws + WS_WGU1); bf16_t* WD0 = (bf16_t*)(c.ws + WS_WD0); bf16_t* WD1 = (bf16_t*)(c.ws + WS_WD1);
  bf16_t* WIN = (bf16_t*)(c.ws + WS_WIN); bf16_t* WOUT = (bf16_t*)(c.ws + WS_WOUT);
  if (even) {
    bf16_t* WUPT = (bf16_t*)(c.ws + WS_LORA); bf16_t* AUPT = WUPT + 512 * 64; bf16_t* GUPT = AUPT + 512 * 64; bf16_t* VDT = GUPT + 512 * 128; bf16_t* VUPT = VDT + 32 * 512;
    const float* w_up = a.in[c.z + IN_WUP] + (size_t)j * 64 * 512; const float* a_up = a.in[c.z + IN_AUP] + (size_t)j * 64 * 512; const float* g_up = a.in[c.z + IN_GUP] + (size_t)j * 128 * 512;
    const int NS = 16 + 16 + 32 + (j > 0 ? 8 : 0);
    for (int it = gw; it < NS; it += NGW) {
      int r = it;
      if (r < 16) { transpose_item(w_up, 64, 512, WUPT, 0, nullptr, 0, 0, 1.f, scr, r, c.lane); continue; } r -= 16;
      if (r < 16) { transpose_item(a_up, 64, 512, AUPT, 0, nullptr, 0, 0, 1.f, scr, r, c.lane); continue; } r -= 16;
      if (r < 32) { transpose_item(g_up, 128, 512, GUPT, 0, nullptr, 0, 0, 1.f, scr, r, c.lane); continue; } r -= 32;
      transpose_item(a.in[c.z + IN_VDOWN] + (size_t)(j - 1) * 512 * 32, 512, 32, VDT, 0, nullptr, 0, 0, 1.f, scr, r, c.lane);
    }
    if (j > 0) { const float* v_up = a.in[c.z + IN_VUP] + (size_t)(j - 1) * 32 * 512;
      for (int e = c.bid * NTHR + c.tid; e < 32 * 512; e += c.G * NTHR) { const int n = e >> 5, k = e & 31; VUPT[e] = f2bf(v_up[(size_t)k * 512 + n]); } }
  }
  for (int it = gw; it < NIT; it += NGW) {
    int r = it;
    if (r < I_GU) { transpose_item(wgu0, DM, 2 * DFF, WGU0, 1, norms + 0 * DM, 0, 0, 1.f, scr, r, c.lane); continue; } r -= I_GU;
    if (r < I_GU) { transpose_item(wgu1, DM, 2 * DFF, WGU1, 3, norms + 4 * DM, 0, 0, 1.f, scr, r, c.lane); continue; } r -= I_GU;
    if (r < I_D) { transpose_item(wd0, DFF, DM, WD0, 0, nullptr, 0, 0, 1.f, scr, r, c.lane); continue; } r -= I_D;
    if (r < I_D) { transpose_item(wd1, DFF, DM, WD1, 2, nullptr, 0, 0, 1.f, scr, r, c.lane); continue; } r -= I_D;
    if (r < I_IN) { transpose_item(win, DM, NIN, WIN, 0, norms + 2 * DM, even ? 0 : 1024, even ? 0 : 2048, 0.0625f, scr, r, c.lane); continue; } r -= I_IN;
    transpose_item(wout, KOUT, DM, WOUT, 2, nullptr, 0, 0, 1.f, scr, r, c.lane);
  }
}

DI f32x4 bf4_to_f(const u32x2 w) { return (f32x4){__uint_as_float(w.x << 16), __uint_as_float(w.x & 0xffff0000u), __uint_as_float(w.y << 16), __uint_as_float(w.y & 0xffff0000u)}; }
DI void rowpass(const Ctx& c, const float* xin, float* xout, const bf16_t* F, const float* gain, float coef) {
  const int gw = c.bid * NWAVES + c.wave, NGW = c.G * NWAVES;
  bf16_t* XB = (bf16_t*)(c.ws + WS_XB); float* RINV = (float*)(c.ws + WS_RINV);
  f32x4 gv[4];
  if (F) {
#pragma unroll
    for (int j = 0; j < 4; ++j) gv[j] = *(const f32x4*)(gain + 512 * (j >> 1) + 8 * c.lane + 4 * (j & 1)) * coef;
  }
  if (xin) {
    for (int row = gw; row < M_TOK; row += NGW) {
      const f32x4* xr = (const f32x4*)(xin + (size_t)row * DM) + c.lane; u32x2* xb = (u32x2*)(XB + (size_t)row * DM) + c.lane;
      float s2 = 0.f;
#pragma unroll
      for (int j = 0; j < 4; ++j) { const f32x4 v = xr[64 * j]; u32x2 w; w.x = cvtpk(v.x, v.y); w.y = cvtpk(v.z, v.w); xb[64 * j] = w;
        const f32x4 q = bf4_to_f(w); s2 += (q.x * q.x + q.y * q.y) + (q.z * q.z + q.w * q.w); }
      s2 = wave_sum(s2);
      if (c.lane == 0) RINV[row] = __builtin_amdgcn_rsqf(s2 * (1.f / DM) + NORM_EPS);
    }
    return;
  }
  u32x4 xc[2], fc[2];
  { const u32x4* xb = (const u32x4*)(XB + (size_t)gw * DM) + c.lane; const u32x4* fr = (const u32x4*)(F + (size_t)gw * DM) + c.lane;
#pragma unroll
    for (int p = 0; p < 2; ++p) { xc[p] = xb[64 * p]; fc[p] = __builtin_nontemporal_load(fr + 64 * p); } }
#pragma unroll 1
  for (int row = gw; row < M_TOK; row += NGW) {
    const int nrow = row + NGW; u32x4 xn[2], fn[2];
    if (nrow < M_TOK) { const u32x4* xb = (const u32x4*)(XB + (size_t)nrow * DM) + c.lane; const u32x4* fr = (const u32x4*)(F + (size_t)nrow * DM) + c.lane;
#pragma unroll
      for (int p = 0; p < 2; ++p) { xn[p] = xb[64 * p]; fn[p] = __builtin_nontemporal_load(fr + 64 * p); } }
    else {
#pragma unroll
      for (int p = 0; p < 2; ++p) { xn[p] = xc[p]; fn[p] = fc[p]; } }
    f32x4 v[4], f[4]; float ss = 0.f;
#pragma unroll
    for (int p = 0; p < 2; ++p) { v[2 * p] = bf4_to_f((u32x2){xc[p].x, xc[p].y}); v[2 * p + 1] = bf4_to_f((u32x2){xc[p].z, xc[p].w});
      f[2 * p] = bf4_to_f((u32x2){fc[p].x, fc[p].y}); f[2 * p + 1] = bf4_to_f((u32x2){fc[p].z, fc[p].w}); }
#pragma unroll
    for (int j = 0; j < 4; ++j) ss += (f[j].x * f[j].x + f[j].y * f[j].y) + (f[j].z * f[j].z + f[j].w * f[j].w);
    const float r = __builtin_amdgcn_rsqf(wave_sum(ss) * (1.f / DM) + NORM_EPS);
#pragma unroll
    for (int j = 0; j < 4; ++j) v[j] = v[j] + f[j] * gv[j] * r;
    if (xout) { f32x4* xo = (f32x4*)(xout + (size_t)row * DM) + 2 * c.lane;
#pragma unroll
      for (int j = 0; j < 4; ++j) __builtin_nontemporal_store(v[j], xo + 128 * (j >> 1) + (j & 1)); }
    else {
      u32x4* xb = (u32x4*)(XB + (size_t)row * DM) + c.lane;
      float s2 = 0.f;
#pragma unroll
      for (int p = 0; p < 2; ++p) { u32x4 w; w.x = cvtpk(v[2 * p].x, v[2 * p].y); w.y = cvtpk(v[2 * p].z, v[2 * p].w); w.z = cvtpk(v[2 * p + 1].x, v[2 * p + 1].y); w.w = cvtpk(v[2 * p + 1].z, v[2 * p + 1].w); xb[64 * p] = w;
        const f32x4 q0 = bf4_to_f((u32x2){w.x, w.y}), q1 = bf4_to_f((u32x2){w.z, w.w});
        s2 += (q0.x * q0.x + q0.y * q0.y) + (q0.z * q0.z + q0.w * q0.w) + (q1.x * q1.x + q1.y * q1.y) + (q1.z * q1.z + q1.w * q1.w); }
      s2 = wave_sum(s2);
      if (c.lane == 0) RINV[row] = __builtin_amdgcn_rsqf(s2 * (1.f / DM) + NORM_EPS);
    }
#pragma unroll
    for (int p = 0; p < 2; ++p) { xc[p] = xn[p]; fc[p] = fn[p]; }
  }
}

DI f32x4 ld_bf4(const bf16_t* p) { const u32x2 w = *(const u32x2*)p; return (f32x4){__uint_as_float(w.x << 16), __uint_as_float(w.x & 0xffff0000u), __uint_as_float(w.y << 16), __uint_as_float(w.y & 0xffff0000u)}; }
DI void st_bf4(bf16_t* p, f32x4 v) { u32x2 w; w.x = cvtpk(v.x, v.y); w.y = cvtpk(v.z, v.w); *(u32x2*)p = w; }
DI f32x4 lds_bf4(const LAS unsigned char* p) { return bf4_to_f(*(const LAS u32x2*)p); }
DI void rwkv_prep(const Ctx& c, const Args& a, int j) {
  const bf16_t* Z = (const bf16_t*)(c.ws + WS_ZEVEN);
  bf16_t* RW = (bf16_t*)(c.ws + WS_RW);
  bf16_t* VF = (bf16_t*)(c.ws + WS_VFIRST);
  const bf16_t* WUPT = (const bf16_t*)(c.ws + WS_LORA); const bf16_t* AUPT = WUPT + 512 * 64; const bf16_t* GUPT = AUPT + 512 * 64;
  const bf16_t* VDT = GUPT + 512 * 128; const bf16_t* VUPT = VDT + 32 * 512;
  const float* mu = a.in[c.z + IN_MU] + (size_t)j * 1792;
  const float* vec = a.in[c.z + IN_VEC] + (size_t)j * 7 * 512;
  const bool vres = j > 0;
  const float* v0p = a.in[c.z + IN_V0] + (size_t)(j > 0 ? j - 1 : 0) * 512;
  constexpr int ZS = 3600, XS = 528, VS = 1040, US = 80;
  LAS unsigned char* zst0 = c.lds; LAS unsigned char* xsb = c.lds + 122880; LAS unsigned char* vsb = c.lds + 131328; LAS unsigned char* ub = c.lds + 147968;
  const int tid = c.tid, lane = c.lane, w = c.wave, l15 = lane & 15, quad = lane >> 4;
  u32x4 pz[8];
  auto zissue = [&](int u) { const int t0 = u * 16; const bool first = (t0 % SEQ) == 0;
#pragma unroll
    for (int i = 0; i < 8; ++i) { const int id = tid + 512 * i; pz[i] = (u32x4){0u, 0u, 0u, 0u};
      if (id < 17 * 224) { const int row = id / 224, ch = id - row * 224;
        if (!(first && row == 0)) pz[i] = *(const u32x4*)(Z + (size_t)(t0 - 1 + row) * EVEN_IN + 1536 + ch * 8); } } };
  auto zstash = [&](LAS unsigned char* zb) {
#pragma unroll
    for (int i = 0; i < 8; ++i) { const int id = tid + 512 * i;
      if (id < 17 * 224) { const int row = id / 224, ch = id - row * 224; *(LAS u32x4*)(zb + row * ZS + ch * 16) = pz[i]; } } };
  int ui = 0;
  if (c.bid < M_TOK / 16) { zissue(c.bid); __syncthreads(); zstash(zst0); }
  for (int u = c.bid; u < M_TOK / 16; u += c.G, ++ui) {
    const int t0 = u * 16;
    LAS unsigned char* zst = zst0 + (ui & 1) * 61440;
    __syncthreads();
    const bool has_next = u + c.G < M_TOK / 16;
    if (has_next) zissue(u + c.G);
    {
      const int cc = tid & 255, tg = tid >> 8; const float m = mu[1536 + cc];
#pragma unroll
      for (int i = 0; i < 8; ++i) { const int tok = tg * 8 + i;
        const float cur = bf2f(*(const LAS bf16_t*)(zst + (1 + tok) * ZS + (1536 + cc) * 2)), prev = bf2f(*(const LAS bf16_t*)(zst + tok * ZS + (1536 + cc) * 2));
        const float zs = cur + (prev - cur) * m;
        const float val = cc < 64 ? tanhf_(zs) : (cc < 128 ? zs : sigmoidf_(zs)); *(LAS bf16_t*)(xsb + tok * XS + cc * 2) = f2bf(val); }
    }
    __syncthreads();
    const int t = t0 + l15;
    const LAS unsigned char* xr = xsb + l15 * XS + quad * 16;
    const LAS unsigned char* zc = zst + (1 + l15) * ZS; const LAS unsigned char* zp = zst + l15 * ZS;
    float ss = 0.f;
#pragma unroll 2
    for (int ct = 0; ct < 4; ++ct) {
      const int col = 64 * w + 16 * ct + 4 * quad;
      const size_t wr = (size_t)(64 * w + 16 * ct + l15);
      f32x4 x = {0.f, 0.f, 0.f, 0.f}, z = x;
#pragma unroll
      for (int ks = 0; ks < 2; ++ks) x = MFMA16(*(const bf16x8*)(WUPT + wr * 64 + 32 * ks + 8 * quad), *(const LAS bf16x8*)(xr + ks * 64), x);
#pragma unroll
      for (int ks = 0; ks < 4; ++ks) z = MFMA16(*(const bf16x8*)(GUPT + wr * 128 + 32 * ks + 8 * quad), *(const LAS bf16x8*)(xr + 256 + ks * 64), z);
      const f32x4 cr = lds_bf4(zc + col * 2), ck = lds_bf4(zc + (512 + col) * 2), cv = lds_bf4(zc + (1024 + col) * 2);
      const f32x4 pr = lds_bf4(zp + col * 2), pk = lds_bf4(zp + (512 + col) * 2), pv = lds_bf4(zp + (1024 + col) * 2);
      const f32x4 mr = *(const f32x4*)(mu + col), mk = *(const f32x4*)(mu + 512 + col), mv = *(const f32x4*)(mu + 1024 + col);
      const f32x4 w0 = *(const f32x4*)(vec + col), k_k = *(const f32x4*)(vec + 1024 + col);
      const f32x4 rr = cr + (pr - cr) * mr, k1 = ck + (pk - ck) * mk, vv = cv + (pv - cv) * mv;
      f32x4 ew;
#pragma unroll
      for (int e = 0; e < 4; ++e) ew[e] = 0.60653065971f * sigmoidf_(w0[e] + x[e]);
      const f32x4 kkr = k1 * k_k; ss += (kkr.x * kkr.x + kkr.y * kkr.y) + (kkr.z * kkr.z + kkr.w * kkr.w);
      const size_t o = (size_t)t * 512 + col;
      st_bf4(RW + 0 * RW_STRIDE + o, ew); st_bf4(RW + 4 * RW_STRIDE + o, rr); st_bf4(RW + 6 * RW_STRIDE + o, z);
      if (!vres) { st_bf4(RW + 5 * RW_STRIDE + o, vv); st_bf4(VF + o, vv); }
      else { u32x2 wv; wv.x = cvtpk(vv.x, vv.y); wv.y = cvtpk(vv.z, vv.w); *(LAS u32x2*)(vsb + l15 * VS + col * 2) = wv; }
    }
    ss += __shfl_xor(ss, 16); ss += __shfl_xor(ss, 32);
    const float rinv = 1.f / fmaxf(sqrtf(ss), 1e-12f);
#pragma unroll 2
    for (int ct = 0; ct < 4; ++ct) {
      const int col = 64 * w + 16 * ct + 4 * quad;
      const size_t wr = (size_t)(64 * w + 16 * ct + l15);
      f32x4 y = {0.f, 0.f, 0.f, 0.f};
#pragma unroll
      for (int ks = 0; ks < 2; ++ks) y = MFMA16(*(const bf16x8*)(AUPT + wr * 64 + 32 * ks + 8 * quad), *(const LAS bf16x8*)(xr + 128 + ks * 64), y);
      const f32x4 ck = lds_bf4(zc + (512 + col) * 2), pk = lds_bf4(zp + (512 + col) * 2);
      const f32x4 mk = *(const f32x4*)(mu + 512 + col), a0 = *(const f32x4*)(vec + 512 + col);
      const f32x4 k_k = *(const f32x4*)(vec + 1024 + col), k_a = *(const f32x4*)(vec + 1536 + col);
      const f32x4 k1 = ck + (pk - ck) * mk;
      f32x4 a1;
#pragma unroll
      for (int e = 0; e < 4; ++e) a1[e] = sigmoidf_(a0[e] + y[e]);
      const f32x4 kk = k1 * k_k * rinv;
      const f32x4 kmod = k1 * (1.f + (a1 - 1.f) * k_a);
      const size_t o = (size_t)t * 512 + col;
      st_bf4(RW + 1 * RW_STRIDE + o, kk); st_bf4(RW + 2 * RW_STRIDE + o, kk * a1); st_bf4(RW + 3 * RW_STRIDE + o, kmod);
    }
    if (vres) {
      __syncthreads();
      if (w < 2) { const int mt = w; f32x4 acc = {0.f, 0.f, 0.f, 0.f};
#pragma unroll 4
        for (int ks = 0; ks < 16; ++ks) acc = MFMA16(*(const bf16x8*)(VDT + (size_t)(16 * mt + l15) * 512 + 32 * ks + 8 * quad), *(const LAS bf16x8*)(vsb + l15 * VS + (32 * ks + 8 * quad) * 2), acc);
        u32x2 wv; wv.x = cvtpk(acc.x, acc.y); wv.y = cvtpk(acc.z, acc.w); *(LAS u32x2*)(ub + l15 * US + (16 * mt + 4 * quad) * 2) = wv; }
      __syncthreads();
#pragma unroll 2
      for (int ct = 0; ct < 4; ++ct) {
        const int col = 64 * w + 16 * ct + 4 * quad;
        const bf16x8 fu = *(const bf16x8*)(VUPT + (size_t)(64 * w + 16 * ct + l15) * 32 + 8 * quad);
        const f32x4 v0 = *(const f32x4*)(v0p + col);
        f32x4 sacc = {0.f, 0.f, 0.f, 0.f};
        sacc = MFMA16(fu, *(const LAS bf16x8*)(ub + l15 * US + quad * 16), sacc);
        const size_t o = (size_t)t * 512 + col;
        const f32x4 vv = lds_bf4(vsb + l15 * VS + col * 2);
        const f32x4 vf = ld_bf4(VF + o); f32x4 r;
#pragma unroll
        for (int e = 0; e < 4; ++e) r[e] = vv[e] + (vf[e] - vv[e]) * sigmoidf_(v0[e] + sacc[e]);
        st_bf4(RW + 5 * RW_STRIDE + o, r);
      }
    }
    if (has_next) zstash(zst0 + ((ui + 1) & 1) * 61440);
  }
}

DI void rwkv_scan_item(const Ctx& c, int item) {
  const int bh = item >> 1, half = item & 1, b = bh >> 3, h = bh & 7;
  const bf16_t* RW = (const bf16_t*)(c.ws + WS_RW);
  bf16_t* MIX = (bf16_t*)(c.ws + WS_MIXE);
  const int tid = c.tid, lane = c.lane, rg8 = lane >> 3, c8 = lane & 7, row = (c.wave & 3) * 8 + rg8;
  constexpr int BUF_F = 32 * 320 + 32 * 32;
  LAS float* buf0 = (LAS float*)c.lds;
  LAS float* ybuf = (LAS float*)c.lds + 2 * BUF_F;
  const size_t tokbase = (size_t)b * SEQ;
  const int i2 = tid & 255;
  const int l_step = i2 >> 3, l_c8 = i2 & 7, l_arr = tid >> 8;
  const bf16_t* src01 = RW + (size_t)l_arr * RW_STRIDE + (tokbase + l_step) * 512 + h * 64 + l_c8 * 8;
  const int vid = tid - 256;
  const bf16_t* srcv = RW + 5 * RW_STRIDE + (tokbase + ((vid >> 2) & 31)) * 512 + h * 64 + half * 32 + (vid & 3) * 8;
  bf16x8 p0, p1, p2;
  auto issue = [&](int ch) {
    const size_t off = (size_t)ch * 32 * 512;
    p0 = *(const bf16x8*)(src01 + off); p1 = *(const bf16x8*)(src01 + 2 * RW_STRIDE + off);
    if (tid < 256) p2 = *(const bf16x8*)(src01 + 4 * RW_STRIDE + off);
    else if (tid < 384) p2 = *(const bf16x8*)(srcv + off);
  };
  auto stash = [&](int bsel) {
    LAS float* B = buf0 + bsel * BUF_F;
    float f[8];
    { unpack8(p0, f); LAS float* d = B + l_step * 320 + l_arr * 64 + l_c8 * 8;
      if (l_arr == 0) {
#pragma unroll
        for (int e = 0; e < 8; ++e) f[e] = __builtin_amdgcn_exp2f(-f[e] * LOG2E);
      } else {
#pragma unroll
        for (int e = 0; e < 8; ++e) f[e] = -f[e];
      }
      *(LAS f32x4*)d = (f32x4){f[0], f[1], f[2], f[3]}; *(LAS f32x4*)(d + 4) = (f32x4){f[4], f[5], f[6], f[7]}; }
    { unpack8(p1, f); LAS float* d = B + l_step * 320 + (l_arr + 2) * 64 + l_c8 * 8;
      *(LAS f32x4*)d = (f32x4){f[0], f[1], f[2], f[3]}; *(LAS f32x4*)(d + 4) = (f32x4){f[4], f[5], f[6], f[7]}; }
    if (tid < 256) { unpack8(p2, f); LAS float* d = B + l_step * 320 + 4 * 64 + l_c8 * 8;
      *(LAS f32x4*)d = (f32x4){f[0], f[1], f[2], f[3]}; *(LAS f32x4*)(d + 4) = (f32x4){f[4], f[5], f[6], f[7]}; }
    else if (tid < 384) { unpack8(p2, f); LAS float* d = B + 32 * 320 + (vid >> 2) * 32 + (vid & 3) * 8;
      *(LAS f32x4*)d = (f32x4){f[0], f[1], f[2], f[3]}; *(LAS f32x4*)(d + 4) = (f32x4){f[4], f[5], f[6], f[7]}; }
  };
  __syncthreads();
  issue(0); stash(0);
  if (1 < SEQ / 32) issue(1);
  __syncthreads();
  f32x2 S0 = {0.f, 0.f}, S1 = {0.f, 0.f}, S2 = {0.f, 0.f}, S3 = {0.f, 0.f};
  if (c.wave < 4) __builtin_amdgcn_s_setprio(2);
#pragma unroll 1
  for (int ch = 0; ch < SEQ / 32; ++ch) {
    if (ch + 1 < SEQ / 32) stash((ch + 1) & 1);
    if (ch + 2 < SEQ / 32) issue(ch + 2);
    LAS float* yb = ybuf + (ch & 1) * 1024;
    if (c.wave < 4) {
      const LAS float* B = buf0 + (ch & 1) * BUF_F;
      const LAS float* Lb = B + c8 * 8; const LAS float* Vb = B + 32 * 320 + row;
      float yk0 = 0.f, yk1 = 0.f, yk2 = 0.f, yk3 = 0.f, up = 0.f;
      f32x4 dw0 = *(const LAS f32x4*)(Lb), dw1 = *(const LAS f32x4*)(Lb + 4), nk0 = *(const LAS f32x4*)(Lb + 64), nk1 = *(const LAS f32x4*)(Lb + 68), ka0 = *(const LAS f32x4*)(Lb + 128), ka1 = *(const LAS f32x4*)(Lb + 132),
            kv0 = *(const LAS f32x4*)(Lb + 192), kv1 = *(const LAS f32x4*)(Lb + 196), rv0 = *(const LAS f32x4*)(Lb + 256), rv1 = *(const LAS f32x4*)(Lb + 260);
      float vv = Vb[0];
#define LO(v) ((f32x2){(v).x, (v).y})
#define HI(v) ((f32x2){(v).z, (v).w})
#pragma unroll
      for (int s = 0; s < 32; ++s) {
        f32x4 dw0n = dw0, dw1n = dw1, nk0n = nk0, nk1n = nk1, ka0n = ka0, ka1n = ka1, kv0n = kv0, kv1n = kv1, rv0n = rv0, rv1n = rv1; float vvn = vv;
        if (s + 1 < 32) { const LAS float* L = Lb + (s + 1) * 320;
          dw0n = *(const LAS f32x4*)(L); dw1n = *(const LAS f32x4*)(L + 4); nk0n = *(const LAS f32x4*)(L + 64); nk1n = *(const LAS f32x4*)(L + 68); ka0n = *(const LAS f32x4*)(L + 128); ka1n = *(const LAS f32x4*)(L + 132);
          kv0n = *(const LAS f32x4*)(L + 192); kv1n = *(const LAS f32x4*)(L + 196); rv0n = *(const LAS f32x4*)(L + 256); rv1n = *(const LAS f32x4*)(L + 260);
          vvn = Vb[(s + 1) * 32]; }
        __builtin_amdgcn_sched_barrier(0);
        f32x2 t = S0 * LO(nk0); t = S1 * HI(nk0) + t; t = S2 * LO(nk1) + t; t = S3 * HI(nk1) + t;
        const f32x2 tk0 = LO(kv0) * vv, tk1 = HI(kv0) * vv, tk2 = LO(kv1) * vv, tk3 = HI(kv1) * vv;
        float sa = t.x + t.y, yq = up;
        sa += dppf<0xB1>(sa); yq += dppf<0xB1>(yq);
        sa += dppf<0x4E>(sa); yq += dppf<0x4E>(yq);
        sa += dppf<0x141>(sa); yq += dppf<0x141>(yq);
        if (s >= 1) { const int sp = s - 1;
          if (sp < 8) yk0 = (c8 == sp) ? yq : yk0; else if (sp < 16) yk1 = (c8 == sp - 8) ? yq : yk1; else if (sp < 24) yk2 = (c8 == sp - 16) ? yq : yk2; else yk3 = (c8 == sp - 24) ? yq : yk3; }
        S0 = S0 * LO(dw0) + tk0; S1 = S1 * HI(dw0) + tk1; S2 = S2 * LO(dw1) + tk2; S3 = S3 * HI(dw1) + tk3;
        S0 = LO(ka0) * sa + S0; S1 = HI(ka0) * sa + S1; S2 = LO(ka1) * sa + S2; S3 = HI(ka1) * sa + S3;
        f32x2 u = S0 * LO(rv0); u = S1 * HI(rv0) + u; u = S2 * LO(rv1) + u; u = S3 * HI(rv1) + u;
        up = u.x + u.y;
        __builtin_amdgcn_sched_barrier(0);
        dw0 = dw0n; dw1 = dw1n; nk0 = nk0n; nk1 = nk1n; ka0 = ka0n; ka1 = ka1n; kv0 = kv0n; kv1 = kv1n; rv0 = rv0n; rv1 = rv1n; vv = vvn;
      }
#undef LO
#undef HI
      { float yq = up; yq += dppf<0xB1>(yq); yq += dppf<0x4E>(yq); yq += dppf<0x141>(yq); yk3 = (c8 == 7) ? yq : yk3; }
      yb[c8 * 32 + row] = yk0; yb[(8 + c8) * 32 + row] = yk1; yb[(16 + c8) * 32 + row] = yk2; yb[(24 + c8) * 32 + row] = yk3;
    }
    lds_barrier();
    { const int s = tid >> 4, r2 = (tid & 15) * 2; const float y0 = yb[s * 32 + r2], y1 = yb[s * 32 + r2 + 1];
      *(unsigned*)(MIX + (tokbase + ch * 32 + s) * 1024 + 512 + h * 64 + half * 32 + r2) = cvtpk(y0, y1); }
  }
  __builtin_amdgcn_s_setprio(0);
}

DI float wave_max(float v) {
#pragma unroll
  for (int o = 1; o < 64; o <<= 1) v = fmaxf(v, __shfl_xor(v, o));
  return v;
}
DI float wave_min(float v) {
#pragma unroll
  for (int o = 1; o < 64; o <<= 1) v = fminf(v, __shfl_xor(v, o));
  return v;
}
DI void attn_knorm(const Ctx& c) {
  const bf16_t* Z = (const bf16_t*)(c.ws + WS_ZEVEN); float* KN = (float*)(c.ws + WS_KN);
  const int gw = c.bid * NWAVES + c.wave, NGW = c.G * NWAVES;
  for (int item = gw; item < 32 * 64; item += NGW) {
    const int bh = item >> 6, tile = item & 63, b = bh >> 2, h = bh & 3;
    const bf16_t* p = Z + (size_t)(b * SEQ + tile * 64 + c.lane) * EVEN_IN + 512 + h * 128;
    float s0 = 0.f, s1 = 0.f;
#pragma unroll
    for (int i = 0; i < 8; ++i) { float f[8], g[8]; unpack8(*(const bf16x8*)(p + i * 8), f); unpack8(*(const bf16x8*)(p + 64 + i * 8), g);
#pragma unroll
      for (int e = 0; e < 8; ++e) { s0 += f[e] * f[e]; s1 += g[e] * g[e]; } }
    const float m0 = wave_max(sqrtf(s0)), m1 = wave_max(sqrtf(s1));
    if (c.lane == 0) { KN[(bh * 2 + 0) * 64 + tile] = m0; KN[(bh * 2 + 1) * 64 + tile] = m1; }
  }
}

DI float xrow_max(float v) {
  auto a = __builtin_amdgcn_permlane16_swap(__float_as_uint(v), __float_as_uint(v), false, false);
  v = fmaxf(__uint_as_float(a[0]), __uint_as_float(a[1]));
  auto b = __builtin_amdgcn_permlane32_swap(__float_as_uint(v), __float_as_uint(v), false, false);
  return fmaxf(__uint_as_float(b[0]), __uint_as_float(b[1]));
}
DI float xrow_sum(float v) {
  auto a = __builtin_amdgcn_permlane16_swap(__float_as_uint(v), __float_as_uint(v), false, false);
  v = __uint_as_float(a[0]) + __uint_as_float(a[1]);
  auto b = __builtin_amdgcn_permlane32_swap(__float_as_uint(v), __float_as_uint(v), false, false);
  return __uint_as_float(b[0]) + __uint_as_float(b[1]);
}
DI void attn_unit(const Ctx& c, const Args& a, int j, int b, int h, int c2, float lam, float lam_init) {
  const bf16_t* Z = (const bf16_t*)(c.ws + WS_ZEVEN) + (size_t)b * SEQ * EVEN_IN;
  bf16_t* MIX = (bf16_t*)(c.ws + WS_MIXE) + (size_t)b * SEQ * 1024;
  const float* subln = a.in[c.z + IN_SUBLN] + (size_t)j * 128;
  const int tid = c.tid, lane = c.lane, wave = c.wave, l15 = lane & 15, quad = lane >> 4, q_ = l15 >> 2, p_ = l15 & 3;
  const int q0 = 128 * c2 + 16 * wave, my_chunk = 2 * c2 + (wave >> 2), nkt = 2 * c2 + 2;
  constexpr int RS = 288, IMG = 64 * RS, BUFB = 2 * IMG;
  constexpr float QSC = 0.125f * LOG2E;
  LAS unsigned char* qlds = c.lds + 2 * BUFB + wave * 4096 + lane * 16;
  LAS float* red = (LAS float*)(c.lds + 2 * BUFB + 32768);
  const float* KN = (const float*)(c.ws + WS_KN) + (size_t)((b * 4 + h) * 2) * 64;
  float qpart[2] = {0.f, 0.f};
#pragma unroll
  for (int m = 0; m < 2; ++m)
#pragma unroll
    for (int ks = 0; ks < 2; ++ks) { const bf16x8 raw = *(const bf16x8*)(Z + (size_t)(q0 + l15) * EVEN_IN + h * 128 + m * 64 + ks * 32 + quad * 8);
      float f[8]; unpack8(raw, f);
#pragma unroll
      for (int e = 0; e < 8; ++e) qpart[m] += (f[e] * QSC) * (f[e] * QSC);
      u32x4 w; w.x = cvtpk(f[0] * QSC, f[1] * QSC); w.y = cvtpk(f[2] * QSC, f[3] * QSC); w.z = cvtpk(f[4] * QSC, f[5] * QSC); w.w = cvtpk(f[6] * QSC, f[7] * QSC);
      *(LAS u32x4*)(qlds + (m * 2 + ks) * 1024) = w; }
  f32x4 o[2][8];
#pragma unroll
  for (int m = 0; m < 2; ++m)
#pragma unroll
    for (int d = 0; d < 8; ++d) o[m][d] = (f32x4){0.f, 0.f, 0.f, 0.f};
  float mrun[2] = {-1e30f, -1e30f}, lrun[2] = {0.f, 0.f};
  const float slope2 = __builtin_amdgcn_exp2f(-2.f * (float)(h + 1)) * LOG2E;
  u32x4 pf[4];
  const int prow = tid >> 4, pc16 = tid & 15;
  const bf16_t* ksrc = Z + (size_t)prow * EVEN_IN + 512 + h * 128 + pc16 * 8;
  auto issue = [&](int kt) {
    const bf16_t* s = ksrc + (size_t)kt * 64 * EVEN_IN;
    pf[0] = *(const u32x4*)(s); pf[1] = *(const u32x4*)(s + (size_t)32 * EVEN_IN);
    pf[2] = *(const u32x4*)(s + 512); pf[3] = *(const u32x4*)(s + (size_t)32 * EVEN_IN + 512);
  };
  auto stash = [&](int bsel) {
    LAS unsigned char* B = c.lds + bsel * BUFB + prow * RS + pc16 * 16;
    *(LAS u32x4*)(B) = pf[0]; *(LAS u32x4*)(B + 32 * RS) = pf[1]; *(LAS u32x4*)(B + IMG) = pf[2]; *(LAS u32x4*)(B + IMG + 32 * RS) = pf[3];
  };
  issue(nkt - 1); stash(0);
  { const float w0 = wave_max(sqrtf(xrow_sum(qpart[0]))), w1 = wave_max(sqrtf(xrow_sum(qpart[1]))); if (lane == 0) { red[wave * 2] = w0; red[wave * 2 + 1] = w1; } }
  __syncthreads();
  int n_iter = nkt;
#pragma unroll 1
  for (int it = 0; it < n_iter; ++it) {
    const int kt = nkt - 1 - it;
    const bool has_next = it + 1 < n_iter;
    if (has_next) issue(kt - 1);
    if (kt <= my_chunk) {
      const LAS unsigned char* Kb = c.lds + (it & 1) * BUFB; const LAS unsigned char* Vb = Kb + IMG;
      float sl = slope2; asm volatile("" : "+v"(sl));
      const float db = (float)(q0 + l15 - 64 * kt - 4 * quad), atile = -sl * db;
      bf16x8 pfr[2][2]; bool live = false;
#pragma unroll
      for (int m = 0; m < 2; ++m) {
        f32x4 s[4];
#pragma unroll
        for (int t16 = 0; t16 < 4; ++t16) { const float r0 = sl * (float)(16 * t16); f32x4 acc = {r0, r0 + sl, r0 + 2.f * sl, r0 + 3.f * sl};
#pragma unroll
          for (int ks = 0; ks < 2; ++ks) { const bf16x8 kf = *(const LAS bf16x8*)(Kb + (16 * t16 + l15) * RS + (m * 64 + ks * 32 + quad * 8) * 2); acc = MFMA16(kf, *(const LAS bf16x8*)(qlds + (m * 2 + ks) * 1024), acc); }
          s[t16] = acc; }
        if (kt >= 2 * c2) {
#pragma unroll
          for (int t16 = 0; t16 < 4; ++t16)
#pragma unroll
            for (int e = 0; e < 4; ++e) s[t16][e] -= 2.f * sl * fmaxf((float)(16 * t16 + e) - db, 0.f);
        }
        float mx = fmaxf(fmaxf(s[0][0], s[0][1]), fmaxf(s[0][2], s[0][3]));
#pragma unroll
        for (int t16 = 1; t16 < 4; ++t16) mx = fmaxf(mx, fmaxf(fmaxf(s[t16][0], s[t16][1]), fmaxf(s[t16][2], s[t16][3])));
        const float mt = xrow_max(mx + atile);
        if (__any(mt > mrun[m] - 32.f)) {
          live = true;
          const float mnew = fmaxf(mrun[m], mt), alpha = __builtin_amdgcn_exp2f(mrun[m] - mnew), shift = mnew - atile; mrun[m] = mnew;
          float ps = 0.f;
#pragma unroll
          for (int t16 = 0; t16 < 4; ++t16)
#pragma unroll
            for (int e = 0; e < 4; ++e) { const float p = __builtin_amdgcn_exp2f(s[t16][e] - shift); s[t16][e] = p; ps += p; }
          lrun[m] = lrun[m] * alpha + ps;
          if (__any(alpha != 1.f)) {
#pragma unroll
            for (int d = 0; d < 8; ++d) o[m][d] = o[m][d] * alpha;
          }
#pragma unroll
          for (int s2 = 0; s2 < 2; ++s2) { u32x4 w; w.x = cvtpk(s[2 * s2][0], s[2 * s2][1]); w.y = cvtpk(s[2 * s2][2], s[2 * s2][3]);
            w.z = cvtpk(s[2 * s2 + 1][0], s[2 * s2 + 1][1]); w.w = cvtpk(s[2 * s2 + 1][2], s[2 * s2 + 1][3]); pfr[m][s2] = __builtin_bit_cast(bf16x8, w); }
        } else { pfr[m][0] = (bf16x8){0, 0, 0, 0, 0, 0, 0, 0}; pfr[m][1] = pfr[m][0]; }
      }
      if (live) {
#pragma unroll
        for (int s2 = 0; s2 < 2; ++s2)
#pragma unroll
          for (int d = 0; d < 8; ++d) {
            const LAS unsigned char* vp = Vb + (32 * s2 + 4 * quad + q_) * RS + (16 * d + 4 * p_) * 2;
            const bf16x8 vf = comb8(tr_read(vp), tr_read(vp + 16 * RS));
            o[0][d] = MFMA16(vf, pfr[0][s2], o[0][d]); o[1][d] = MFMA16(vf, pfr[1][s2], o[1][d]);
          }
      }
    }
    if (has_next) stash((it + 1) & 1);
    const bool prune = (it == 1) && (nkt > 3);
    if (prune) { const float m0 = wave_min(mrun[0]), m1 = wave_min(mrun[1]); if (lane == 0) { red[16 + wave * 2] = m0; red[16 + wave * 2 + 1] = m1; } }
    lds_barrier();
    if (prune) {
      float q0 = red[0], q1 = red[1], mm0 = red[16], mm1 = red[17];
#pragma unroll
      for (int w2 = 1; w2 < 8; ++w2) { q0 = fmaxf(q0, red[2 * w2]); q1 = fmaxf(q1, red[2 * w2 + 1]); mm0 = fminf(mm0, red[16 + 2 * w2]); mm1 = fminf(mm1, red[17 + 2 * w2]); }
      bool need = false;
      if (lane < nkt - 3) { const float dmin = (float)(128 * c2 - 64 * lane - 63);
        need = (q0 * KN[lane] * 1.01f - slope2 * dmin > mm0 - 40.f) || (q1 * KN[64 + lane] * 1.01f - slope2 * dmin > mm1 - 40.f); }
      const unsigned long long bal = __ballot(need);
      const int kt_stop = bal ? (int)__builtin_ctzll(bal) : (nkt - 3);
      n_iter = __builtin_amdgcn_readfirstlane(nkt - kt_stop);
    }
  }
  float inv[2];
#pragma unroll
  for (int m = 0; m < 2; ++m) { float l = xrow_sum(lrun[m]); inv[m] = 1.f / l; }
  const float i1 = lam * inv[1];
  float ss = 0.f;
#pragma unroll
  for (int d = 0; d < 8; ++d)
#pragma unroll
    for (int e = 0; e < 4; ++e) { const float v = o[0][d][e] * inv[0] - o[1][d][e] * i1; o[0][d][e] = v; ss += v * v; }
  ss = xrow_sum(ss);
  const float rn = __builtin_amdgcn_rsqf(ss * (1.f / 128.f) + NORM_EPS) * (1.f - lam_init);
  bf16_t* orow = MIX + (size_t)(q0 + l15) * 1024 + h * 128 + 4 * quad;
#pragma unroll
  for (int d = 0; d < 8; ++d) { const f32x4 g = *(const f32x4*)(subln + 16 * d + 4 * quad);
    u32x2 w; w.x = cvtpk(o[0][d][0] * rn * g.x, o[0][d][1] * rn * g.y); w.y = cvtpk(o[0][d][2] * rn * g.z, o[0][d][3] * rn * g.w);
    *(u32x2*)(orow + 16 * d) = w; }
}

DI void attn_phase(const Ctx& c, const Args& a, int j, int layer, unsigned* counter) {
  const float* lv = a.in[c.z + IN_LAM] + (size_t)j * 4 * 64;
  const float lam_init = 0.8f - 0.6f * __expf(-0.3f * (float)layer);
  const float d1 = wave_sum(lv[c.lane] * lv[64 + c.lane]), d2 = wave_sum(lv[128 + c.lane] * lv[192 + c.lane]);
  const float lam = __expf(d1) - __expf(d2) + lam_init;
  LAS int* qw = (LAS int*)(c.lds + LDS_CTLO + 64);
  const int x = (int)(xb_xcc_id() & 7u);
#define NEXT_ITEM(dst) do { __syncthreads(); if (c.tid == 0) *qw = (int)atomicAdd(counter + q, 1u); __syncthreads(); dst = *qw; } while (0)
  for (int qi = 0; qi < 8; ++qi) { const int q = (x + qi) & 7;
    int item; NEXT_ITEM(item);
    while (item < 16) { rwkv_scan_item(c, (q * 8 + (item >> 1)) * 2 + (item & 1)); NEXT_ITEM(item); }
    while (item < 144) { const int r = item - 16; const int c2 = 31 - (r >> 2), bh = q * 4 + (r & 3);
      attn_unit(c, a, j, bh >> 2, bh & 3, c2, lam, lam_init); NEXT_ITEM(item); }
  }
#undef NEXT_ITEM
}

DI void rwkv_post(const Ctx& c, const Args& a, int j) {
  const bf16_t* RW = (const bf16_t*)(c.ws + WS_RW);
  bf16_t* MIX = (bf16_t*)(c.ws + WS_MIXE);
  const float* vec = a.in[c.z + IN_VEC] + (size_t)j * 7 * 512;
  const int gw = c.bid * NWAVES + c.wave, NGW = c.G * NWAVES, rg = c.lane >> 4, c4 = (c.lane & 15) * 4;
  u32x2 yc, rc, kc, vc, gc;
  { const int p = gw * 4 + rg, t = p >> 3, h = p & 7, cc = h * 64 + c4; const size_t o = (size_t)t * 512 + cc;
    yc = *(const u32x2*)(MIX + (size_t)t * 1024 + 512 + cc); rc = *(const u32x2*)(RW + 4 * RW_STRIDE + o); kc = *(const u32x2*)(RW + 3 * RW_STRIDE + o); vc = *(const u32x2*)(RW + 5 * RW_STRIDE + o); gc = *(const u32x2*)(RW + 6 * RW_STRIDE + o); }
#pragma unroll 1
  for (int p4 = gw; p4 < M_TOK * 2; p4 += NGW) {
    const int p = p4 * 4 + rg, t = p >> 3, h = p & 7, cc = h * 64 + c4;
    u32x2 yn = yc, rn = rc, kn = kc, vn = vc, gn = gc;
    if (p4 + NGW < M_TOK * 2) { const int pq = (p4 + NGW) * 4 + rg, tq = pq >> 3, hq = pq & 7, cq = hq * 64 + c4; const size_t oq = (size_t)tq * 512 + cq;
      yn = *(const u32x2*)(MIX + (size_t)tq * 1024 + 512 + cq); rn = *(const u32x2*)(RW + 4 * RW_STRIDE + oq); kn = *(const u32x2*)(RW + 3 * RW_STRIDE + oq); vn = *(const u32x2*)(RW + 5 * RW_STRIDE + oq); gn = *(const u32x2*)(RW + 6 * RW_STRIDE + oq); }
    bf16_t* mp = MIX + (size_t)t * 1024 + 512 + cc;
    const f32x4 y = bf4_to_f(yc), r = bf4_to_f(rc), k = bf4_to_f(kc), v = bf4_to_f(vc), g = bf4_to_f(gc);
    const f32x4 rk = *(const f32x4*)(vec + 4 * 512 + cc), lw = *(const f32x4*)(vec + 5 * 512 + cc), lb = *(const f32x4*)(vec + 6 * 512 + cc);
    const float mean = row16_sum((y.x + y.y) + (y.z + y.w)) * (1.f / 64.f);
    const f32x4 d = y - mean;
    const float var = row16_sum((d.x * d.x + d.y * d.y) + (d.z * d.z + d.w * d.w)) * (1.f / 64.f);
    const float rs = __builtin_amdgcn_rsqf(var + 64e-5f);
    const f32x4 rkk = r * k * rk;
    const float bsum = row16_sum((rkk.x + rkk.y) + (rkk.z + rkk.w));
    st_bf4(mp, (d * rs * lw + lb + v * bsum) * g);
    yc = yn; rc = rn; kc = kn; vc = vn; gc = gn;
  }
}

DI void retention_unit(const Ctx& c, int bh, int slice) {
  const int b = bh >> 2, h = bh & 3;
  const bf16_t* Zq = (const bf16_t*)(c.ws + WS_ZODD) + (size_t)bh * SEQ * 256;
  const bf16_t* Zv = (const bf16_t*)(c.ws + WS_ZODD) + 67108864u + (size_t)(bh * 8 + slice) * SEQ * 64;
  bf16_t* YB = (bf16_t*)(c.ws + WS_YB) + (size_t)b * SEQ * 2048 + h * 512 + slice * 64;
  const int tid = c.tid, lane = c.lane, wave = c.wave, l15 = lane & 15, quad = lane >> 4, q_ = l15 >> 2, p_ = l15 & 3;
  constexpr int RQ = 544, RV = 160;
  LAS unsigned char* Qi = c.lds; LAS unsigned char* Ki = c.lds + 34816; LAS unsigned char* Vi = c.lds + 69632; LAS unsigned char* Vdi = c.lds + 79872;
  LAS unsigned char* Sci = c.lds + 90112; LAS unsigned char* Si = c.lds + 100352;
  const float log2g = __log2f(1.f - __builtin_amdgcn_exp2f(-5.f - (float)h));
  const float cd = __builtin_amdgcn_exp2f(log2g * 64.f);
  f32x4 st[2][4];
#pragma unroll
  for (int mt = 0; mt < 2; ++mt)
#pragma unroll
    for (int nt = 0; nt < 4; ++nt) st[mt][nt] = (f32x4){0.f, 0.f, 0.f, 0.f};
  u32x4 pq[4], pk[4], pv;
  const int prow = tid >> 5, pc = tid & 31;
  const bf16_t* qsrc = Zq + (size_t)tid * 8;
  const int vrow = tid >> 3, vc = tid & 7;
  const float kdv = __builtin_amdgcn_exp2f(log2g * (float)(63 - vrow));
  const bf16_t* vsrc = Zv + (size_t)tid * 8;
  auto issue = [&](int ch) {
#pragma unroll
    for (int i = 0; i < 4; ++i) { pq[i] = *(const u32x4*)(qsrc + (size_t)ch * 16384 + i * 4096); pk[i] = *(const u32x4*)(qsrc + 33554432u + (size_t)ch * 16384 + i * 4096); }
    pv = *(const u32x4*)(vsrc + (size_t)ch * 4096);
  };
  auto stash = [&]() {
#pragma unroll
    for (int i = 0; i < 4; ++i) { *(LAS u32x4*)(Qi + (prow + 16 * i) * RQ + pc * 16) = pq[i]; *(LAS u32x4*)(Ki + (prow + 16 * i) * RQ + pc * 16) = pk[i]; }
    *(LAS u32x4*)(Vi + vrow * RV + vc * 16) = pv;
    { float f[8]; unpack8(__builtin_bit_cast(bf16x8, pv), f);
      u32x4 w; w.x = cvtpk(f[0] * kdv, f[1] * kdv); w.y = cvtpk(f[2] * kdv, f[3] * kdv); w.z = cvtpk(f[4] * kdv, f[5] * kdv); w.w = cvtpk(f[6] * kdv, f[7] * kdv);
      *(LAS u32x4*)(Vdi + vrow * RV + vc * 16) = w; }
  };
  __syncthreads();
  issue(0);
  for (int i = tid; i < 34816 / 16; i += NTHR) *(LAS u32x4*)(Si + i * 16) = (u32x4){0u, 0u, 0u, 0u};
  stash();
  __syncthreads();
#pragma unroll 1
  for (int ch = 0; ch < 64; ++ch) {
    if (ch + 1 < 64) issue(ch + 1);
    {
      const int it = wave >> 1;
      bf16x8 qfa[8];
#pragma unroll
      for (int ks = 0; ks < 8; ++ks) qfa[ks] = *(const LAS bf16x8*)(Qi + (16 * it + l15) * RQ + (32 * ks + 8 * quad) * 2);
#pragma unroll
      for (int jj2 = 0; jj2 < 2; ++jj2) { const int jt = 2 * (wave & 1) + jj2; f32x4 acc = {0.f, 0.f, 0.f, 0.f};
#pragma unroll
        for (int ks = 0; ks < 8; ++ks) { const bf16x8 kf = *(const LAS bf16x8*)(Ki + (16 * jt + l15) * RQ + (32 * ks + 8 * quad) * 2);
          acc = MFMA16(kf, qfa[ks], acc); }
        const int i = 16 * it + l15, j0 = 16 * jt + 4 * quad; float v[4];
#pragma unroll
        for (int e = 0; e < 4; ++e) v[e] = acc[e] * __builtin_amdgcn_exp2f(log2g * __builtin_fabsf((float)(i - j0 - e)));
        u32x2 w; w.x = cvtpk(v[0], v[1]); w.y = cvtpk(v[2], v[3]); *(LAS u32x2*)(Sci + i * RV + j0 * 2) = w; }
    }
    lds_barrier();
    {
      const int et = wave >> 1;
      bf16x8 sfa[8];
#pragma unroll
      for (int ks = 0; ks < 8; ++ks) sfa[ks] = *(const LAS bf16x8*)(Si + (16 * et + l15) * RQ + (32 * ks + 8 * quad) * 2);
#pragma unroll
      for (int ii = 0; ii < 2; ++ii) { const int it2 = 2 * (wave & 1) + ii; f32x4 acc = {0.f, 0.f, 0.f, 0.f};
#pragma unroll
        for (int ks = 0; ks < 8; ++ks) { const bf16x8 qf = *(const LAS bf16x8*)(Qi + (16 * it2 + l15) * RQ + (32 * ks + 8 * quad) * 2); acc = MFMA16(sfa[ks], qf, acc); }
        const float qd = __builtin_amdgcn_exp2f(log2g * (float)(16 * it2 + l15 + 1)); acc = acc * qd;
#pragma unroll
        for (int s = 0; s < 2; ++s) { const LAS unsigned char* vp = Vi + (32 * s + 8 * quad + q_) * RV + (16 * et + 4 * p_) * 2;
          const bf16x8 vf = comb8(tr_read(vp), tr_read(vp + 4 * RV));
          const bf16x8 sc = *(const LAS bf16x8*)(Sci + (16 * it2 + l15) * RV + (32 * s + 8 * quad) * 2); acc = MFMA16(vf, sc, acc); }
        u32x2 w; w.x = cvtpk(acc[0], acc[1]); w.y = cvtpk(acc[2], acc[3]);
        *(u32x2*)(YB + (size_t)(ch * 64 + 16 * it2 + l15) * 2048 + 16 * et + 4 * quad) = w; }
#pragma unroll
      for (int mt = 0; mt < 2; ++mt)
#pragma unroll
        for (int nt = 0; nt < 4; ++nt) st[mt][nt] = st[mt][nt] * cd;
#pragma unroll
      for (int s = 0; s < 2; ++s) { bf16x8 vd[4];
#pragma unroll
        for (int nt = 0; nt < 4; ++nt) { const LAS unsigned char* vp = Vdi + (32 * s + 8 * quad + q_) * RV + (16 * nt + 4 * p_) * 2; vd[nt] = comb8(tr_read(vp), tr_read(vp + 4 * RV)); }
#pragma unroll
        for (int mt = 0; mt < 2; ++mt) { const LAS unsigned char* kp = Ki + (32 * s + 8 * quad + q_) * RQ + (32 * wave + 16 * mt + 4 * p_) * 2;
          const bf16x8 kf = comb8(tr_read(kp), tr_read(kp + 4 * RQ));
#pragma unroll
          for (int nt = 0; nt < 4; ++nt) st[mt][nt] = MFMA16(kf, vd[nt], st[mt][nt]); } }
    }
    lds_barrier();
#pragma unroll
    for (int mt = 0; mt < 2; ++mt)
#pragma unroll
      for (int nt = 0; nt < 4; ++nt) { u32x2 w; w.x = cvtpk(st[mt][nt][0], st[mt][nt][1]); w.y = cvtpk(st[mt][nt][2], st[mt][nt][3]);
        *(LAS u32x2*)(Si + (16 * nt + l15) * RQ + (32 * wave + 16 * mt + 4 * quad) * 2) = w; }
    if (ch + 1 < 64) stash();
    lds_barrier();
  }
}

DI void retention_post(const Ctx& c) {
  const bf16_t* YB = (const bf16_t*)(c.ws + WS_YB);
  bf16_t* Z = (bf16_t*)(c.ws + WS_ZODD);
  const int gw = c.bid * NWAVES + c.wave, NGW = c.G * NWAVES;
  bf16x8 yc, gc;
  { const int t = gw >> 2, h = gw & 3; yc = __builtin_nontemporal_load((const bf16x8*)(YB + (size_t)t * 2048 + h * 512 + c.lane * 8)); gc = *(const bf16x8*)(Z + 134217728u + (size_t)t * 2048 + h * 512 + c.lane * 8); }
#pragma unroll 1
  for (int p = gw; p < M_TOK * 4; p += NGW) {
    const int t = p >> 2, h = p & 3, pn = p + NGW;
    bf16x8 yn = yc, gn = gc;
    if (pn < M_TOK * 4) { const int tn = pn >> 2, hn = pn & 3; yn = __builtin_nontemporal_load((const bf16x8*)(YB + (size_t)tn * 2048 + hn * 512 + c.lane * 8)); gn = *(const bf16x8*)(Z + 134217728u + (size_t)tn * 2048 + hn * 512 + c.lane * 8); }
    bf16_t* gp = Z + 134217728u + (size_t)t * 2048 + h * 512 + c.lane * 8;
    float y[8], g[8]; unpack8(yc, y); unpack8(gc, g);
    float ss = 0.f;
#pragma unroll
    for (int e = 0; e < 8; ++e) ss += y[e] * y[e];
    const float rn = __builtin_amdgcn_rsqf(wave_sum(ss) * (1.f / 512.f) + NORM_EPS);
#pragma unroll
    for (int e = 0; e < 8; ++e) y[e] = siluf_(g[e]) * y[e] * rn;
    u32x4 w; w.x = cvtpk(y[0], y[1]); w.y = cvtpk(y[2], y[3]); w.z = cvtpk(y[4], y[5]); w.w = cvtpk(y[6], y[7]);
    *(u32x4*)gp = w;
    yc = yn; gc = gn;
  }
}

#define XB_TMO      128
#define XB_XCNT(j)  (256  + 64 * (j))
#define XB_XSUB(j)  (1280 + 64 * (j))
#define XB_XGEN(j)  (2304 + 64 * (j))
#define XB_TOP      3328
#define XB_TOPGEN   3392
#define XCD_BAR_WORDS 3456
#define XB_SPIN_CAP (1u << 18)
__device__ __forceinline__ unsigned xb_ld(unsigned* p)              { return __hip_atomic_load(p, __ATOMIC_RELAXED, __HIP_MEMORY_SCOPE_AGENT); }
__device__ __forceinline__ unsigned xb_add(unsigned* p, unsigned v) { return __hip_atomic_fetch_add(p, v, __ATOMIC_RELAXED, __HIP_MEMORY_SCOPE_AGENT); }
#define XB_SPIN(cond, bar) do { unsigned _sp = 0; while (cond) { __builtin_amdgcn_s_sleep(1); \
    if ((++_sp & 255u) == 0u) { if (xb_ld(&(bar)[XB_TMO])) break; if (_sp > XB_SPIN_CAP) { atomicAdd(&(bar)[XB_TMO], 1u); break; } } } } while (0)
struct XcdBarrier { unsigned* bar; unsigned x; volatile LAS unsigned* st; };
__device__ __forceinline__ XcdBarrier xcd_barrier_post(unsigned* bar, volatile LAS unsigned* st) {
    XcdBarrier b; b.bar = bar; b.x = xb_xcc_id(); b.st = st;
    if (threadIdx.x == 0) (void)xb_add(&bar[XB_XCNT(b.x)], 1u);
    return b;
}
__device__ __forceinline__ void xcd_barrier_complete(unsigned* bar, unsigned x, unsigned& nloc, unsigned& nx) {
    const unsigned G = gridDim.x * gridDim.y * gridDim.z;
    unsigned sum, cnt, mine, sp = 0u;
    for (;;) {
        sum = 0u; cnt = 0u; mine = 0u;
#pragma unroll
        for (unsigned j = 0; j < 16; ++j) { const unsigned c = xb_ld(&bar[XB_XCNT(j)]); sum += c; cnt += (c > 0u) ? 1u : 0u; mine = (j == x) ? c : mine; }
        if (sum == G) break;
        __builtin_amdgcn_s_sleep(1);
        if ((++sp & 255u) == 0u) { if (xb_ld(&bar[XB_TMO])) break; if (sp > XB_SPIN_CAP) { atomicAdd(&bar[XB_TMO], 1u); break; } }
    }
    nloc = mine > 0u ? mine : 1u; nx = cnt > 0u ? cnt : 1u;
}
__device__ __forceinline__ void xcd_barrier(const XcdBarrier& b) {
    asm volatile("s_waitcnt vmcnt(0)" ::: "memory");
    __syncthreads();
    if (threadIdx.x == 0) {
        unsigned* bar = b.bar;
        __builtin_amdgcn_s_waitcnt(0);
        unsigned nloc = b.st[0], nx = b.st[1];
        if (nloc == 0u) { xcd_barrier_complete(bar, b.x, nloc, nx); b.st[0] = nloc; b.st[1] = nx; }
        const unsigned old = xb_add(&bar[XB_XSUB(b.x)], 1u);
        const unsigned gen = old / nloc;
        if (old + 1u == (gen + 1u) * nloc) {
            __builtin_amdgcn_fence(__ATOMIC_RELEASE, "agent");
            asm volatile("s_waitcnt vmcnt(0)" ::: "memory");
            const unsigned og = xb_add(&bar[XB_TOP], 1u);
            const unsigned tg = og / nx;
            if (og + 1u == (tg + 1u) * nx) xb_add(&bar[XB_TOPGEN], 1u);
            else XB_SPIN(xb_ld(&bar[XB_TOPGEN]) == tg, bar);
            __builtin_amdgcn_fence(__ATOMIC_ACQUIRE, "agent");
            xb_add(&bar[XB_XGEN(b.x)], 1u);
            asm volatile("s_waitcnt vmcnt(0)" ::: "memory");
        } else {
            XB_SPIN(xb_ld(&bar[XB_XGEN(b.x)]) == gen, bar);
            __builtin_amdgcn_fence(__ATOMIC_ACQUIRE, "agent");
            asm volatile("s_waitcnt vmcnt(0)" ::: "memory");
        }
    }
    __syncthreads();
}

enum { T_CONV = 0, T_GU_A, T_DOWN_A, T_ROW1, T_WIN, T_PREP, T_SCAN, T_MIX, T_POST, T_WOUT, T_ROW3, T_GU_B, T_DOWN_B, T_RET, T_RETPOST, T_FINAL };
__global__ void __launch_bounds__(NTHR, 2) fwd_megakernel(Args args) {
  extern __shared__ __attribute__((aligned(16))) unsigned char lds_raw[];
  cg::grid_group grid = cg::this_grid();
  const int lo = args.ph_lo, hi = args.ph_hi;
  volatile LAS unsigned* bst = (volatile LAS unsigned*)((LAS unsigned char*)lds_raw + LDS_CTLO + 128);
  if (threadIdx.x < 2) bst[threadIdx.x] = 0u;
  __syncthreads();
  XcdBarrier xbar; xbar.bar = (unsigned*)(args.ws + WS_CTL) + 4096; xbar.x = 0; xbar.st = bst;
  if (!MK_PER_PHASE) xbar = xcd_barrier_post((unsigned*)(args.ws + WS_CTL) + 4096, bst);
#pragma unroll 1
  for (int ph = lo; ph < hi; ++ph) {
    Ctx c;
    { int tid = threadIdx.x, bid = blockIdx.x, G = gridDim.x, z = 0;
      asm volatile("" : "+v"(tid)); asm volatile("" : "+s"(bid), "+s"(G), "+s"(z));
      unsigned char* ws = args.ws + z; float* out = args.out + z;
      c.lds = (LAS unsigned char*)lds_raw; c.tid = tid; c.lane = tid & 63; c.wave = __builtin_amdgcn_readfirstlane(tid >> 6);
      c.G = G; c.bid = bid; c.z = z; c.ws = ws; c.out = out; }
    int L, k;
    if (ph < 12) { L = 0; k = ph; } else if (ph < 23) { L = 1; k = ph - 12; } else if (ph < 35) { L = 2; k = ph - 23; } else if (ph < 46) { L = 3; k = ph - 35; } else { L = 4; k = 0; }
    int type;
    if (L == 4) type = T_FINAL;
    else if ((L & 1) == 0) type = (k <= T_PREP) ? k : k + 1;
    else type = (k <= 4) ? k : (k == 5 ? T_RET : (k == 6 ? T_RETPOST : k + 2));
    const unsigned long long pt0 = PROBE_MASK ? __builtin_amdgcn_s_memrealtime() : 0ull;
    const bool even = (L & 1) == 0; const int j = L >> 1;
    const bool is_gemm = (type == T_GU_A || type == T_DOWN_A || type == T_WIN || type == T_WOUT || type == T_GU_B || type == T_DOWN_B);
    if (is_gemm) {
      pg8::Gemm g; pg8::EpiRT E;
      bf16_t* XB = (bf16_t*)(c.ws + WS_XB); bf16_t* F = (bf16_t*)(c.ws + WS_F); bf16_t* H = (bf16_t*)(c.ws + WS_H);
      const float* RINV = (const float*)(c.ws + WS_RINV);
      g.M = M_TOK;
      if (type == T_GU_A || type == T_GU_B) { g.A = XB; g.Bt = (const bf16_t*)(c.ws + (type == T_GU_A ? WS_WGU0 : WS_WGU1)); g.N = 2 * DFF; g.K = DM; g.lda = DM; g.ldb = DM; E.mode = 2; E.O = H; E.ldc = DFF; E.rs = RINV; }
      else if (type == T_DOWN_A || type == T_DOWN_B) { g.A = H; g.Bt = (const bf16_t*)(c.ws + (type == T_DOWN_A ? WS_WD0 : WS_WD1)); g.N = DM; g.K = DFF; g.lda = DFF; g.ldb = DFF; E.mode = 0; E.O = F; E.ldc = DM; E.rs = RINV; }
      else if (type == T_WIN) { const int NIN = even ? EVEN_IN : ODD_IN; g.A = XB; g.Bt = (const bf16_t*)(c.ws + WS_WIN); g.N = NIN; g.K = DM; g.lda = DM; g.ldb = DM; E.mode = even ? 1 : 3; E.O = (bf16_t*)(c.ws + (even ? WS_ZEVEN : WS_ZODD)); E.ldc = NIN; E.rs = RINV; }
      else { if (even) { g.A = (const bf16_t*)(c.ws + WS_MIXE); g.K = DM; g.lda = DM; g.ldb = DM; } else { g.A = (const bf16_t*)(c.ws + WS_ZODD) + 134217728u; g.K = 2048; g.lda = 2048; g.ldb = 2048; }
        g.Bt = (const bf16_t*)(c.ws + WS_WOUT); g.N = DM; E.mode = 0; E.O = F; E.ldc = DM; E.rs = RINV; }
      pg8::StaticOrder S; S.init(M_TOK, g.N, c.G, c.bid);
      pg8::gemm_phase(c.lds, g, S, E);
      if ((DUP_MASK >> type) & 1) pg8::gemm_phase(c.lds, g, S, E);
    } else if (type == T_CONV || type == T_ROW1 || type == T_ROW3 || type == T_FINAL) {
      const float* xin = nullptr; float* xout = nullptr; const bf16_t* F = (const bf16_t*)(c.ws + WS_F); const float* gain = nullptr; float coef = 0.5f;
      if (type == T_CONV) {
        convert_layer(c, args, L);
        if (L == 0) { xin = args.in[c.z + IN_X]; F = nullptr; } else gain = args.in[c.z + IN_NORMS] + (size_t)(L - 1) * 6 * DM + 5 * DM;
      } else if (type == T_ROW1) gain = args.in[c.z + IN_NORMS] + (size_t)L * 6 * DM + 1 * DM;
      else if (type == T_ROW3) { gain = args.in[c.z + IN_NORMS] + (size_t)L * 6 * DM + 3 * DM; coef = 1.0f; }
      else { gain = args.in[c.z + IN_NORMS] + (size_t)3 * 6 * DM + 5 * DM; xout = c.out; }
      rowpass(c, xin, xout, F, gain, coef);
    } else if (type == T_PREP) {
      rwkv_prep(c, args, j);
      attn_knorm(c);
    } else if (type == T_MIX) {
      attn_phase(c, args, j, L, (unsigned*)(c.ws + WS_CTL) + 64 * j);
    } else if (type == T_POST) {
      rwkv_post(c, args, j);
    } else if (type == T_RET) {
      { unsigned* cnt0 = (unsigned*)(c.ws + WS_CTL) + 128 + 64 * j; const int x = (int)(xb_xcc_id() & 7u);
        LAS int* qw = (LAS int*)(c.lds + LDS_CTLO + 64);
        for (int qi = 0; qi < 8; ++qi) { const int q = (x + qi) & 7;
          for (;;) { __syncthreads(); if (c.tid == 0) *qw = (int)atomicAdd(cnt0 + q, 1u); __syncthreads();
            const int slot = *qw; if (slot >= 32) break; retention_unit(c, q * 4 + (slot >> 3), slot & 7); } } }
    } else if (type == T_RETPOST) {
      retention_post(c);
    }
    if (PROBE_MASK && ((PROBE_MASK >> type) & 1)) { __syncthreads(); const unsigned long long pt1 = __builtin_amdgcn_s_memrealtime(); while (__builtin_amdgcn_s_memrealtime() - pt1 < pt1 - pt0) __builtin_amdgcn_s_sleep(8); }
    if (ph + 1 < hi) { if (lo < 0) grid.sync(); else xcd_barrier(xbar); }
  }
}
constexpr int N_PHASES = 12 + 11 + 12 + 11 + 1;

extern "C" void kernel_launch(void* const* d_in, const int* in_sizes, int n_in, void* d_out, int out_size, void* d_ws, size_t ws_size, hipStream_t stream) {
  static int grid = 0;
  if (grid == 0) {
    if (n_in != 18 || out_size != M_TOK * DM || ws_size < WS_END) { fprintf(stderr, "kernel_launch: unexpected shapes (n_in %d, out %d, ws %zu, need %zu)\n", n_in, out_size, ws_size, (size_t)WS_END); grid = -1; return; }
    int dev = 0, cus = 0, per_cu = 0;
    hipGetDevice(&dev); hipDeviceGetAttribute(&cus, hipDeviceAttributeMultiprocessorCount, dev);
    if (hipFuncSetAttribute((const void*)fwd_megakernel, hipFuncAttributeMaxDynamicSharedMemorySize, LDS_BYTES) != hipSuccess) { fprintf(stderr, "kernel_launch: hipFuncSetAttribute failed\n"); grid = -1; return; }
    if (hipOccupancyMaxActiveBlocksPerMultiprocessor(&per_cu, (const void*)fwd_megakernel, NTHR, LDS_BYTES) != hipSuccess || per_cu < 1) { fprintf(stderr, "kernel_launch: occupancy query gives %d\n", per_cu); per_cu = 1; }
    (void)hipGetLastError();
    grid = cus * per_cu;
    if (grid > 256) grid = 256;
  }
  if (grid < 0) return;
  hipMemsetAsync((char*)d_ws + WS_CTL, 0, CTL_BYTES, stream);
  Args a{};
  for (int i = 0; i < 18; ++i) a.in[i] = (const float*)d_in[i];
  a.out = (float*)d_out; a.ws = (unsigned char*)d_ws;
#if MK_PER_PHASE
  for (int p = 0; p < N_PHASES; ++p) { a.ph_lo = p; a.ph_hi = p + 1; hipLaunchKernelGGL(fwd_megakernel, dim3(grid), dim3(NTHR), LDS_BYTES, stream, a); }
#else
  a.ph_lo = 0; a.ph_hi = N_PHASES;
  void* kargs[] = {&a};
  hipError_t e = hipLaunchCooperativeKernel((const void*)fwd_megakernel, dim3(grid), dim3(NTHR), kargs, LDS_BYTES, stream);
  if (e != hipSuccess) fprintf(stderr, "cooperative launch failed: %s (grid %d)\n", hipGetErrorString(e), grid);
#endif
}
```

```cpp
#include <hip/hip_runtime.h>
#include <hip/hip_cooperative_groups.h>
#include <cstdio>
#include <cstdint>
namespace cg = cooperative_groups;

#define LAS __attribute__((address_space(3)))
#define DI __device__ __forceinline__
typedef unsigned short bf16_t;
typedef short bf16x8 __attribute__((ext_vector_type(8)));
typedef short s16x4 __attribute__((ext_vector_type(4)));
typedef float f32x4 __attribute__((ext_vector_type(4)));
typedef float f32x2 __attribute__((ext_vector_type(2)));
typedef unsigned u32x4 __attribute__((ext_vector_type(4)));
typedef unsigned u32x2 __attribute__((ext_vector_type(2)));
typedef __bf16 bf16x2_t __attribute__((ext_vector_type(2)));

#ifndef DUP_MASK
#define DUP_MASK 0
#endif
#ifndef PROBE_MASK
#define PROBE_MASK 0
#endif
#ifndef MK_PER_PHASE
#define MK_PER_PHASE 0
#endif

constexpr int M_TOK = 32768, SEQ = 4096, DM = 1024, DFF = 2816, NWAVES = 8, NTHR = 512;
constexpr int EVEN_IN = 3328, ODD_IN = 6144;
constexpr float NORM_EPS = 1e-6f;
constexpr float LOG2E = 1.4426950408889634f;

constexpr size_t MiB = 1u << 20;
constexpr size_t WS_CTL = 0, CTL_BYTES = 32768;
constexpr size_t WS_RINV = 1 * MiB;
constexpr size_t WS_KN = 1 * MiB + 512 * 1024;
constexpr size_t WS_WGU0 = 2 * MiB, WS_WD0 = 13 * MiB, WS_WIN = 19 * MiB, WS_WOUT = 31 * MiB, WS_WGU1 = 35 * MiB, WS_WD1 = 46 * MiB;
constexpr size_t WS_LORA = 51 * MiB + 512 * 1024;
constexpr size_t WS_VFIRST = 52 * MiB;
constexpr size_t WS_TMP = 84 * MiB;
constexpr size_t WS_XB = 596 * MiB, WS_F = WS_TMP + 64 * MiB;
constexpr size_t WS_BIG = 212 * MiB;
constexpr size_t WS_H = WS_BIG, WS_ZODD = WS_BIG, WS_MIXE = WS_BIG + 112 * MiB, WS_ZEVEN = WS_BIG + 176 * MiB;
constexpr size_t WS_RW = WS_TMP;
constexpr size_t RW_STRIDE = (size_t)M_TOK * 512;
constexpr size_t WS_YB = WS_TMP;
constexpr size_t WS_END = 660 * MiB;

constexpr int LDS_MAIN = 131072, LDS_CTLO = 159744, LDS_BYTES = 160 * 1024;

DI float bf2f(unsigned short b) { return __uint_as_float((unsigned)b << 16); }
DI unsigned cvtpk(float lo, float hi) { f32x2 v = {lo, hi}; bf16x2_t b = __builtin_convertvector(v, bf16x2_t); return __builtin_bit_cast(unsigned, b); }
DI bf16_t f2bf(float f) { return (bf16_t)(cvtpk(f, 0.f) & 0xffffu); }
DI float wave_sum(float v) {
#pragma unroll
  for (int o = 1; o < 64; o <<= 1) v += __shfl_xor(v, o);
  return v;
}
DI float sigmoidf_(float x) { return __builtin_amdgcn_rcpf(1.f + __builtin_amdgcn_exp2f(-x * LOG2E)); }
DI float siluf_(float x) { return x * sigmoidf_(x); }
DI float tanhf_(float x) { return 2.f * sigmoidf_(2.f * x) - 1.f; }
DI void unpack8(const bf16x8 v, float (&f)[8]) {
#pragma unroll
  for (int e = 0; e < 8; ++e) f[e] = bf2f((unsigned short)v[e]);
}
#define MFMA16(a, b, c) __builtin_amdgcn_mfma_f32_16x16x32_bf16((a), (b), (c), 0, 0, 0)
typedef short v4i16_t __attribute__((ext_vector_type(4)));
DI s16x4 tr_read(const LAS unsigned char* p) { return __builtin_bit_cast(s16x4, __builtin_amdgcn_ds_read_tr16_b64_v4i16((LAS v4i16_t*)p)); }
DI bf16x8 comb8(s16x4 lo, s16x4 hi) { return __builtin_shufflevector(lo, hi, 0, 1, 2, 3, 4, 5, 6, 7); }
template <int CTRL> DI float dppf(float v) { return __builtin_bit_cast(float, __builtin_amdgcn_update_dpp(0, __builtin_bit_cast(int, v), CTRL, 0xF, 0xF, true)); }
DI void lds_barrier() { asm volatile("s_waitcnt lgkmcnt(0)" ::: "memory"); __builtin_amdgcn_s_barrier(); asm volatile("" ::: "memory"); }
DI float row16_sum(float v) {
  v += dppf<0xB1>(v); v += dppf<0x4E>(v); v += dppf<0x141>(v); v += dppf<0x140>(v); return v;
}

__device__ __forceinline__ unsigned xb_xcc_id() { return (unsigned)__builtin_amdgcn_s_getreg((3 << 11) | 20) & 0xFu; }

namespace pg8 {
constexpr int BM = 256, BK = 64, HALF = 128, HTB = HALF * BK * 2, STAGE_BYTES = 8 * HTB, NXCD = 8, WGM = 4;
__host__ __device__ __forceinline__ int lds_byte(int r, int c) { const int st = (r >> 4) * 2 + (c >> 5), rr = r & 15, cc = c & 31, ob = rr * 64 + cc * 2; return st * 1024 + (ob ^ (((ob >> 9) & 1) << 5)); }
__host__ __device__ __forceinline__ void stage_rc(int b, int& R, int& C) { const int st = b / 1024, sb = b % 1024, swz = sb ^ (((sb >> 9) & 1) << 5); R = (st >> 1) * 16 + swz / 64; C = (st & 1) * 32 + (swz % 64) / 2; }
__host__ __device__ __forceinline__ int perm32(int rho) { const int n = rho >> 4, i = rho & 15; return 8 * (i >> 2) + 4 * n + (i & 3); }
struct Unit { int pm, pn; };
struct Gemm { const bf16_t* A; const bf16_t* Bt; int M, N, K, lda, ldb; };
struct StaticOrder {
  int nM, nN, nwg, G, c;
  __device__ void init(int M, int N, int G_, int c_) { nM = M / BM; nN = N / BM; nwg = nM * nN; G = G_; c = c_; }
  __device__ bool next(int i, Unit& u) const {
    const long L = (long)i * G + c; if (L >= nwg) return false;
    int wgid = (int)L; { const int q = nwg / NXCD, r = nwg % NXCD, xcd = wgid % NXCD, off = wgid / NXCD; wgid = (xcd < r ? xcd * (q + 1) : r * (q + 1) + (xcd - r) * q) + off; }
    const int nig = WGM * nN, gid = wgid / nig, fm = gid * WGM, gsz = (nM - fm) < WGM ? (nM - fm) : WGM;
    u.pm = fm + ((wgid % nig) % gsz); u.pn = (wgid % nig) / gsz; return true;
  }
};
template <int MODE> struct Epi {
  static constexpr bool PERM = true;
  bf16_t* O; int ldc; const float* rs;
  DI void operator()(const f32x4 (&acc)[2][2][4][2], const Unit& u, int wr, int wc, int fr, int fq) const {
    const int row0 = u.pm * BM + wr * 64 + fr;
    if constexpr (MODE == 2) {
      const int col0 = u.pn * HALF + wc * 32 + 8 * fq;
#pragma unroll
      for (int ai = 0; ai < 2; ++ai)
#pragma unroll
        for (int m = 0; m < 4; ++m) {
          const int row = row0 + ai * HALF + m * 16; const float r = rs[row];
          f32x4 g0 = acc[ai][0][m][0] * r, g1 = acc[ai][0][m][1] * r, u0 = acc[ai][1][m][0] * r, u1 = acc[ai][1][m][1] * r;
          float h[8];
#pragma unroll
          for (int e = 0; e < 4; ++e) { h[e] = siluf_(g0[e]) * u0[e]; h[4 + e] = siluf_(g1[e]) * u1[e]; }
          u32x4 w; w.x = cvtpk(h[0], h[1]); w.y = cvtpk(h[2], h[3]); w.z = cvtpk(h[4], h[5]); w.w = cvtpk(h[6], h[7]);
          *(u32x4*)(O + (size_t)row * ldc + col0) = w;
        }
    } else {
      const int col0 = u.pn * BM + wc * 32 + 8 * fq;
#pragma unroll
      for (int ai = 0; ai < 2; ++ai)
#pragma unroll
        for (int m = 0; m < 4; ++m) {
          const int row = row0 + ai * HALF + m * 16; float r = 1.f; if constexpr (MODE == 1) r = rs[row];
          bf16_t* rowp = O + (size_t)row * ldc + col0;
#pragma unroll
          for (int bj = 0; bj < 2; ++bj) { f32x4 v0 = acc[ai][bj][m][0] * r, v1 = acc[ai][bj][m][1] * r;
            u32x4 w; w.x = cvtpk(v0[0], v0[1]); w.y = cvtpk(v0[2], v0[3]); w.z = cvtpk(v1[0], v1[1]); w.w = cvtpk(v1[2], v1[3]);
            *(u32x4*)(rowp + bj * HALF) = w; }
        }
    }
  }
};

struct EpiRT {
  static constexpr bool PERM = true;
  int mode; bf16_t* O; int ldc; const float* rs;
  DI void operator()(const f32x4 (&acc)[2][2][4][2], const Unit& u, int wr, int wc, int fr, int fq) const {
    if (mode == 3) {
      const int row0 = u.pm * BM + wr * 64 + fr;
#pragma unroll
      for (int ai = 0; ai < 2; ++ai)
#pragma unroll
        for (int m = 0; m < 4; ++m) {
          const int row = row0 + ai * HALF + m * 16; const float r = rs[row]; const int b = row >> 12, t = row & 4095;
#pragma unroll
          for (int bj = 0; bj < 2; ++bj) { const int cw = wc * 32 + 8 * fq + bj * HALF; size_t off;
            if (u.pn < 8) off = (size_t)(u.pn >> 2) * 33554432u + ((size_t)((b * 4 + (u.pn & 3)) * 4096 + t)) * 256 + cw;
            else if (u.pn < 16) { const int e = ((u.pn - 8) & 1) * 256 + cw; off = (size_t)67108864u + ((size_t)(((b * 4 + ((u.pn - 8) >> 1)) * 8 + (e >> 6)) * 4096 + t)) * 64 + (e & 63); }
            else off = (size_t)134217728u + (size_t)row * 2048 + (u.pn - 16) * 256 + cw;
            f32x4 v0 = acc[ai][bj][m][0] * r, v1 = acc[ai][bj][m][1] * r;
            u32x4 w; w.x = cvtpk(v0[0], v0[1]); w.y = cvtpk(v0[2], v0[3]); w.z = cvtpk(v1[0], v1[1]); w.w = cvtpk(v1[2], v1[3]);
            *(u32x4*)(O + off) = w; }
        }
    }
    else if (mode == 2) { Epi<2> e{O, ldc, rs}; e(acc, u, wr, wc, fr, fq); }
    else if (mode == 1) { Epi<1> e{O, ldc, rs}; e(acc, u, wr, wc, fr, fq); }
    else { Epi<0> e{O, ldc, rs}; e(acc, u, wr, wc, fr, fq); }
  }
};

template <class EpiT>
DI void gemm_phase(LAS unsigned char* lds, const Gemm g, const StaticOrder& S, const EpiT& E) {
  const int tid = threadIdx.x, wid = __builtin_amdgcn_readfirstlane(tid >> 6), lane = tid & 63, wr = wid >> 2, wc = wid & 3, fr = lane & 15, fq = lane >> 4;
  const int K = g.K, nt = K / BK;
  unsigned voffA[2], voffB[2];
#pragma unroll
  for (int i = 0; i < 2; ++i) { int R, C; stage_rc(tid * 16 + i * 8192, R, C); const int Rb = EpiT::PERM ? ((R & ~31) + perm32(R & 31)) : R;
    voffA[i] = (unsigned)(R * g.lda + C) * 2u; voffB[i] = (unsigned)(Rb * g.ldb + C) * 2u; }
  const size_t kstep = (size_t)(BK * 2);
  const size_t hstepA = (size_t)HALF * g.lda * 2, hstepB = (size_t)HALF * g.ldb * 2;
  const size_t tstepA = 2 * hstepA, tstepB = 2 * hstepB;
  const unsigned ldsw = (unsigned)wid * 1024u;
  const int aoff = lds_byte(wr * 64 + fr, fq * 8), boff = lds_byte(wc * 32 + fr, fq * 8);
#define PG8_SA(b, h) (((b) * 2 + (h)) * HTB)
#define PG8_SB(b, h) ((4 + (b) * 2 + (h)) * HTB)
#define PG8_STAGE(bufoff, gbase, voff) do { _Pragma("unroll") for (int _i = 0; _i < 2; ++_i) \
    __builtin_amdgcn_global_load_lds((const unsigned*)((const char*)(gbase) + (voff)[_i]), (LAS unsigned*)(lds + (bufoff) + ldsw + _i * 8192), 16, 0, 0); } while (0)
#define PG8_LDA(dst, b, h) do { _Pragma("unroll") for (int m = 0; m < 4; ++m) _Pragma("unroll") for (int k = 0; k < 2; ++k) dst[m][k] = *(const LAS bf16x8*)(lds + PG8_SA(b, h) + aoff + m * 2048 + k * 1024); } while (0)
#define PG8_LDB(dst, b, h) do { _Pragma("unroll") for (int n = 0; n < 2; ++n) _Pragma("unroll") for (int k = 0; k < 2; ++k) dst[n][k] = *(const LAS bf16x8*)(lds + PG8_SB(b, h) + boff + n * 2048 + k * 1024); } while (0)
#define PG8_MMA(ai, bj, At, Bt) do { __builtin_amdgcn_s_setprio(1); _Pragma("unroll") for (int m = 0; m < 4; ++m) _Pragma("unroll") for (int n = 0; n < 2; ++n) _Pragma("unroll") for (int k = 0; k < 2; ++k) \
    acc[ai][bj][m][n] = __builtin_amdgcn_mfma_f32_16x16x32_bf16(Bt[n][k], At[m][k], acc[ai][bj][m][n], 0, 0, 0); __builtin_amdgcn_s_setprio(0); } while (0)
#define PG8_WAIT_V(n) asm volatile("s_waitcnt vmcnt(" #n ")" ::: "memory")
#define PG8_WAIT_L(n) asm volatile("s_waitcnt lgkmcnt(" #n ")" ::: "memory")
#define PG8_BAR __builtin_amdgcn_s_barrier()
#define PG8_SCHED __builtin_amdgcn_sched_barrier(0)
  Unit cur, nxt; int ui = 0;
  if (!S.next(0, cur)) return;
  f32x4 acc[2][2][4][2];
#pragma unroll
  for (int a = 0; a < 2; ++a)
#pragma unroll
    for (int b = 0; b < 2; ++b)
#pragma unroll
      for (int m = 0; m < 4; ++m)
#pragma unroll
        for (int n = 0; n < 2; ++n) acc[a][b][m][n] = (f32x4){0.f, 0.f, 0.f, 0.f};
  bf16x8 At[4][2], B0[2][2], B1[2][2];
  const char* cA = (const char*)g.A + (size_t)cur.pm * tstepA; const char* cB = (const char*)g.Bt + (size_t)cur.pn * tstepB;
  PG8_STAGE(PG8_SB(0, 0), cB, voffB); PG8_STAGE(PG8_SB(0, 1), cB + hstepB, voffB); PG8_STAGE(PG8_SA(0, 0), cA, voffA); PG8_STAGE(PG8_SA(0, 1), cA + hstepA, voffA);
  if (wr == 1) PG8_BAR;
  PG8_WAIT_V(2); PG8_BAR;
  PG8_STAGE(PG8_SB(1, 0), cB + kstep, voffB); PG8_STAGE(PG8_SA(1, 0), cA + kstep, voffA); PG8_STAGE(PG8_SB(1, 1), cB + hstepB + kstep, voffB);
  PG8_WAIT_V(6); PG8_BAR;
  for (;;) {
    const bool has_next = S.next(ui + 1, nxt);
    const char* nA = has_next ? (const char*)g.A + (size_t)nxt.pm * tstepA : cA; const char* nB = has_next ? (const char*)g.Bt + (size_t)nxt.pn * tstepB : cB;
    for (int t = 0; t < nt; t += 2) {
      const bool last = (t == nt - 2);
      const char* a1 = cA + (size_t)(t + 1) * kstep;
      const char* a2 = last ? nA : cA + (size_t)(t + 2) * kstep; const char* b2 = last ? nB : cB + (size_t)(t + 2) * kstep;
      const char* a3 = a2 + kstep; const char* b3 = b2 + kstep;
      PG8_LDB(B0, 0, 0); PG8_LDB(B1, 0, 1); PG8_SCHED; PG8_LDA(At, 0, 0); PG8_STAGE(PG8_SA(1, 1), a1 + hstepA, voffA);
      PG8_WAIT_V(8); PG8_WAIT_L(0); PG8_BAR; PG8_MMA(0, 0, At, B0); PG8_MMA(0, 1, At, B1); PG8_BAR; PG8_SCHED;
      PG8_LDA(At, 0, 1); PG8_STAGE(PG8_SB(0, 0), b2, voffB); PG8_STAGE(PG8_SB(0, 1), b2 + hstepB, voffB); PG8_STAGE(PG8_SA(0, 0), a2, voffA);
      PG8_WAIT_V(8); PG8_WAIT_L(0); PG8_BAR; PG8_MMA(1, 0, At, B0); PG8_MMA(1, 1, At, B1); PG8_BAR; PG8_SCHED;
      PG8_LDB(B0, 1, 0); PG8_LDB(B1, 1, 1); PG8_SCHED; PG8_LDA(At, 1, 0); PG8_STAGE(PG8_SA(0, 1), a2 + hstepA, voffA);
      PG8_WAIT_V(8); PG8_WAIT_L(0); PG8_BAR; PG8_MMA(0, 0, At, B0); PG8_MMA(0, 1, At, B1); PG8_BAR; PG8_SCHED;
      PG8_LDA(At, 1, 1); PG8_STAGE(PG8_SB(1, 0), b3, voffB); PG8_STAGE(PG8_SB(1, 1), b3 + hstepB, voffB); PG8_STAGE(PG8_SA(1, 0), a3, voffA);
      PG8_WAIT_V(8); PG8_WAIT_L(0); PG8_BAR; PG8_MMA(1, 0, At, B0); PG8_MMA(1, 1, At, B1); PG8_BAR; PG8_SCHED;
    }
    if (wr == 0) PG8_BAR;
    E(acc, cur, wr, wc, fr, fq);
    if (!has_next) break;
#pragma unroll
    for (int a = 0; a < 2; ++a)
#pragma unroll
      for (int b = 0; b < 2; ++b)
#pragma unroll
        for (int m = 0; m < 4; ++m)
#pragma unroll
          for (int n = 0; n < 2; ++n) acc[a][b][m][n] = (f32x4){0.f, 0.f, 0.f, 0.f};
    cur = nxt; cA = nA; cB = nB; ++ui;
    if (wr == 1) PG8_BAR;
  }
  PG8_WAIT_V(0);
  PG8_BAR;
#undef PG8_SA
#undef PG8_SB
#undef PG8_STAGE
#undef PG8_LDA
#undef PG8_LDB
#undef PG8_MMA
#undef PG8_WAIT_V
#undef PG8_WAIT_L
#undef PG8_BAR
#undef PG8_SCHED
}
}

struct Args { const float* in[18]; float* out; unsigned char* ws; int ph_lo, ph_hi; };
struct Ctx {
  LAS unsigned char* lds;
  int tid, lane, wave, G, bid, z;
  unsigned char* ws; float* out;
};
enum { IN_X = 0, IN_NORMS, IN_WGU, IN_WD, IN_EWIN, IN_EWOUT, IN_LAM, IN_SUBLN, IN_MU, IN_VEC, IN_WUP, IN_AUP, IN_GUP, IN_V0, IN_VDOWN, IN_VUP, IN_OWIN, IN_OWOUT };

DI void transpose_item(const float* W, int K, int N, bf16_t* WT, int mode, const float* gain, int sc_lo, int sc_hi, float sc, LAS float* scr, int item, int lane) {
  const int nblk = N / 32, kb = item / nblk, nb = item % nblk, k0 = 64 * kb, n0 = 32 * nb;
  const float cs = (n0 >= sc_lo && n0 < sc_hi) ? sc : 1.f;
#pragma unroll
  for (int i = 0; i < 8; ++i) { const int kk = 8 * i + (lane >> 3), n4 = (lane & 7) * 4; const float gk = gain ? gain[k0 + kk] * cs : cs;
    const f32x4 v = __builtin_nontemporal_load((const f32x4*)(W + (size_t)(k0 + kk) * N + n0 + n4)) * gk;
    LAS float* d = scr + kk * 33 + n4; d[0] = v.x; d[1] = v.y; d[2] = v.z; d[3] = v.w; }
  asm volatile("s_waitcnt lgkmcnt(0)" ::: "memory");
  int d0 = n0;
  if (mode & 1) d0 = (n0 < DFF) ? 256 * (n0 / 128) + (n0 % 128) : 256 * ((n0 - DFF) / 128) + 128 + ((n0 - DFF) % 128);
  const int c = lane & 7;
#pragma unroll
  for (int j = 0; j < 4; ++j) { const int n = (lane >> 3) + 8 * j; const LAS float* s = scr + (8 * c) * 33 + n;
    u32x4 o; o.x = cvtpk(s[0 * 33], s[1 * 33]); o.y = cvtpk(s[2 * 33], s[3 * 33]); o.z = cvtpk(s[4 * 33], s[5 * 33]); o.w = cvtpk(s[6 * 33], s[7 * 33]);
    if (mode & 2) __builtin_nontemporal_store(o, (u32x4*)(WT + (size_t)(d0 + n) * K + k0 + 8 * c));
    else *(u32x4*)(WT + (size_t)(d0 + n) * K + k0 + 8 * c) = o; }
  asm volatile("s_waitcnt lgkmcnt(0)" ::: "memory");
}

DI void convert_layer(const Ctx& c, const Args& a, int L) {
  LAS float* scr = (LAS float*)(c.lds + c.wave * 16384);
  const int gw = c.bid * NWAVES + c.wave, NGW = c.G * NWAVES;
  const bool even = (L & 1) == 0; const int j = L >> 1;
  const float* norms = a.in[c.z + IN_NORMS] + (size_t)L * 6 * DM;
  const float* wgu0 = a.in[c.z + IN_WGU] + (size_t)(L * 2 + 0) * DM * 2 * DFF; const float* wgu1 = a.in[c.z + IN_WGU] + (size_t)(L * 2 + 1) * DM * 2 * DFF;
  const float* wd0 = a.in[c.z + IN_WD] + (size_t)(L * 2 + 0) * DFF * DM; const float* wd1 = a.in[c.z + IN_WD] + (size_t)(L * 2 + 1) * DFF * DM;
  const float* win = even ? a.in[c.z + IN_EWIN] + (size_t)j * DM * EVEN_IN : a.in[c.z + IN_OWIN] + (size_t)j * DM * ODD_IN;
  const float* wout = even ? a.in[c.z + IN_EWOUT] + (size_t)j * DM * DM : a.in[c.z + IN_OWOUT] + (size_t)j * 2048 * DM;
  const int NIN = even ? EVEN_IN : ODD_IN, KOUT = even ? DM : 2048;
  const int I_GU = (DM / 64) * (2 * DFF / 32), I_D = (DFF / 64) * (DM / 32), I_IN = (DM / 64) * (NIN / 32), I_OUT = (KOUT / 64) * (DM / 32);
  const int NIT = 2 * I_GU + 2 * I_D + I_IN + I_OUT;
  bf16_t* WGU0 = (bf16_t*)(c.ws + WS_WGU0); bf16_t* WGU1 = (bf16_t*)(c.ws + WS_WGU1); bf16_t* WD0 = (bf16_t*)(c.ws + WS_WD0); bf16_t* WD1 = (bf16_t*)(c.ws + WS_WD1);
  bf16_t* WIN = (bf16_t*)(c.ws + WS_WIN); bf16_t* WOUT = (bf16_t*)(c.ws + WS_WOUT);
  if (even) {
    bf16_t* WUPT = (bf16_t*)(c.ws + WS_LORA); bf16_t* AUPT = WUPT + 512 * 64; bf16_t* GUPT = AUPT + 512 * 64; bf16_t* VDT = GUPT + 512 * 128; bf16_t* VUPT = VDT + 32 * 512;
    const float* w_up = a.in[c.z + IN_WUP] + (size_t)j * 64 * 512; const float* a_up = a.in[c.z + IN_AUP] + (size_t)j * 64 * 512; const float* g_up = a.in[c.z + IN_GUP] + (size_t)j * 128 * 512;
    const int NS = 16 + 16 + 32 + (j > 0 ? 8 : 0);
    for (int it = gw; it < NS; it += NGW) {
      int r = it;
      if (r < 16) { transpose_item(w_up, 64, 512, WUPT, 0, nullptr, 0, 0, 1.f, scr, r, c.lane); continue; } r -= 16;
      if (r < 16) { transpose_item(a_up, 64, 512, AUPT, 0, nullptr, 0, 0, 1.f, scr, r, c.lane); continue; } r -= 16;
      if (r < 32) { transpose_item(g_up, 128, 512, GUPT, 0, nullptr, 0, 0, 1.f, scr, r, c.lane); continue; } r -= 32;
      transpose_item(a.in[c.z + IN_VDOWN] + (size_t)(j - 1) * 512 * 32, 512, 32, VDT, 0, nullptr, 0, 0, 1.f, scr, r, c.lane);
    }
    if (j > 0) { const float* v_up = a.in[c.z + IN_VUP] + (size_t)(j - 1) * 32 * 512;
      for (int e = c.bid * NTHR + c.tid; e < 32 * 512; e += c.G * NTHR) { const int n = e >> 5, k = e & 31; VUPT[e] = f2bf(v_up[(size_t)k * 512 + n]); } }
  }
  for (int it = gw; it < NIT; it += NGW) {
    int r = it;
    if (r < I_GU) { transpose_item(wgu0, DM, 2 * DFF, WGU0, 1, norms + 0 * DM, 0, 0, 1.f, scr, r, c.lane); continue; } r -= I_GU;
    if (r < I_GU) { transpose_item(wgu1, DM, 2 * DFF, WGU1, 3, norms + 4 * DM, 0, 0, 1.f, scr, r, c.lane); continue; } r -= I_GU;
    if (r < I_D) { transpose_item(wd0, DFF, DM, WD0, 0, nullptr, 0, 0, 1.f, scr, r, c.lane); continue; } r -= I_D;
    if (r < I_D) { transpose_item(wd1, DFF, DM, WD1, 2, nullptr, 0, 0, 1.f, scr, r, c.lane); continue; } r -= I_D;
    if (r < I_IN) { transpose_item(win, DM, NIN, WIN, 0, norms + 2 * DM, even ? 0 : 1024, even ? 0 : 2048, 0.0625f, scr, r, c.lane); continue; } r -= I_IN;
    transpose_item(wout, KOUT, DM, WOUT, 2, nullptr, 0, 0, 1.f, scr, r, c.lane);
  }
}

DI f32x4 bf4_to_f(const u32x2 w) { return (f32x4){__uint_as_float(w.x << 16), __uint_as_float(w.x & 0xffff0000u), __uint_as_float(w.y << 16), __uint_as_float(w.y & 0xffff0000u)}; }
DI void rowpass(const Ctx& c, const float* xin, float* xout, const bf16_t* F, const float* gain, float coef) {
  const int gw = c.bid * NWAVES + c.wave, NGW = c.G * NWAVES;
  bf16_t* XB = (bf16_t*)(c.ws + WS_XB); float* RINV = (float*)(c.ws + WS_RINV);
  f32x4 gv[4];
  if (F) {
#pragma unroll
    for (int j = 0; j < 4; ++j) gv[j] = *(const f32x4*)(gain + 512 * (j >> 1) + 8 * c.lane + 4 * (j & 1)) * coef;
  }
  if (xin) {
    for (int row = gw; row < M_TOK; row += NGW) {
      const f32x4* xr = (const f32x4*)(xin + (size_t)row * DM) + c.lane; u32x2* xb = (u32x2*)(XB + (size_t)row * DM) + c.lane;
      float s2 = 0.f;
#pragma unroll
      for (int j = 0; j < 4; ++j) { const f32x4 v = xr[64 * j]; u32x2 w; w.x = cvtpk(v.x, v.y); w.y = cvtpk(v.z, v.w); xb[64 * j] = w;
        const f32x4 q = bf4_to_f(w); s2 += (q.x * q.x + q.y * q.y) + (q.z * q.z + q.w * q.w); }
      s2 = wave_sum(s2);
      if (c.lane == 0) RINV[row] = __builtin_amdgcn_rsqf(s2 * (1.f / DM) + NORM_EPS);
    }
    return;
  }
  u32x4 xc[2], fc[2];
  { const u32x4* xb = (const u32x4*)(XB + (size_t)gw * DM) + c.lane; const u32x4* fr = (const u32x4*)(F + (size_t)gw * DM) + c.lane;
#pragma unroll
    for (int p = 0; p < 2; ++p) { xc[p] = xb[64 * p]; fc[p] = __builtin_nontemporal_load(fr + 64 * p); } }
#pragma unroll 1
  for (int row = gw; row < M_TOK; row += NGW) {
    const int nrow = row + NGW; u32x4 xn[2], fn[2];
    if (nrow < M_TOK) { const u32x4* xb = (const u32x4*)(XB + (size_t)nrow * DM) + c.lane; const u32x4* fr = (const u32x4*)(F + (size_t)nrow * DM) + c.lane;
#pragma unroll
      for (int p = 0; p < 2; ++p) { xn[p] = xb[64 * p]; fn[p] = __builtin_nontemporal_load(fr + 64 * p); } }
    else {
#pragma unroll
      for (int p = 0; p < 2; ++p) { xn[p] = xc[p]; fn[p] = fc[p]; } }
    f32x4 v[4], f[4]; float ss = 0.f;
#pragma unroll
    for (int p = 0; p < 2; ++p) { v[2 * p] = bf4_to_f((u32x2){xc[p].x, xc[p].y}); v[2 * p + 1] = bf4_to_f((u32x2){xc[p].z, xc[p].w});
      f[2 * p] = bf4_to_f((u32x2){fc[p].x, fc[p].y}); f[2 * p + 1] = bf4_to_f((u32x2){fc[p].z, fc[p].w}); }
#pragma unroll
    for (int j = 0; j < 4; ++j) ss += (f[j].x * f[j].x + f[j].y * f[j].y) + (f[j].z * f[j].z + f[j].w * f[j].w);
    const float r = __builtin_amdgcn_rsqf(wave_sum(ss) * (1.f / DM) + NORM_EPS);
#pragma unroll
    for (int j = 0; j < 4; ++j) v[j] = v[j] + f[j] * gv[j] * r;
    if (xout) { f32x4* xo = (f32x4*)(xout + (size_t)row * DM) + 2 * c.lane;
#pragma unroll
      for (int j = 0; j < 4; ++j) __builtin_nontemporal_store(v[j], xo + 128 * (j >> 1) + (j & 1)); }
    else {
      u32x4* xb = (u32x4*)(XB + (size_t)row * DM) + c.lane;
      float s2 = 0.f;
#pragma unroll
      for (int p = 0; p < 2; ++p) { u32x4 w; w.x = cvtpk(v[2 * p].x, v[2 * p].y); w.y = cvtpk(v[2 * p].z, v[2 * p].w); w.z = cvtpk(v[2 * p + 1].x, v[2 * p + 1].y); w.w = cvtpk(v[2 * p + 1].z, v[2 * p + 1].w); xb[64 * p] = w;
        const f32x4 q0 = bf4_to_f((u32x2){w.x, w.y}), q1 = bf4_to_f((u32x2){w.z, w.w});
        s2 += (q0.x * q0.x + q0.y * q0.y) + (q0.z * q0.z + q0.w * q0.w) + (q1.x * q1.x + q1.y * q1.y) + (q1.z * q1.z + q1.w * q1.w); }
      s2 = wave_sum(s2);
      if (c.lane == 0) RINV[row] = __builtin_amdgcn_rsqf(s2 * (1.f / DM) + NORM_EPS);
    }
#pragma unroll
    for (int p = 0; p < 2; ++p) { xc[p] = xn[p]; fc[p] = fn[p]; }
  }
}

DI f32x4 ld_bf4(const bf16_t* p) { const u32x2 w = *(const u32x2*)p; return (f32x4){__uint_as_float(w.x << 16), __uint_as_float(w.x & 0xffff0000u), __uint_as_float(w.y << 16), __uint_as_float(w.y & 0xffff0000u)}; }
DI void st_bf4(bf16_t* p, f32x4 v) { u32x2 w; w.x = cvtpk(v.x, v.y); w.y = cvtpk(v.z, v.w); *(u32x2*)p = w; }
DI f32x4 lds_bf4(const LAS unsigned char* p) { return bf4_to_f(*(const LAS u32x2*)p); }
DI void rwkv_prep(const Ctx& c, const Args& a, int j) {
  const bf16_t* Z = (const bf16_t*)(c.ws + WS_ZEVEN);
  bf16_t* RW = (bf16_t*)(c.ws + WS_RW);
  bf16_t* VF = (bf16_t*)(c.ws + WS_VFIRST);
  const bf16_t* WUPT = (const bf16_t*)(c.ws + WS_LORA); const bf16_t* AUPT = WUPT + 512 * 64; const bf16_t* GUPT = AUPT + 512 * 64;
  const bf16_t* VDT = GUPT + 512 * 128; const bf16_t* VUPT = VDT + 32 * 512;
  const float* mu = a.in[c.z + IN_MU] + (size_t)j * 1792;
  const float* vec = a.in[c.z + IN_VEC] + (size_t)j * 7 * 512;
  const bool vres = j > 0;
  const float* v0p = a.in[c.z + IN_V0] + (size_t)(j > 0 ? j - 1 : 0) * 512;
  constexpr int ZS = 3600, XS = 528, VS = 1040, US = 80;
  LAS unsigned char* zst0 = c.lds; LAS unsigned char* xsb = c.lds + 122880; LAS unsigned char* vsb = c.lds + 131328; LAS unsigned char* ub = c.lds + 147968;
  const int tid = c.tid, lane = c.lane, w = c.wave, l15 = lane & 15, quad = lane >> 4;
  u32x4 pz[8];
  auto zissue = [&](int u) { const int t0 = u * 16; const bool first = (t0 % SEQ) == 0;
#pragma unroll
    for (int i = 0; i < 8; ++i) { const int id = tid + 512 * i; pz[i] = (u32x4){0u, 0u, 0u, 0u};
      if (id < 17 * 224) { const int row = id / 224, ch = id - row * 224;
        if (!(first && row == 0)) pz[i] = *(const u32x4*)(Z + (size_t)(t0 - 1 + row) * EVEN_IN + 1536 + ch * 8); } } };
  auto zstash = [&](LAS unsigned char* zb) {
#pragma unroll
    for (int i = 0; i < 8; ++i) { const int id = tid + 512 * i;
      if (id < 17 * 224) { const int row = id / 224, ch = id - row * 224; *(LAS u32x4*)(zb + row * ZS + ch * 16) = pz[i]; } } };
  int ui = 0;
  if (c.bid < M_TOK / 16) { zissue(c.bid); __syncthreads(); zstash(zst0); }
  for (int u = c.bid; u < M_TOK / 16; u += c.G, ++ui) {
    const int t0 = u * 16;
    LAS unsigned char* zst = zst0 + (ui & 1) * 61440;
    __syncthreads();
    const bool has_next = u + c.G < M_TOK / 16;
    if (has_next) zissue(u + c.G);
    {
      const int cc = tid & 255, tg = tid >> 8; const float m = mu[1536 + cc];
#pragma unroll
      for (int i = 0; i < 8; ++i) { const int tok = tg * 8 + i;
        const float cur = bf2f(*(const LAS bf16_t*)(zst + (1 + tok) * ZS + (1536 + cc) * 2)), prev = bf2f(*(const LAS bf16_t*)(zst + tok * ZS + (1536 + cc) * 2));
        const float zs = cur + (prev - cur) * m;
        const float val = cc < 64 ? tanhf_(zs) : (cc < 128 ? zs : sigmoidf_(zs)); *(LAS bf16_t*)(xsb + tok * XS + cc * 2) = f2bf(val); }
    }
    __syncthreads();
    const int t = t0 + l15;
    const LAS unsigned char* xr = xsb + l15 * XS + quad * 16;
    const LAS unsigned char* zc = zst + (1 + l15) * ZS; const LAS unsigned char* zp = zst + l15 * ZS;
    float ss = 0.f;
#pragma unroll 2
    for (int ct = 0; ct < 4; ++ct) {
      const int col = 64 * w + 16 * ct + 4 * quad;
      const size_t wr = (size_t)(64 * w + 16 * ct + l15);
      f32x4 x = {0.f, 0.f, 0.f, 0.f}, z = x;
#pragma unroll
      for (int ks = 0; ks < 2; ++ks) x = MFMA16(*(const bf16x8*)(WUPT + wr * 64 + 32 * ks + 8 * quad), *(const LAS bf16x8*)(xr + ks * 64), x);
#pragma unroll
      for (int ks = 0; ks < 4; ++ks) z = MFMA16(*(const bf16x8*)(GUPT + wr * 128 + 32 * ks + 8 * quad), *(const LAS bf16x8*)(xr + 256 + ks * 64), z);
      const f32x4 cr = lds_bf4(zc + col * 2), ck = lds_bf4(zc + (512 + col) * 2), cv = lds_bf4(zc + (1024 + col) * 2);
      const f32x4 pr = lds_bf4(zp + col * 2), pk = lds_bf4(zp + (512 + col) * 2), pv = lds_bf4(zp + (1024 + col) * 2);
      const f32x4 mr = *(const f32x4*)(mu + col), mk = *(const f32x4*)(mu + 512 + col), mv = *(const f32x4*)(mu + 1024 + col);
      const f32x4 w0 = *(const f32x4*)(vec + col), k_k = *(const f32x4*)(vec + 1024 + col);
      const f32x4 rr = cr + (pr - cr) * mr, k1 = ck + (pk - ck) * mk, vv = cv + (pv - cv) * mv;
      f32x4 ew;
#pragma unroll
      for (int e = 0; e < 4; ++e) ew[e] = 0.60653065971f * sigmoidf_(w0[e] + x[e]);
      const f32x4 kkr = k1 * k_k; ss += (kkr.x * kkr.x + kkr.y * kkr.y) + (kkr.z * kkr.z + kkr.w * kkr.w);
      const size_t o = (size_t)t * 512 + col;
      st_bf4(RW + 0 * RW_STRIDE + o, ew); st_bf4(RW + 4 * RW_STRIDE + o, rr); st_bf4(RW + 6 * RW_STRIDE + o, z);
      if (!vres) { st_bf4(RW + 5 * RW_STRIDE + o, vv); st_bf4(VF + o, vv); }
      else { u32x2 wv; wv.x = cvtpk(vv.x, vv.y); wv.y = cvtpk(vv.z, vv.w); *(LAS u32x2*)(vsb + l15 * VS + col * 2) = wv; }
    }
    ss += __shfl_xor(ss, 16); ss += __shfl_xor(ss, 32);
    const float rinv = 1.f / fmaxf(sqrtf(ss), 1e-12f);
#pragma unroll 2
    for (int ct = 0; ct < 4; ++ct) {
      const int col = 64 * w + 16 * ct + 4 * quad;
      const size_t wr = (size_t)(64 * w + 16 * ct + l15);
      f32x4 y = {0.f, 0.f, 0.f, 0.f};
#pragma unroll
      for (int ks = 0; ks < 2; ++ks) y = MFMA16(*(const bf16x8*)(AUPT + wr * 64 + 32 * ks + 8 * quad), *(const LAS bf16x8*)(xr + 128 + ks * 64), y);
      const f32x4 ck = lds_bf4(zc + (512 + col) * 2), pk = lds_bf4(zp + (512 + col) * 2);
      const f32x4 mk = *(const f32x4*)(mu + 512 + col), a0 = *(const f32x4*)(vec + 512 + col);
      const f32x4 k_k = *(const f32x4*)(vec + 1024 + col), k_a = *(const f32x4*)(vec + 1536 + col);
      const f32x4 k1 = ck + (pk - ck) * mk;
      f32x4 a1;
#pragma unroll
      for (int e = 0; e < 4; ++e) a1[e] = sigmoidf_(a0[e] + y[e]);
      const f32x4 kk = k1 * k_k * rinv;
      const f32x4 kmod = k1 * (1.f + (a1 - 1.f) * k_a);
      const size_t o = (size_t)t * 512 + col;
      st_bf4(RW + 1 * RW_STRIDE + o, kk); st_bf4(RW + 2 * RW_STRIDE + o, kk * a1); st_bf4(RW + 3 * RW_STRIDE + o, kmod);
    }
    if (vres) {
      __syncthreads();
      if (w < 2) { const int mt = w; f32x4 acc = {0.f, 0.f, 0.f, 0.f};
#pragma unroll 4
        for (int ks = 0; ks < 16; ++ks) acc = MFMA16(*(const bf16x8*)(VDT + (size_t)(16 * mt + l15) * 512 + 32 * ks + 8 * quad), *(const LAS bf16x8*)(vsb + l15 * VS + (32 * ks + 8 * quad) * 2), acc);
        u32x2 wv; wv.x = cvtpk(acc.x, acc.y); wv.y = cvtpk(acc.z, acc.w); *(LAS u32x2*)(ub + l15 * US + (16 * mt + 4 * quad) * 2) = wv; }
      __syncthreads();
#pragma unroll 2
      for (int ct = 0; ct < 4; ++ct) {
        const int col = 64 * w + 16 * ct + 4 * quad;
        const bf16x8 fu = *(const bf16x8*)(VUPT + (size_t)(64 * w + 16 * ct + l15) * 32 + 8 * quad);
        const f32x4 v0 = *(const f32x4*)(v0p + col);
        f32x4 sacc = {0.f, 0.f, 0.f, 0.f};
        sacc = MFMA16(fu, *(const LAS bf16x8*)(ub + l15 * US + quad * 16), sacc);
        const size_t o = (size_t)t * 512 + col;
        const f32x4 vv = lds_bf4(vsb + l15 * VS + col * 2);
        const f32x4 vf = ld_bf4(VF + o); f32x4 r;
#pragma unroll
        for (int e = 0; e < 4; ++e) r[e] = vv[e] + (vf[e] - vv[e]) * sigmoidf_(v0[e] + sacc[e]);
        st_bf4(RW + 5 * RW_STRIDE + o, r);
      }
    }
    if (has_next) zstash(zst0 + ((ui + 1) & 1) * 61440);
  }
}

DI void rwkv_scan_item(const Ctx& c, int item) {
  const int bh = item >> 1, half = item & 1, b = bh >> 3, h = bh & 7;
  const bf16_t* RW = (const bf16_t*)(c.ws + WS_RW);
  bf16_t* MIX = (bf16_t*)(c.ws + WS_MIXE);
  const int tid = c.tid, lane = c.lane, rg8 = lane >> 3, c8 = lane & 7, row = (c.wave & 3) * 8 + rg8;
  constexpr int BUF_F = 32 * 320 + 32 * 32;
  LAS float* buf0 = (LAS float*)c.lds;
  LAS float* ybuf = (LAS float*)c.lds + 2 * BUF_F;
  const size_t tokbase = (size_t)b * SEQ;
  const int i2 = tid & 255;
  const int l_step = i2 >> 3, l_c8 = i2 & 7, l_arr = tid >> 8;
  const bf16_t* src01 = RW + (size_t)l_arr * RW_STRIDE + (tokbase + l_step) * 512 + h * 64 + l_c8 * 8;
  const int vid = tid - 256;
  const bf16_t* srcv = RW + 5 * RW_STRIDE + (tokbase + ((vid >> 2) & 31)) * 512 + h * 64 + half * 32 + (vid & 3) * 8;
  bf16x8 p0, p1, p2;
  auto issue = [&](int ch) {
    const size_t off = (size_t)ch * 32 * 512;
    p0 = *(const bf16x8*)(src01 + off); p1 = *(const bf16x8*)(src01 + 2 * RW_STRIDE + off);
    if (tid < 256) p2 = *(const bf16x8*)(src01 + 4 * RW_STRIDE + off);
    else if (tid < 384) p2 = *(const bf16x8*)(srcv + off);
  };
  auto stash = [&](int bsel) {
    LAS float* B = buf0 + bsel * BUF_F;
    float f[8];
    { unpack8(p0, f); LAS float* d = B + l_step * 320 + l_arr * 64 + l_c8 * 8;
      if (l_arr == 0) {
#pragma unroll
        for (int e = 0; e < 8; ++e) f[e] = __builtin_amdgcn_exp2f(-f[e] * LOG2E);
      } else {
#pragma unroll
        for (int e = 0; e < 8; ++e) f[e] = -f[e];
      }
      *(LAS f32x4*)d = (f32x4){f[0], f[1], f[2], f[3]}; *(LAS f32x4*)(d + 4) = (f32x4){f[4], f[5], f[6], f[7]}; }
    { unpack8(p1, f); LAS float* d = B + l_step * 320 + (l_arr + 2) * 64 + l_c8 * 8;
      *(LAS f32x4*)d = (f32x4){f[0], f[1], f[2], f[3]}; *(LAS f32x4*)(d + 4) = (f32x4){f[4], f[5], f[6], f[7]}; }
    if (tid < 256) { unpack8(p2, f); LAS float* d = B + l_step * 320 + 4 * 64 + l_c8 * 8;
      *(LAS f32x4*)d = (f32x4){f[0], f[1], f[2], f[3]}; *(LAS f32x4*)(d + 4) = (f32x4){f[4], f[5], f[6], f[7]}; }
    else if (tid < 384) { unpack8(p2, f); LAS float* d = B + 32 * 320 + (vid >> 2) * 32 + (vid & 3) * 8;
      *(LAS f32x4*)d = (f32x4){f[0], f[1], f[2], f[3]}; *(LAS f32x4*)(d + 4) = (f32x4){f[4], f[5], f[6], f[7]}; }
  };
  __syncthreads();
  issue(0); stash(0);
  if (1 < SEQ / 32) issue(1);
  __syncthreads();
  f32x2 S0 = {0.f, 0.f}, S1 = {0.f, 0.f}, S2 = {0.f, 0.f}, S3 = {0.f, 0.f};
#pragma unroll 1
  for (int ch = 0; ch < SEQ / 32; ++ch) {
    if (ch + 1 < SEQ / 32) stash((ch + 1) & 1);
    if (ch + 2 < SEQ / 32) issue(ch + 2);
    LAS float* yb = ybuf + (ch & 1) * 1024;
    if (c.wave < 4) {
      const LAS float* B = buf0 + (ch & 1) * BUF_F;
      const LAS float* Lb = B + c8 * 8; const LAS float* Vb = B + 32 * 320 + row;
      float yk0 = 0.f, yk1 = 0.f, yk2 = 0.f, yk3 = 0.f, up = 0.f;
      f32x4 dw0 = *(const LAS f32x4*)(Lb), dw1 = *(const LAS f32x4*)(Lb + 4), nk0 = *(const LAS f32x4*)(Lb + 64), nk1 = *(const LAS f32x4*)(Lb + 68), ka0 = *(const LAS f32x4*)(Lb + 128), ka1 = *(const LAS f32x4*)(Lb + 132),
            kv0 = *(const LAS f32x4*)(Lb + 192), kv1 = *(const LAS f32x4*)(Lb + 196), rv0 = *(const LAS f32x4*)(Lb + 256), rv1 = *(const LAS f32x4*)(Lb + 260);
      float vv = Vb[0];
#define LO(v) ((f32x2){(v).x, (v).y})
#define HI(v) ((f32x2){(v).z, (v).w})
#pragma unroll
      for (int s = 0; s < 32; ++s) {
        f32x4 dw0n = dw0, dw1n = dw1, nk0n = nk0, nk1n = nk1, ka0n = ka0, ka1n = ka1, kv0n = kv0, kv1n = kv1, rv0n = rv0, rv1n = rv1; float vvn = vv;
        if (s + 1 < 32) { const LAS float* L = Lb + (s + 1) * 320;
          dw0n = *(const LAS f32x4*)(L); dw1n = *(const LAS f32x4*)(L + 4); nk0n = *(const LAS f32x4*)(L + 64); nk1n = *(const LAS f32x4*)(L + 68); ka0n = *(const LAS f32x4*)(L + 128); ka1n = *(const LAS f32x4*)(L + 132);
          kv0n = *(const LAS f32x4*)(L + 192); kv1n = *(const LAS f32x4*)(L + 196); rv0n = *(const LAS f32x4*)(L + 256); rv1n = *(const LAS f32x4*)(L + 260);
          vvn = Vb[(s + 1) * 32]; }
        __builtin_amdgcn_sched_barrier(0);
        f32x2 t = S0 * LO(nk0); t = S1 * HI(nk0) + t; t = S2 * LO(nk1) + t; t = S3 * HI(nk1) + t;
        const f32x2 tk0 = LO(kv0) * vv, tk1 = HI(kv0) * vv, tk2 = LO(kv1) * vv, tk3 = HI(kv1) * vv;
        float sa = t.x + t.y, yq = up;
        sa += dppf<0xB1>(sa); yq += dppf<0xB1>(yq);
        sa += dppf<0x4E>(sa); yq += dppf<0x4E>(yq);
        sa += dppf<0x141>(sa); yq += dppf<0x141>(yq);
        if (s >= 1) { const int sp = s - 1;
          if (sp < 8) yk0 = (c8 == sp) ? yq : yk0; else if (sp < 16) yk1 = (c8 == sp - 8) ? yq : yk1; else if (sp < 24) yk2 = (c8 == sp - 16) ? yq : yk2; else yk3 = (c8 == sp - 24) ? yq : yk3; }
        S0 = S0 * LO(dw0) + tk0; S1 = S1 * HI(dw0) + tk1; S2 = S2 * LO(dw1) + tk2; S3 = S3 * HI(dw1) + tk3;
        S0 = LO(ka0) * sa + S0; S1 = HI(ka0) * sa + S1; S2 = LO(ka1) * sa + S2; S3 = HI(ka1) * sa + S3;
        f32x2 u = S0 * LO(rv0); u = S1 * HI(rv0) + u; u = S2 * LO(rv1) + u; u = S3 * HI(rv1) + u;
        up = u.x + u.y;
        __builtin_amdgcn_sched_barrier(0);
        dw0 = dw0n; dw1 = dw1n; nk0 = nk0n; nk1 = nk1n; ka0 = ka0n; ka1 = ka1n; kv0 = kv0n; kv1 = kv1n; rv0 = rv0n; rv1 = rv1n; vv = vvn;
      }
#undef LO
#undef HI
      { float yq = up; yq += dppf<0xB1>(yq); yq += dppf<0x4E>(yq); yq += dppf<0x141>(yq); yk3 = (c8 == 7) ? yq : yk3; }
      yb[c8 * 32 + row] = yk0; yb[(8 + c8) * 32 + row] = yk1; yb[(16 + c8) * 32 + row] = yk2; yb[(24 + c8) * 32 + row] = yk3;
    }
    lds_barrier();
    { const int s = tid >> 4, r2 = (tid & 15) * 2; const float y0 = yb[s * 32 + r2], y1 = yb[s * 32 + r2 + 1];
      *(unsigned*)(MIX + (tokbase + ch * 32 + s) * 1024 + 512 + h * 64 + half * 32 + r2) = cvtpk(y0, y1); }
  }
}

DI float wave_max(float v) {
#pragma unroll
  for (int o = 1; o < 64; o <<= 1) v = fmaxf(v, __shfl_xor(v, o));
  return v;
}
DI float wave_min(float v) {
#pragma unroll
  for (int o = 1; o < 64; o <<= 1) v = fminf(v, __shfl_xor(v, o));
  return v;
}
DI void attn_knorm(const Ctx& c) {
  const bf16_t* Z = (const bf16_t*)(c.ws + WS_ZEVEN); float* KN = (float*)(c.ws + WS_KN);
  const int gw = c.bid * NWAVES + c.wave, NGW = c.G * NWAVES;
  for (int item = gw; item < 32 * 64; item += NGW) {
    const int bh = item >> 6, tile = item & 63, b = bh >> 2, h = bh & 3;
    const bf16_t* p = Z + (size_t)(b * SEQ + tile * 64 + c.lane) * EVEN_IN + 512 + h * 128;
    float s0 = 0.f, s1 = 0.f;
#pragma unroll
    for (int i = 0; i < 8; ++i) { float f[8], g[8]; unpack8(*(const bf16x8*)(p + i * 8), f); unpack8(*(const bf16x8*)(p + 64 + i * 8), g);
#pragma unroll
      for (int e = 0; e < 8; ++e) { s0 += f[e] * f[e]; s1 += g[e] * g[e]; } }
    const float m0 = wave_max(sqrtf(s0)), m1 = wave_max(sqrtf(s1));
    if (c.lane == 0) { KN[(bh * 2 + 0) * 64 + tile] = m0; KN[(bh * 2 + 1) * 64 + tile] = m1; }
  }
}

DI float xrow_max(float v) {
  auto a = __builtin_amdgcn_permlane16_swap(__float_as_uint(v), __float_as_uint(v), false, false);
  v = fmaxf(__uint_as_float(a[0]), __uint_as_float(a[1]));
  auto b = __builtin_amdgcn_permlane32_swap(__float_as_uint(v), __float_as_uint(v), false, false);
  return fmaxf(__uint_as_float(b[0]), __uint_as_float(b[1]));
}
DI float xrow_sum(float v) {
  auto a = __builtin_amdgcn_permlane16_swap(__float_as_uint(v), __float_as_uint(v), false, false);
  v = __uint_as_float(a[0]) + __uint_as_float(a[1]);
  auto b = __builtin_amdgcn_permlane32_swap(__float_as_uint(v), __float_as_uint(v), false, false);
  return __uint_as_float(b[0]) + __uint_as_float(b[1]);
}
DI void attn_unit(const Ctx& c, const Args& a, int j, int b, int h, int c2, float lam, float lam_init) {
  const bf16_t* Z = (const bf16_t*)(c.ws + WS_ZEVEN) + (size_t)b * SEQ * EVEN_IN;
  bf16_t* MIX = (bf16_t*)(c.ws + WS_MIXE) + (size_t)b * SEQ * 1024;
  const float* subln = a.in[c.z + IN_SUBLN] + (size_t)j * 128;
  const int tid = c.tid, lane = c.lane, wave = c.wave, l15 = lane & 15, quad = lane >> 4, q_ = l15 >> 2, p_ = l15 & 3;
  const int q0 = 128 * c2 + 16 * wave, my_chunk = 2 * c2 + (wave >> 2), nkt = 2 * c2 + 2;
  constexpr int RS = 288, IMG = 64 * RS, BUFB = 2 * IMG;
  constexpr float QSC = 0.125f * LOG2E;
  LAS unsigned char* qlds = c.lds + 2 * BUFB + wave * 4096 + lane * 16;
  LAS float* red = (LAS float*)(c.lds + 2 * BUFB + 32768);
  const float* KN = (const float*)(c.ws + WS_KN) + (size_t)((b * 4 + h) * 2) * 64;
  float qpart[2] = {0.f, 0.f};
#pragma unroll
  for (int m = 0; m < 2; ++m)
#pragma unroll
    for (int ks = 0; ks < 2; ++ks) { const bf16x8 raw = *(const bf16x8*)(Z + (size_t)(q0 + l15) * EVEN_IN + h * 128 + m * 64 + ks * 32 + quad * 8);
      float f[8]; unpack8(raw, f);
#pragma unroll
      for (int e = 0; e < 8; ++e) qpart[m] += (f[e] * QSC) * (f[e] * QSC);
      u32x4 w; w.x = cvtpk(f[0] * QSC, f[1] * QSC); w.y = cvtpk(f[2] * QSC, f[3] * QSC); w.z = cvtpk(f[4] * QSC, f[5] * QSC); w.w = cvtpk(f[6] * QSC, f[7] * QSC);
      *(LAS u32x4*)(qlds + (m * 2 + ks) * 1024) = w; }
  f32x4 o[2][8];
#pragma unroll
  for (int m = 0; m < 2; ++m)
#pragma unroll
    for (int d = 0; d < 8; ++d) o[m][d] = (f32x4){0.f, 0.f, 0.f, 0.f};
  float mrun[2] = {-1e30f, -1e30f}, lrun[2] = {0.f, 0.f};
  const float slope2 = __builtin_amdgcn_exp2f(-2.f * (float)(h + 1)) * LOG2E;
  u32x4 pf[4];
  const int prow = tid >> 4, pc16 = tid & 15;
  const bf16_t* ksrc = Z + (size_t)prow * EVEN_IN + 512 + h * 128 + pc16 * 8;
  auto issue = [&](int kt) {
    const bf16_t* s = ksrc + (size_t)kt * 64 * EVEN_IN;
    pf[0] = *(const u32x4*)(s); pf[1] = *(const u32x4*)(s + (size_t)32 * EVEN_IN);
    pf[2] = *(const u32x4*)(s + 512); pf[3] = *(const u32x4*)(s + (size_t)32 * EVEN_IN + 512);
  };
  auto stash = [&](int bsel) {
    LAS unsigned char* B = c.lds + bsel * BUFB + prow * RS + pc16 * 16;
    *(LAS u32x4*)(B) = pf[0]; *(LAS u32x4*)(B + 32 * RS) = pf[1]; *(LAS u32x4*)(B + IMG) = pf[2]; *(LAS u32x4*)(B + IMG + 32 * RS) = pf[3];
  };
  issue(nkt - 1); stash(0);
  { const float w0 = wave_max(sqrtf(xrow_sum(qpart[0]))), w1 = wave_max(sqrtf(xrow_sum(qpart[1]))); if (lane == 0) { red[wave * 2] = w0; red[wave * 2 + 1] = w1; } }
  __syncthreads();
  int n_iter = nkt;
#pragma unroll 1
  for (int it = 0; it < n_iter; ++it) {
    const int kt = nkt - 1 - it;
    const bool has_next = it + 1 < n_iter;
    if (has_next) issue(kt - 1);
    if (kt <= my_chunk) {
      const LAS unsigned char* Kb = c.lds + (it & 1) * BUFB; const LAS unsigned char* Vb = Kb + IMG;
      float sl = slope2; asm volatile("" : "+v"(sl));
      const float db = (float)(q0 + l15 - 64 * kt - 4 * quad), atile = -sl * db;
      bf16x8 pfr[2][2]; bool live = false;
#pragma unroll
      for (int m = 0; m < 2; ++m) {
        f32x4 s[4];
#pragma unroll
        for (int t16 = 0; t16 < 4; ++t16) { const float r0 = sl * (float)(16 * t16); f32x4 acc = {r0, r0 + sl, r0 + 2.f * sl, r0 + 3.f * sl};
#pragma unroll
          for (int ks = 0; ks < 2; ++ks) { const bf16x8 kf = *(const LAS bf16x8*)(Kb + (16 * t16 + l15) * RS + (m * 64 + ks * 32 + quad * 8) * 2); acc = MFMA16(kf, *(const LAS bf16x8*)(qlds + (m * 2 + ks) * 1024), acc); }
          s[t16] = acc; }
        if (kt >= 2 * c2) {
#pragma unroll
          for (int t16 = 0; t16 < 4; ++t16)
#pragma unroll
            for (int e = 0; e < 4; ++e) s[t16][e] -= 2.f * sl * fmaxf((float)(16 * t16 + e) - db, 0.f);
        }
        float mx = fmaxf(fmaxf(s[0][0], s[0][1]), fmaxf(s[0][2], s[0][3]));
#pragma unroll
        for (int t16 = 1; t16 < 4; ++t16) mx = fmaxf(mx, fmaxf(fmaxf(s[t16][0], s[t16][1]), fmaxf(s[t16][2], s[t16][3])));
        const float mt = xrow_max(mx + atile);
        if (__any(mt > mrun[m] - 32.f)) {
          live = true;
          const float mnew = fmaxf(mrun[m], mt), alpha = __builtin_amdgcn_exp2f(mrun[m] - mnew), shift = mnew - atile; mrun[m] = mnew;
          float ps = 0.f;
#pragma unroll
          for (int t16 = 0; t16 < 4; ++t16)
#pragma unroll
            for (int e = 0; e < 4; ++e) { const float p = __builtin_amdgcn_exp2f(s[t16][e] - shift); s[t16][e] = p; ps += p; }
          lrun[m] = lrun[m] * alpha + ps;
          if (__any(alpha != 1.f)) {
#pragma unroll
            for (int d = 0; d < 8; ++d) o[m][d] = o[m][d] * alpha;
          }
#pragma unroll
          for (int s2 = 0; s2 < 2; ++s2) { u32x4 w; w.x = cvtpk(s[2 * s2][0], s[2 * s2][1]); w.y = cvtpk(s[2 * s2][2], s[2 * s2][3]);
            w.z = cvtpk(s[2 * s2 + 1][0], s[2 * s2 + 1][1]); w.w = cvtpk(s[2 * s2 + 1][2], s[2 * s2 + 1][3]); pfr[m][s2] = __builtin_bit_cast(bf16x8, w); }
        } else { pfr[m][0] = (bf16x8){0, 0, 0, 0, 0, 0, 0, 0}; pfr[m][1] = pfr[m][0]; }
      }
      if (live) {
#pragma unroll
        for (int s2 = 0; s2 < 2; ++s2)
#pragma unroll
          for (int d = 0; d < 8; ++d) {
            const LAS unsigned char* vp = Vb + (32 * s2 + 4 * quad + q_) * RS + (16 * d + 4 * p_) * 2;
            const bf16x8 vf = comb8(tr_read(vp), tr_read(vp + 16 * RS));
            o[0][d] = MFMA16(vf, pfr[0][s2], o[0][d]); o[1][d] = MFMA16(vf, pfr[1][s2], o[1][d]);
          }
      }
    }
    if (has_next) stash((it + 1) & 1);
    const bool prune = (it == 1) && (nkt > 3);
    if (prune) { const float m0 = wave_min(mrun[0]), m1 = wave_min(mrun[1]); if (lane == 0) { red[16 + wave * 2] = m0; red[16 + wave * 2 + 1] = m1; } }
    lds_barrier();
    if (prune) {
      float q0 = red[0], q1 = red[1], mm0 = red[16], mm1 = red[17];
#pragma unroll
      for (int w2 = 1; w2 < 8; ++w2) { q0 = fmaxf(q0, red[2 * w2]); q1 = fmaxf(q1, red[2 * w2 + 1]); mm0 = fminf(mm0, red[16 + 2 * w2]); mm1 = fminf(mm1, red[17 + 2 * w2]); }
      bool need = false;
      if (lane < nkt - 3) { const float dmin = (float)(128 * c2 - 64 * lane - 63);
        need = (q0 * KN[lane] * 1.01f - slope2 * dmin > mm0 - 40.f) || (q1 * KN[64 + lane] * 1.01f - slope2 * dmin > mm1 - 40.f); }
      const unsigned long long bal = __ballot(need);
      const int kt_stop = bal ? (int)__builtin_ctzll(bal) : (nkt - 3);
      n_iter = __builtin_amdgcn_readfirstlane(nkt - kt_stop);
    }
  }
  float inv[2];
#pragma unroll
  for (int m = 0; m < 2; ++m) { float l = xrow_sum(lrun[m]); inv[m] = 1.f / l; }
  const float i1 = lam * inv[1];
  float ss = 0.f;
#pragma unroll
  for (int d = 0; d < 8; ++d)
#pragma unroll
    for (int e = 0; e < 4; ++e) { const float v = o[0][d][e] * inv[0] - o[1][d][e] * i1; o[0][d][e] = v; ss += v * v; }
  ss = xrow_sum(ss);
  const float rn = __builtin_amdgcn_rsqf(ss * (1.f / 128.f) + NORM_EPS) * (1.f - lam_init);
  bf16_t* orow = MIX + (size_t)(q0 + l15) * 1024 + h * 128 + 4 * quad;
#pragma unroll
  for (int d = 0; d < 8; ++d) { const f32x4 g = *(const f32x4*)(subln + 16 * d + 4 * quad);
    u32x2 w; w.x = cvtpk(o[0][d][0] * rn * g.x, o[0][d][1] * rn * g.y); w.y = cvtpk(o[0][d][2] * rn * g.z, o[0][d][3] * rn * g.w);
    *(u32x2*)(orow + 16 * d) = w; }
}

DI void attn_phase(const Ctx& c, const Args& a, int j, int layer, unsigned* counter) {
  const float* lv = a.in[c.z + IN_LAM] + (size_t)j * 4 * 64;
  const float lam_init = 0.8f - 0.6f * __expf(-0.3f * (float)layer);
  const float d1 = wave_sum(lv[c.lane] * lv[64 + c.lane]), d2 = wave_sum(lv[128 + c.lane] * lv[192 + c.lane]);
  const float lam = __expf(d1) - __expf(d2) + lam_init;
  LAS int* qw = (LAS int*)(c.lds + LDS_CTLO + 64);
  const int x = (int)(xb_xcc_id() & 7u);
#define NEXT_ITEM(dst) do { __syncthreads(); if (c.tid == 0) *qw = (int)atomicAdd(counter + q, 1u); __syncthreads(); dst = *qw; } while (0)
  for (int qi = 0; qi < 8; ++qi) { const int q = (x + qi) & 7;
    int item; NEXT_ITEM(item);
    while (item < 16) { rwkv_scan_item(c, (q * 8 + (item >> 1)) * 2 + (item & 1)); NEXT_ITEM(item); }
    while (item < 144) { const int r = item - 16; const int c2 = 31 - (r >> 2), bh = q * 4 + (r & 3);
      attn_unit(c, a, j, bh >> 2, bh & 3, c2, lam, lam_init); NEXT_ITEM(item); }
  }
#undef NEXT_ITEM
}

DI void rwkv_post(const Ctx& c, const Args& a, int j) {
  const bf16_t* RW = (const bf16_t*)(c.ws + WS_RW);
  bf16_t* MIX = (bf16_t*)(c.ws + WS_MIXE);
  const float* vec = a.in[c.z + IN_VEC] + (size_t)j * 7 * 512;
  const int gw = c.bid * NWAVES + c.wave, NGW = c.G * NWAVES, rg = c.lane >> 4, c4 = (c.lane & 15) * 4;
  u32x2 yc, rc, kc, vc, gc;
  { const int p = gw * 4 + rg, t = p >> 3, h = p & 7, cc = h * 64 + c4; const size_t o = (size_t)t * 512 + cc;
    yc = *(const u32x2*)(MIX + (size_t)t * 1024 + 512 + cc); rc = *(const u32x2*)(RW + 4 * RW_STRIDE + o); kc = *(const u32x2*)(RW + 3 * RW_STRIDE + o); vc = *(const u32x2*)(RW + 5 * RW_STRIDE + o); gc = *(const u32x2*)(RW + 6 * RW_STRIDE + o); }
#pragma unroll 1
  for (int p4 = gw; p4 < M_TOK * 2; p4 += NGW) {
    const int p = p4 * 4 + rg, t = p >> 3, h = p & 7, cc = h * 64 + c4;
    u32x2 yn = yc, rn = rc, kn = kc, vn = vc, gn = gc;
    if (p4 + NGW < M_TOK * 2) { const int pq = (p4 + NGW) * 4 + rg, tq = pq >> 3, hq = pq & 7, cq = hq * 64 + c4; const size_t oq = (size_t)tq * 512 + cq;
      yn = *(const u32x2*)(MIX + (size_t)tq * 1024 + 512 + cq); rn = *(const u32x2*)(RW + 4 * RW_STRIDE + oq); kn = *(const u32x2*)(RW + 3 * RW_STRIDE + oq); vn = *(const u32x2*)(RW + 5 * RW_STRIDE + oq); gn = *(const u32x2*)(RW + 6 * RW_STRIDE + oq); }
    bf16_t* mp = MIX + (size_t)t * 1024 + 512 + cc;
    const f32x4 y = bf4_to_f(yc), r = bf4_to_f(rc), k = bf4_to_f(kc), v = bf4_to_f(vc), g = bf4_to_f(gc);
    const f32x4 rk = *(const f32x4*)(vec + 4 * 512 + cc), lw = *(const f32x4*)(vec + 5 * 512 + cc), lb = *(const f32x4*)(vec + 6 * 512 + cc);
    const float mean = row16_sum((y.x + y.y) + (y.z + y.w)) * (1.f / 64.f);
    const f32x4 d = y - mean;
    const float var = row16_sum((d.x * d.x + d.y * d.y) + (d.z * d.z + d.w * d.w)) * (1.f / 64.f);
    const float rs = __builtin_amdgcn_rsqf(var + 64e-5f);
    const f32x4 rkk = r * k * rk;
    const float bsum = row16_sum((rkk.x + rkk.y) + (rkk.z + rkk.w));
    st_bf4(mp, (d * rs * lw + lb + v * bsum) * g);
    yc = yn; rc = rn; kc = kn; vc = vn; gc = gn;
  }
}

DI void retention_unit(const Ctx& c, int bh, int slice) {
  const int b = bh >> 2, h = bh & 3;
  const bf16_t* Zq = (const bf16_t*)(c.ws + WS_ZODD) + (size_t)bh * SEQ * 256;
  const bf16_t* Zv = (const bf16_t*)(c.ws + WS_ZODD) + 67108864u + (size_t)(bh * 8 + slice) * SEQ * 64;
  bf16_t* YB = (bf16_t*)(c.ws + WS_YB) + (size_t)b * SEQ * 2048 + h * 512 + slice * 64;
  const int tid = c.tid, lane = c.lane, wave = c.wave, l15 = lane & 15, quad = lane >> 4, q_ = l15 >> 2, p_ = l15 & 3;
  constexpr int RQ = 544, RV = 160;
  LAS unsigned char* Qi = c.lds; LAS unsigned char* Ki = c.lds + 34816; LAS unsigned char* Vi = c.lds + 69632; LAS unsigned char* Vdi = c.lds + 79872;
  LAS unsigned char* Sci = c.lds + 90112; LAS unsigned char* Si = c.lds + 100352;
  const float log2g = __log2f(1.f - __builtin_amdgcn_exp2f(-5.f - (float)h));
  const float cd = __builtin_amdgcn_exp2f(log2g * 64.f);
  f32x4 st[2][4];
#pragma unroll
  for (int mt = 0; mt < 2; ++mt)
#pragma unroll
    for (int nt = 0; nt < 4; ++nt) st[mt][nt] = (f32x4){0.f, 0.f, 0.f, 0.f};
  u32x4 pq[4], pk[4], pv;
  const int prow = tid >> 5, pc = tid & 31;
  const bf16_t* qsrc = Zq + (size_t)tid * 8;
  const int vrow = tid >> 3, vc = tid & 7;
  const float kdv = __builtin_amdgcn_exp2f(log2g * (float)(63 - vrow));
  const bf16_t* vsrc = Zv + (size_t)tid * 8;
  auto issue = [&](int ch) {
#pragma unroll
    for (int i = 0; i < 4; ++i) { pq[i] = *(const u32x4*)(qsrc + (size_t)ch * 16384 + i * 4096); pk[i] = *(const u32x4*)(qsrc + 33554432u + (size_t)ch * 16384 + i * 4096); }
    pv = *(const u32x4*)(vsrc + (size_t)ch * 4096);
  };
  auto stash = [&]() {
#pragma unroll
    for (int i = 0; i < 4; ++i) { *(LAS u32x4*)(Qi + (prow + 16 * i) * RQ + pc * 16) = pq[i]; *(LAS u32x4*)(Ki + (prow + 16 * i) * RQ + pc * 16) = pk[i]; }
    *(LAS u32x4*)(Vi + vrow * RV + vc * 16) = pv;
    { float f[8]; unpack8(__builtin_bit_cast(bf16x8, pv), f);
      u32x4 w; w.x = cvtpk(f[0] * kdv, f[1] * kdv); w.y = cvtpk(f[2] * kdv, f[3] * kdv); w.z = cvtpk(f[4] * kdv, f[5] * kdv); w.w = cvtpk(f[6] * kdv, f[7] * kdv);
      *(LAS u32x4*)(Vdi + vrow * RV + vc * 16) = w; }
  };
  __syncthreads();
  issue(0);
  for (int i = tid; i < 34816 / 16; i += NTHR) *(LAS u32x4*)(Si + i * 16) = (u32x4){0u, 0u, 0u, 0u};
  stash();
  __syncthreads();
#pragma unroll 1
  for (int ch = 0; ch < 64; ++ch) {
    if (ch + 1 < 64) issue(ch + 1);
    {
      const int it = wave >> 1;
      bf16x8 qfa[8];
#pragma unroll
      for (int ks = 0; ks < 8; ++ks) qfa[ks] = *(const LAS bf16x8*)(Qi + (16 * it + l15) * RQ + (32 * ks + 8 * quad) * 2);
#pragma unroll
      for (int jj2 = 0; jj2 < 2; ++jj2) { const int jt = 2 * (wave & 1) + jj2; f32x4 acc = {0.f, 0.f, 0.f, 0.f};
#pragma unroll
        for (int ks = 0; ks < 8; ++ks) { const bf16x8 kf = *(const LAS bf16x8*)(Ki + (16 * jt + l15) * RQ + (32 * ks + 8 * quad) * 2);
          acc = MFMA16(kf, qfa[ks], acc); }
        const int i = 16 * it + l15, j0 = 16 * jt + 4 * quad; float v[4];
#pragma unroll
        for (int e = 0; e < 4; ++e) v[e] = acc[e] * __builtin_amdgcn_exp2f(log2g * __builtin_fabsf((float)(i - j0 - e)));
        u32x2 w; w.x = cvtpk(v[0], v[1]); w.y = cvtpk(v[2], v[3]); *(LAS u32x2*)(Sci + i * RV + j0 * 2) = w; }
    }
    lds_barrier();
    {
      const int et = wave >> 1;
      bf16x8 sfa[8];
#pragma unroll
      for (int ks = 0; ks < 8; ++ks) sfa[ks] = *(const LAS bf16x8*)(Si + (16 * et + l15) * RQ + (32 * ks + 8 * quad) * 2);
#pragma unroll
      for (int ii = 0; ii < 2; ++ii) { const int it2 = 2 * (wave & 1) + ii; f32x4 acc = {0.f, 0.f, 0.f, 0.f};
#pragma unroll
        for (int ks = 0; ks < 8; ++ks) { const bf16x8 qf = *(const LAS bf16x8*)(Qi + (16 * it2 + l15) * RQ + (32 * ks + 8 * quad) * 2); acc = MFMA16(sfa[ks], qf, acc); }
        const float qd = __builtin_amdgcn_exp2f(log2g * (float)(16 * it2 + l15 + 1)); acc = acc * qd;
#pragma unroll
        for (int s = 0; s < 2; ++s) { const LAS unsigned char* vp = Vi + (32 * s + 8 * quad + q_) * RV + (16 * et + 4 * p_) * 2;
          const bf16x8 vf = comb8(tr_read(vp), tr_read(vp + 4 * RV));
          const bf16x8 sc = *(const LAS bf16x8*)(Sci + (16 * it2 + l15) * RV + (32 * s + 8 * quad) * 2); acc = MFMA16(vf, sc, acc); }
        u32x2 w; w.x = cvtpk(acc[0], acc[1]); w.y = cvtpk(acc[2], acc[3]);
        *(u32x2*)(YB + (size_t)(ch * 64 + 16 * it2 + l15) * 2048 + 16 * et + 4 * quad) = w; }
#pragma unroll
      for (int mt = 0; mt < 2; ++mt)
#pragma unroll
        for (int nt = 0; nt < 4; ++nt) st[mt][nt] = st[mt][nt] * cd;
#pragma unroll
      for (int s = 0; s < 2; ++s) { bf16x8 vd[4];
#pragma unroll
        for (int nt = 0; nt < 4; ++nt) { const LAS unsigned char* vp = Vdi + (32 * s + 8 * quad + q_) * RV + (16 * nt + 4 * p_) * 2; vd[nt] = comb8(tr_read(vp), tr_read(vp + 4 * RV)); }
#pragma unroll
        for (int mt = 0; mt < 2; ++mt) { const LAS unsigned char* kp = Ki + (32 * s + 8 * quad + q_) * RQ + (32 * wave + 16 * mt + 4 * p_) * 2;
          const bf16x8 kf = comb8(tr_read(kp), tr_read(kp + 4 * RQ));
#pragma unroll
          for (int nt = 0; nt < 4; ++nt) st[mt][nt] = MFMA16(kf, vd[nt], st[mt][nt]); } }
    }
    lds_barrier();
#pragma unroll
    for (int mt = 0; mt < 2; ++mt)
#pragma unroll
      for (int nt = 0; nt < 4; ++nt) { u32x2 w; w.x = cvtpk(st[mt][nt][0], st[mt][nt][1]); w.y = cvtpk(st[mt][nt][2], st[mt][nt][3]);
        *(LAS u32x2*)(Si + (16 * nt + l15) * RQ + (32 * wave + 16 * mt + 4 * quad) * 2) = w; }
    if (ch + 1 < 64) stash();
    lds_barrier();
  }
}

DI void retention_post(const Ctx& c) {
  const bf16_t* YB = (const bf16_t*)(c.ws + WS_YB);
  bf16_t* Z = (bf16_t*)(c.ws + WS_ZODD);
  const int gw = c.bid * NWAVES + c.wave, NGW = c.G * NWAVES;
  bf16x8 yc, gc;
  { const int t = gw >> 2, h = gw & 3; yc = __builtin_nontemporal_load((const bf16x8*)(YB + (size_t)t * 2048 + h * 512 + c.lane * 8)); gc = *(const bf16x8*)(Z + 134217728u + (size_t)t * 2048 + h * 512 + c.lane * 8); }
#pragma unroll 1
  for (int p = gw; p < M_TOK * 4; p += NGW) {
    const int t = p >> 2, h = p & 3, pn = p + NGW;
    bf16x8 yn = yc, gn = gc;
    if (pn < M_TOK * 4) { const int tn = pn >> 2, hn = pn & 3; yn = __builtin_nontemporal_load((const bf16x8*)(YB + (size_t)tn * 2048 + hn * 512 + c.lane * 8)); gn = *(const bf16x8*)(Z + 134217728u + (size_t)tn * 2048 + hn * 512 + c.lane * 8); }
    bf16_t* gp = Z + 134217728u + (size_t)t * 2048 + h * 512 + c.lane * 8;
    float y[8], g[8]; unpack8(yc, y); unpack8(gc, g);
    float ss = 0.f;
#pragma unroll
    for (int e = 0; e < 8; ++e) ss += y[e] * y[e];
    const float rn = __builtin_amdgcn_rsqf(wave_sum(ss) * (1.f / 512.f) + NORM_EPS);
#pragma unroll
    for (int e = 0; e < 8; ++e) y[e] = siluf_(g[e]) * y[e] * rn;
    u32x4 w; w.x = cvtpk(y[0], y[1]); w.y = cvtpk(y[2], y[3]); w.z = cvtpk(y[4], y[5]); w.w = cvtpk(y[6], y[7]);
    *(u32x4*)gp = w;
    yc = yn; gc = gn;
  }
}

#define XB_TMO      128
#define XB_XCNT(j)  (256  + 64 * (j))
#define XB_XSUB(j)  (1280 + 64 * (j))
#define XB_XGEN(j)  (2304 + 64 * (j))
#define XB_TOP      3328
#define XB_TOPGEN   3392
#define XCD_BAR_WORDS 3456
#define XB_SPIN_CAP (1u << 18)
__device__ __forceinline__ unsigned xb_ld(unsigned* p)              { return __hip_atomic_load(p, __ATOMIC_RELAXED, __HIP_MEMORY_SCOPE_AGENT); }
__device__ __forceinline__ unsigned xb_add(unsigned* p, unsigned v) { return __hip_atomic_fetch_add(p, v, __ATOMIC_RELAXED, __HIP_MEMORY_SCOPE_AGENT); }
#define XB_SPIN(cond, bar) do { unsigned _sp = 0; while (cond) { __builtin_amdgcn_s_sleep(1); \
    if ((++_sp & 255u) == 0u) { if (xb_ld(&(bar)[XB_TMO])) break; if (_sp > XB_SPIN_CAP) { atomicAdd(&(bar)[XB_TMO], 1u); break; } } } } while (0)
struct XcdBarrier { unsigned* bar; unsigned x; volatile LAS unsigned* st; };
__device__ __forceinline__ XcdBarrier xcd_barrier_post(unsigned* bar, volatile LAS unsigned* st) {
    XcdBarrier b; b.bar = bar; b.x = xb_xcc_id(); b.st = st;
    if (threadIdx.x == 0) (void)xb_add(&bar[XB_XCNT(b.x)], 1u);
    return b;
}
__device__ __forceinline__ void xcd_barrier_complete(unsigned* bar, unsigned x, unsigned& nloc, unsigned& nx) {
    const unsigned G = gridDim.x * gridDim.y * gridDim.z;
    unsigned sum, cnt, mine, sp = 0u;
    for (;;) {
        sum = 0u; cnt = 0u; mine = 0u;
#pragma unroll
        for (unsigned j = 0; j < 16; ++j) { const unsigned c = xb_ld(&bar[XB_XCNT(j)]); sum += c; cnt += (c > 0u) ? 1u : 0u; mine = (j == x) ? c : mine; }
        if (sum == G) break;
        __builtin_amdgcn_s_sleep(1);
        if ((++sp & 255u) == 0u) { if (xb_ld(&bar[XB_TMO])) break; if (sp > XB_SPIN_CAP) { atomicAdd(&bar[XB_TMO], 1u); break; } }
    }
    nloc = mine > 0u ? mine : 1u; nx = cnt > 0u ? cnt : 1u;
}
__device__ __forceinline__ void xcd_barrier(const XcdBarrier& b) {
    asm volatile("s_waitcnt vmcnt(0)" ::: "memory");
    __syncthreads();
    if (threadIdx.x == 0) {
        unsigned* bar = b.bar;
        __builtin_amdgcn_s_waitcnt(0);
        unsigned nloc = b.st[0], nx = b.st[1];
        if (nloc == 0u) { xcd_barrier_complete(bar, b.x, nloc, nx); b.st[0] = nloc; b.st[1] = nx; }
        const unsigned old = xb_add(&bar[XB_XSUB(b.x)], 1u);
        const unsigned gen = old / nloc;
        if (old + 1u == (gen + 1u) * nloc) {
            __builtin_amdgcn_fence(__ATOMIC_RELEASE, "agent");
            asm volatile("s_waitcnt vmcnt(0)" ::: "memory");
            const unsigned og = xb_add(&bar[XB_TOP], 1u);
            const unsigned tg = og / nx;
            if (og + 1u == (tg + 1u) * nx) xb_add(&bar[XB_TOPGEN], 1u);
            else XB_SPIN(xb_ld(&bar[XB_TOPGEN]) == tg, bar);
            __builtin_amdgcn_fence(__ATOMIC_ACQUIRE, "agent");
            xb_add(&bar[XB_XGEN(b.x)], 1u);
            asm volatile("s_waitcnt vmcnt(0)" ::: "memory");
        } else {
            XB_SPIN(xb_ld(&bar[XB_XGEN(b.x)]) == gen, bar);
            __builtin_amdgcn_fence(__ATOMIC_ACQUIRE, "agent");
            asm volatile("s_waitcnt vmcnt(0)" ::: "memory");
        }
    }
    __syncthreads();
}

enum { T_CONV = 0, T_GU_A, T_DOWN_A, T_ROW1, T_WIN, T_PREP, T_SCAN, T_MIX, T_POST, T_WOUT, T_ROW3, T_GU_B, T_DOWN_B, T_RET, T_RETPOST, T_FINAL };
__global__ void __launch_bounds__(NTHR, 2) fwd_megakernel(Args args) {
  extern __shared__ __attribute__((aligned(16))) unsigned char lds_raw[];
  cg::grid_group grid = cg::this_grid();
  const int lo = args.ph_lo, hi = args.ph_hi;
  volatile LAS unsigned* bst = (volatile LAS unsigned*)((LAS unsigned char*)lds_raw + LDS_CTLO + 128);
  if (threadIdx.x < 2) bst[threadIdx.x] = 0u;
  __syncthreads();
  XcdBarrier xbar; xbar.bar = (unsigned*)(args.ws + WS_CTL) + 4096; xbar.x = 0; xbar.st = bst;
  if (!MK_PER_PHASE) xbar = xcd_barrier_post((unsigned*)(args.ws + WS_CTL) + 4096, bst);
#pragma unroll 1
  for (int ph = lo; ph < hi; ++ph) {
    Ctx c;
    { int tid = threadIdx.x, bid = blockIdx.x, G = gridDim.x, z = 0;
      asm volatile("" : "+v"(tid)); asm volatile("" : "+s"(bid), "+s"(G), "+s"(z));
      unsigned char* ws = args.ws + z; float* out = args.out + z;
      c.lds = (LAS unsigned char*)lds_raw; c.tid = tid; c.lane = tid & 63; c.wave = __builtin_amdgcn_readfirstlane(tid >> 6);
      c.G = G; c.bid = bid; c.z = z; c.ws = ws; c.out = out; }
    int L, k;
    if (ph < 12) { L = 0; k = ph; } else if (ph < 23) { L = 1; k = ph - 12; } else if (ph < 35) { L = 2; k = ph - 23; } else if (ph < 46) { L = 3; k = ph - 35; } else { L = 4; k = 0; }
    int type;
    if (L == 4) type = T_FINAL;
    else if ((L & 1) == 0) type = (k <= T_PREP) ? k : k + 1;
    else type = (k <= 4) ? k : (k == 5 ? T_RET : (k == 6 ? T_RETPOST : k + 2));
    const unsigned long long pt0 = PROBE_MASK ? __builtin_amdgcn_s_memrealtime() : 0ull;
    const bool even = (L & 1) == 0; const int j = L >> 1;
    const bool is_gemm = (type == T_GU_A || type == T_DOWN_A || type == T_WIN || type == T_WOUT || type == T_GU_B || type == T_DOWN_B);
    if (is_gemm) {
      pg8::Gemm g; pg8::EpiRT E;
      bf16_t* XB = (bf16_t*)(c.ws + WS_XB); bf16_t* F = (bf16_t*)(c.ws + WS_F); bf16_t* H = (bf16_t*)(c.ws + WS_H);
      const float* RINV = (const float*)(c.ws + WS_RINV);
      g.M = M_TOK;
      if (type == T_GU_A || type == T_GU_B) { g.A = XB; g.Bt = (const bf16_t*)(c.ws + (type == T_GU_A ? WS_WGU0 : WS_WGU1)); g.N = 2 * DFF; g.K = DM; g.lda = DM; g.ldb = DM; E.mode = 2; E.O = H; E.ldc = DFF; E.rs = RINV; }
      else if (type == T_DOWN_A || type == T_DOWN_B) { g.A = H; g.Bt = (const bf16_t*)(c.ws + (type == T_DOWN_A ? WS_WD0 : WS_WD1)); g.N = DM; g.K = DFF; g.lda = DFF; g.ldb = DFF; E.mode = 0; E.O = F; E.ldc = DM; E.rs = RINV; }
      else if (type == T_WIN) { const int NIN = even ? EVEN_IN : ODD_IN; g.A = XB; g.Bt = (const bf16_t*)(c.ws + WS_WIN); g.N = NIN; g.K = DM; g.lda = DM; g.ldb = DM; E.mode = even ? 1 : 3; E.O = (bf16_t*)(c.ws + (even ? WS_ZEVEN : WS_ZODD)); E.ldc = NIN; E.rs = RINV; }
      else { if (even) { g.A = (const bf16_t*)(c.ws + WS_MIXE); g.K = DM; g.lda = DM; g.ldb = DM; } else { g.A = (const bf16_t*)(c.ws + WS_ZODD) + 134217728u; g.K = 2048; g.lda = 2048; g.ldb = 2048; }
        g.Bt = (const bf16_t*)(c.ws + WS_WOUT); g.N = DM; E.mode = 0; E.O = F; E.ldc = DM; E.rs = RINV; }
      pg8::StaticOrder S; S.init(M_TOK, g.N, c.G, c.bid);
      pg8::gemm_phase(c.lds, g, S, E);
      if ((DUP_MASK >> type) & 1) pg8::gemm_phase(c.lds, g, S, E);
    } else if (type == T_CONV || type == T_ROW1 || type == T_ROW3 || type == T_FINAL) {
      const float* xin = nullptr; float* xout = nullptr; const bf16_t* F = (const bf16_t*)(c.ws + WS_F); const float* gain = nullptr; float coef = 0.5f;
      if (type == T_CONV) {
        convert_layer(c, args, L);
        if (L == 0) { xin = args.in[c.z + IN_X]; F = nullptr; } else gain = args.in[c.z + IN_NORMS] + (size_t)(L - 1) * 6 * DM + 5 * DM;
      } else if (type == T_ROW1) gain = args.in[c.z + IN_NORMS] + (size_t)L * 6 * DM + 1 * DM;
      else if (type == T_ROW3) { gain = args.in[c.z + IN_NORMS] + (size_t)L * 6 * DM + 3 * DM; coef = 1.0f; }
      else { gain = args.in[c.z + IN_NORMS] + (size_t)3 * 6 * DM + 5 * DM; xout = c.out; }
      rowpass(c, xin, xout, F, gain, coef);
    } else if (type == T_PREP) {
      rwkv_prep(c, args, j);
      attn_knorm(c);
    } else if (type == T_MIX) {
      attn_phase(c, args, j, L, (unsigned*)(c.ws + WS_CTL) + 64 * j);
    } else if (type == T_POST) {
      rwkv_post(c, args, j);
    } else if (type == T_RET) {
      { unsigned* cnt0 = (unsigned*)(c.ws + WS_CTL) + 128 + 64 * j; const int x = (int)(xb_xcc_id() & 7u);
        LAS int* qw = (LAS int*)(c.lds + LDS_CTLO + 64);
        for (int qi = 0; qi < 8; ++qi) { const int q = (x + qi) & 7;
          for (;;) { __syncthreads(); if (c.tid == 0) *qw = (int)atomicAdd(cnt0 + q, 1u); __syncthreads();
            const int slot = *qw; if (slot >= 32) break; retention_unit(c, q * 4 + (slot >> 3), slot & 7); } } }
    } else if (type == T_RETPOST) {
      retention_post(c);
    }
    if (PROBE_MASK && ((PROBE_MASK >> type) & 1)) { __syncthreads(); const unsigned long long pt1 = __builtin_amdgcn_s_memrealtime(); while (__builtin_amdgcn_s_memrealtime() - pt1 < pt1 - pt0) __builtin_amdgcn_s_sleep(8); }
    if (ph + 1 < hi) { if (lo < 0) grid.sync(); else xcd_barrier(xbar); }
  }
}
constexpr int N_PHASES = 12 + 11 + 12 + 11 + 1;

extern "C" void kernel_launch(void* const* d_in, const int* in_sizes, int n_in, void* d_out, int out_size, void* d_ws, size_t ws_size, hipStream_t stream) {
  static int grid = 0;
  if (grid == 0) {
    if (n_in != 18 || out_size != M_TOK * DM || ws_size < WS_END) { fprintf(stderr, "kernel_launch: unexpected shapes (n_in %d, out %d, ws %zu, need %zu)\n", n_in, out_size, ws_size, (size_t)WS_END); grid = -1; return; }
    int dev = 0, cus = 0, per_cu = 0;
    hipGetDevice(&dev); hipDeviceGetAttribute(&cus, hipDeviceAttributeMultiprocessorCount, dev);
    if (hipFuncSetAttribute((const void*)fwd_megakernel, hipFuncAttributeMaxDynamicSharedMemorySize, LDS_BYTES) != hipSuccess) { fprintf(stderr, "kernel_launch: hipFuncSetAttribute failed\n"); grid = -1; return; }
    if (hipOccupancyMaxActiveBlocksPerMultiprocessor(&per_cu, (const void*)fwd_megakernel, NTHR, LDS_BYTES) != hipSuccess || per_cu < 1) { fprintf(stderr, "kernel_launch: occupancy query gives %d\n", per_cu); per_cu = 1; }
    (void)hipGetLastError();
    grid = cus * per_cu;
    if (grid > 256) grid = 256;
  }
  if (grid < 0) return;
  hipMemsetAsync((char*)d_ws + WS_CTL, 0, CTL_BYTES, stream);
  Args a{};
  for (int i = 0; i < 18; ++i) a.in[i] = (const float*)d_in[i];
  a.out = (float*)d_out; a.ws = (unsigned char*)d_ws;
#if MK_PER_PHASE
  for (int p = 0; p < N_PHASES; ++p) { a.ph_lo = p; a.ph_hi = p + 1; hipLaunchKernelGGL(fwd_megakernel, dim3(grid), dim3(NTHR), LDS_BYTES, stream, a); }
#else
  a.ph_lo = 0; a.ph_hi = N_PHASES;
  void* kargs[] = {&a};
  hipError_t e = hipLaunchCooperativeKernel((const void*)fwd_megakernel, dim3(grid), dim3(NTHR), kargs, LDS_BYTES, stream);
  if (e != hipSuccess) fprintf(stderr, "cooperative launch failed: %s (grid %d)\n", hipGetErrorString(e), grid);
#endif
}
```
